# Optimizing an MI355X kernel written in HIP

```python
import jax
import jax.numpy as jnp
from jax import lax
import numpy as np

D_MODEL = 1024
BATCH = 1
SEQ = 16384
DEPTH = 1
DEC_BATCH = 128
DEC_SEQ = 1
PAST_LEN = 8192
PAGE_SIZE = 128

A_WINDOWS = (128, 512, 2048)
A_DILATIONS = (1, 4, 16)
A_GROUPS = 3
A_HEADS = 8
A_HEAD_DIM = 64
A_NKEY = A_WINDOWS[0] // A_DILATIONS[0]
ROPE_THETA = 10000.0
HG_HEADS = 4
HG_K = 128
HG_V = 128
HG_CHUNK = 64
MEM_LEN = 256
XA_HEADS = 4
XA_HEAD_DIM = 128
EPS = 1e-6

A_QKV = A_GROUPS * A_HEADS * A_HEAD_DIM
A_OUT = A_HEADS * A_HEAD_DIM
HG_QK = HG_HEADS * HG_K
HG_OUT = HG_HEADS * HG_V
XA_W = XA_HEADS * XA_HEAD_DIM
IN_SPLITS = (A_QKV, A_QKV, A_QKV, A_OUT, HG_QK, HG_QK, HG_OUT, HG_OUT, XA_W, XA_W, D_MODEL, D_MODEL, D_MODEL)
IN_OFFSETS = tuple(sum(IN_SPLITS[:i + 1]) for i in range(len(IN_SPLITS) - 1))
N_IN = sum(IN_SPLITS)

kernel_name = 'hybrid_dilated_hgrn2_memory_step'


def _rmsnorm(x, g):
    x32 = x.astype(jnp.float32)
    y = x32 * lax.rsqrt(jnp.mean(x32 * x32, axis=-1, keepdims=True) + EPS)
    return (y * g.astype(jnp.float32)).astype(x.dtype)


def _rope(x, pos):
    dh = x.shape[-1]
    inv = ROPE_THETA ** (-jnp.arange(0, dh, 2, dtype=jnp.float32) / dh)
    ang = pos.astype(jnp.float32)[:, None] * inv[None, :]
    cos = jnp.cos(ang)[None, :, None, :]
    sin = jnp.sin(ang)[None, :, None, :]
    x32 = x.astype(jnp.float32)
    x1, x2 = x32[..., :dh // 2], x32[..., dh // 2:]
    return jnp.concatenate([x1 * cos - x2 * sin, x2 * cos + x1 * sin], axis=-1)


def _dilated_prompt(q, k, v, dil):
    B, T, H, Dh = q.shape
    L = T // dil
    blk = A_NKEY
    nb = -(-L // blk)
    Lp = nb * blk

    def residues(a):
        return a.reshape(B, L, dil, H, Dh).transpose(0, 2, 1, 3, 4)

    qb = jnp.pad(residues(q), ((0, 0), (0, 0), (0, Lp - L), (0, 0), (0, 0))).reshape(B, dil, nb, blk, H, Dh)

    def key_blocks(a):
        a = jnp.pad(residues(a), ((0, 0), (0, 0), (blk, Lp - L), (0, 0), (0, 0)))
        prev = a[:, :, :Lp].reshape(B, dil, nb, blk, H, Dh)
        cur = a[:, :, blk:].reshape(B, dil, nb, blk, H, Dh)
        return jnp.concatenate([prev, cur], axis=3)

    kb = key_blocks(k)
    vb = key_blocks(v)
    s = jnp.einsum('brnqhd,brnkhd->brnhqk', qb, kb) * (Dh ** -0.5)
    qi = jnp.arange(blk)[:, None]
    ki = jnp.arange(2 * blk)[None, :]
    dist = qi + blk - ki
    band = (dist >= 0) & (dist <= A_NKEY)
    real = (jnp.arange(nb)[:, None, None] > 0) | (ki[None] >= blk)
    mask = band[None] & real
    s = jnp.where(mask[None, None, :, None], s, -jnp.inf)
    m = jnp.max(s, axis=-1, keepdims=True)
    p = jnp.exp(s - m)
    l = jnp.sum(p, axis=-1, keepdims=True)
    o = jnp.einsum('brnhqk,brnkhd->brnqhd', p / l, vb)
    lse = (m + jnp.log(l))[..., 0].transpose(0, 1, 2, 4, 3)
    o = o.reshape(B, dil, Lp, H, Dh)[:, :, :L].transpose(0, 2, 1, 3, 4).reshape(B, T, H, Dh)
    lse = lse.reshape(B, dil, Lp, H)[:, :, :L].transpose(0, 2, 1, 3).reshape(B, T, H)
    return o, lse


def _dilated_sample(q, buf, k, v, dil):
    Wb = buf.shape[1]
    S = q.shape[1]
    Dh = q.shape[-1]
    kc = jnp.concatenate([buf[:, :, 0].astype(jnp.float32), k], axis=1)
    vc = jnp.concatenate([buf[:, :, 1].astype(jnp.float32), v], axis=1)
    idx = Wb + jnp.arange(S)[:, None] - dil * jnp.arange(A_NKEY + 1)[None, :]
    valid = idx >= 0
    idx = jnp.maximum(idx, 0)
    kg = kc[:, idx]
    vg = vc[:, idx]
    s = jnp.einsum('bshd,bsjhd->bshj', q, kg) * (Dh ** -0.5)
    s = jnp.where(valid[None, :, None, :], s, -jnp.inf)
    m = jnp.max(s, axis=-1, keepdims=True)
    p = jnp.exp(s - m)
    l = jnp.sum(p, axis=-1, keepdims=True)
    o = jnp.einsum('bshj,bsjhd->bshd', p / l, vg)
    lse = (m + jnp.log(l))[..., 0]
    return o, lse


def _hgrn2(q, k, v, logf, S0):
    B, T, H, K = q.shape
    C = min(HG_CHUNK, T)
    n = -(-T // C)
    Tp = n * C

    def chunks(a):
        a = jnp.pad(a, ((0, 0), (0, Tp - T), (0, 0), (0, 0)))
        return a.reshape(B, n, C, H, a.shape[-1]).transpose(1, 0, 2, 3, 4)

    tri = jnp.tril(jnp.ones((C, C), dtype=bool))

    def step(S, inp):
        qc, kc, vc, gc = inp
        b = jnp.cumsum(gc, axis=1)
        o_inter = jnp.einsum('bthk,bhkv->bthv', qc * jnp.exp(b), S)
        diff = b[:, :, None] - b[:, None, :]
        dec = jnp.exp(jnp.where(tri[None, :, :, None, None], diff, -jnp.inf))
        att = jnp.einsum('bthk,btshk,bshk->bhts', qc, dec, kc)
        o_intra = jnp.einsum('bhts,bshv->bthv', att, vc)
        b_last = b[:, -1]
        S_new = jnp.exp(b_last)[..., None] * S + jnp.einsum('bshk,bshv->bhkv', kc * jnp.exp(b_last[:, None] - b), vc)
        return S_new, o_inter + o_intra

    S_fin, o = lax.scan(step, S0, (chunks(q), chunks(k), chunks(v), chunks(logf)))
    o = o.transpose(1, 0, 2, 3, 4).reshape(B, Tp, H, v.shape[-1])[:, :T]
    return o, S_fin


def _layer(h, pos, attend, S0, mem_kv, lb, pre_g, post_g, w_in, hg_g, w_pa, w_pb, w_pc, w_out):
    B, T, _ = h.shape
    u = _rmsnorm(h, pre_g) @ w_in
    aq, ak, av, az, bq, bf, bi, bz, cq, cz, ga, gb, gc = jnp.split(u, IN_OFFSETS, axis=-1)

    ga_shape = (B, T, A_GROUPS, A_HEADS, A_HEAD_DIM)
    aq = _rope(aq.reshape(B, T, A_GROUPS * A_HEADS, A_HEAD_DIM), pos).reshape(ga_shape)
    ak = _rope(ak.reshape(B, T, A_GROUPS * A_HEADS, A_HEAD_DIM), pos).reshape(ga_shape)
    av = av.astype(jnp.float32).reshape(ga_shape)
    outs = []
    lses = []
    for g in range(A_GROUPS):
        o_g, lse_g = attend(g, aq[:, :, g], ak[:, :, g], av[:, :, g])
        outs.append(o_g)
        lses.append(lse_g)
    alpha = jax.nn.softmax(jnp.stack(lses, axis=0), axis=0)
    oa = jnp.sum(alpha[..., None] * jnp.stack(outs, axis=0), axis=0).reshape(B, T, A_OUT)
    ya = oa.astype(h.dtype) * jax.nn.silu(az)

    bf32 = bf.astype(jnp.float32)
    logf = jnp.log(lb + (1.0 - lb) * jax.nn.sigmoid(bf32))
    kin = (1.0 - lb) * jax.nn.sigmoid(-bf32)
    hs4 = (B, T, HG_HEADS, HG_K)
    ob, S_fin = _hgrn2(bq.astype(jnp.float32).reshape(hs4), kin.reshape(hs4),
                       bi.astype(jnp.float32).reshape(B, T, HG_HEADS, HG_V), logf.reshape(hs4), S0)
    ob = ob * lax.rsqrt(jnp.mean(ob * ob, axis=-1, keepdims=True) + EPS) * hg_g.astype(jnp.float32).reshape(HG_HEADS, HG_V)
    yb = ob.reshape(B, T, HG_OUT).astype(h.dtype) * jax.nn.silu(bz)

    mk = mem_kv[:, :, 0].astype(jnp.float32)
    mv = mem_kv[:, :, 1].astype(jnp.float32)
    cq32 = cq.astype(jnp.float32).reshape(B, T, XA_HEADS, XA_HEAD_DIM)
    sc = jnp.einsum('bthd,bmhd->bhtm', cq32, mk) * (XA_HEAD_DIM ** -0.5)
    pc = jax.nn.softmax(sc, axis=-1)
    oc = jnp.einsum('bhtm,bmhd->bthd', pc, mv).reshape(B, T, XA_W)
    yc = oc.astype(h.dtype) * jax.nn.silu(cz)

    merged = (jax.nn.sigmoid(ga) * (ya @ w_pa) + jax.nn.sigmoid(gb) * (yb @ w_pb)
              + jax.nn.sigmoid(gc) * (yc @ w_pc))
    out = h + _rmsnorm(merged @ w_out, post_g)
    return out, ak, av, S_fin


def setup_inputs(seed: int = 0) -> dict:
    key = jax.random.key(seed)
    ks = jax.random.split(key, 20)

    def nrm(k, shape, scale):
        return jax.random.normal(k, shape, jnp.float32) * scale

    wb = [min(w, PAST_LEN) for w in A_WINDOWS]
    return {
        'x_prompt': nrm(ks[0], (BATCH, SEQ, D_MODEL), 1.0),
        'x_sample': nrm(ks[1], (DEC_BATCH, DEC_SEQ, D_MODEL), 1.0),
        'mem_prompt': nrm(ks[2], (BATCH, MEM_LEN, D_MODEL), 1.0),
        'cache_win128_kv': nrm(ks[3], (DEPTH, DEC_BATCH, wb[0], 2, A_HEADS, A_HEAD_DIM), 1.0),
        'cache_win512_kv': nrm(ks[4], (DEPTH, DEC_BATCH, wb[1], 2, A_HEADS, A_HEAD_DIM), 1.0),
        'cache_win2048_kv': nrm(ks[5], (DEPTH, DEC_BATCH, wb[2], 2, A_HEADS, A_HEAD_DIM), 1.0),
        'state_hgrn': nrm(ks[6], (DEPTH, DEC_BATCH, HG_HEADS, HG_K, HG_V), 0.5),
        'cache_mem_kv': nrm(ks[7], (DEPTH, DEC_BATCH, MEM_LEN, 2, XA_HEADS, XA_HEAD_DIM), 1.0),
        'norm_pre': 1.0 + nrm(ks[8], (DEPTH, D_MODEL), 0.05),
        'norm_post': 1.0 + nrm(ks[9], (DEPTH, D_MODEL), 0.05),
        'w_in': nrm(ks[10], (DEPTH, D_MODEL, N_IN), D_MODEL ** -0.5),
        'hgrn_lb_logits': nrm(ks[11], (DEPTH + 1, HG_QK), 0.1),
        'hgrn_out_norm': 1.0 + nrm(ks[12], (DEPTH, HG_OUT), 0.05),
        'mem_norm': 1.0 + nrm(ks[13], (DEPTH, D_MODEL), 0.05),
        'w_mem_kv': nrm(ks[14], (DEPTH, D_MODEL, 2 * XA_W), D_MODEL ** -0.5),
        'w_branch_a': nrm(ks[15], (DEPTH, A_OUT, D_MODEL), A_OUT ** -0.5),
        'w_branch_b': nrm(ks[16], (DEPTH, HG_OUT, D_MODEL), HG_OUT ** -0.5),
        'w_branch_c': nrm(ks[17], (DEPTH, XA_W, D_MODEL), XA_W ** -0.5),
        'w_out': nrm(ks[18], (DEPTH, D_MODEL, D_MODEL), D_MODEL ** -0.5),
    }


def reference(x_prompt, x_sample, mem_prompt, cache_win128_kv, cache_win512_kv, cache_win2048_kv,
              state_hgrn, cache_mem_kv, norm_pre, norm_post, w_in, hgrn_lb_logits, hgrn_out_norm,
              mem_norm, w_mem_kv, w_branch_a, w_branch_b, w_branch_c, w_out):
    win_caches = (cache_win128_kv, cache_win512_kv, cache_win2048_kv)
    lb_all = jnp.cumsum(jax.nn.softmax(hgrn_lb_logits.astype(jnp.float32), axis=0), axis=0)
    Bp, T, _ = x_prompt.shape
    Bd, S, _ = x_sample.shape
    M = mem_prompt.shape[1]
    pos_p = jnp.arange(T, dtype=jnp.int32)
    pos_s = PAST_LEN + jnp.arange(S, dtype=jnp.int32)
    hp = x_prompt
    hs = x_sample
    p_win = [[] for _ in range(A_GROUPS)]
    s_win = [[] for _ in range(A_GROUPS)]
    p_hg, s_hg, p_mem = [], [], []

    def attend_p(g, q, k, v):
        return _dilated_prompt(q, k, v, A_DILATIONS[g])

    for l in range(DEPTH):
        shared = (lb_all[l], norm_pre[l], norm_post[l], w_in[l], hgrn_out_norm[l],
                  w_branch_a[l], w_branch_b[l], w_branch_c[l], w_out[l])
        mem_kv = (_rmsnorm(mem_prompt, mem_norm[l]) @ w_mem_kv[l]).reshape(Bp, M, 2, XA_HEADS, XA_HEAD_DIM)
        S0 = jnp.zeros((Bp, HG_HEADS, HG_K, HG_V), jnp.float32)
        hp, akp, avp, Sp = _layer(hp, pos_p, attend_p, S0, mem_kv, *shared)
        for g in range(A_GROUPS):
            wb = min(A_WINDOWS[g], T)
            p_win[g].append(jnp.stack([akp[:, T - wb:, g], avp[:, T - wb:, g]], axis=2).astype(x_prompt.dtype))
        p_hg.append(Sp.astype(x_prompt.dtype))
        p_mem.append(mem_kv)
        bufs = tuple(c[l] for c in win_caches)

        def attend_s(g, q, k, v, bufs=bufs):
            return _dilated_sample(q, bufs[g], k, v, A_DILATIONS[g])

        hs, aks, avs, Ss = _layer(hs, pos_s, attend_s, state_hgrn[l].astype(jnp.float32), cache_mem_kv[l], *shared)
        for g in range(A_GROUPS):
            s_win[g].append(jnp.stack([aks[:, :, g], avs[:, :, g]], axis=2).astype(x_sample.dtype))
        s_hg.append(Ss.astype(x_sample.dtype))

    new_win128_p = jnp.stack(p_win[0], axis=0)
    new_win512_p = jnp.stack(p_win[1], axis=0)
    new_win2048_p = jnp.stack(p_win[2], axis=0)
    new_hgrn_p = jnp.stack(p_hg, axis=0)
    new_mem_kv_p = jnp.stack(p_mem, axis=0)
    new_win128_s = jnp.stack(s_win[0], axis=0)
    new_win512_s = jnp.stack(s_win[1], axis=0)
    new_win2048_s = jnp.stack(s_win[2], axis=0)
    new_hgrn_s = jnp.stack(s_hg, axis=0)
    return (hp, hs, new_win128_p, new_win512_p, new_win2048_p, new_hgrn_p, new_mem_kv_p,
            new_win128_s, new_win512_s, new_win2048_s, new_hgrn_s)
```

```cpp
#include <hip/hip_runtime.h>
#include <cstdio>
#include <cstdint>
constexpr int T_SEQ = 16384, DMODEL = 1024, NSAMP = 128, MROWS = 16640  , NIN = 11264;
constexpr int C_AQ = 0, C_AK = 1536, C_AV = 3072, C_AZ = 4608, C_BQ = 5120, C_BF = 5632, C_BI = 6144, C_BZ = 6656, C_CQ = 7168, C_CZ = 7680, C_GA = 8192;
constexpr float EPS = 1e-6f;
constexpr size_t O_YP = 0, O_YS = 16777216, O_W128P = 16908288, O_W512P = 17039360, O_W2048P = 17563648, O_HGP = 19660800, O_MEMKV = 19726336,
                 O_W128S = 19988480, O_W512S = 20119552, O_W2048S = 20250624, O_HGS = 20381696, O_END = 28770304;
constexpr size_t MiB = 1u << 20;
constexpr size_t WS_CTL = 0, CTL_ZERO_BYTES = 1 * MiB;
constexpr size_t WS_WIN = 2 * MiB, WS_WMEM = 24 * MiB, WS_WPA = 26 * MiB, WS_WPB = 27 * MiB, WS_WPC = 28 * MiB, WS_WOUT = 29 * MiB, WS_MN = 31 * MiB, WS_MEMKV = 31 * MiB + 512 * 1024;
constexpr size_t WS_CS = 32 * MiB, WS_XN = 36 * MiB, WS_U = 70 * MiB, WS_OG = 428 * MiB, WS_LSE = 477 * MiB, WS_HU = 479 * MiB, WS_HP = 495 * MiB, WS_HS = 496 * MiB;
constexpr size_t WS_YA = 512 * MiB, WS_YB = 529 * MiB, WS_YC = 546 * MiB, WS_M32 = 563 * MiB, WS_MG = 628 * MiB, WS_Z = 661 * MiB, WS_END = 726 * MiB;
constexpr int CW_BAR = 4096;
namespace pg8 {
#define PG8_LAS __attribute__((address_space(3)))
typedef unsigned short bf16_t;
typedef short bf16x8 __attribute__((ext_vector_type(8)));
typedef float f32x4 __attribute__((ext_vector_type(4)));
typedef unsigned u32x4 __attribute__((ext_vector_type(4)));
constexpr int BM = 256, BK = 64, HALF = 128, HTB = HALF * BK * 2  , STAGE_BYTES = 8 * HTB, NXCD = 8, WGM = 8;

__host__ __device__ __forceinline__ int lds_byte(int r, int c) { const int st = (r >> 4) * 2 + (c >> 5), rr = r & 15, cc = c & 31, ob = rr * 64 + cc * 2; return st * 1024 + (ob ^ (((ob >> 9) & 1) << 5)); }
__host__ __device__ __forceinline__ void stage_rc(int b, int& R, int& C) { const int st = b / 1024, sb = b % 1024, swz = sb ^ (((sb >> 9) & 1) << 5); R = (st >> 1) * 16 + swz / 64; C = (st & 1) * 32 + (swz % 64) / 2; }
__host__ __device__ __forceinline__ int perm32(int rho) { const int n = rho >> 4, i = rho & 15; return 8 * (i >> 2) + 4 * n + (i & 3); }

struct Unit { int pm, pn; };
struct Gemm { const bf16_t* A; const bf16_t* Bt; int M, N, K; };

struct StaticOrder {
    int nM, nN, nwg, G, c;
    __host__ __device__ void init(int M, int N, int G_, int c_) { nM = M / BM; nN = N / BM; nwg = nM * nN; G = G_; c = c_; }
    __host__ __device__ bool next(int i, Unit& u) const {
        const long L = (long)i * G + c; if (L >= nwg) return false;
        int wgid = (int)L; { const int q = nwg / NXCD, r = nwg % NXCD, xcd = wgid % NXCD, off = wgid / NXCD; wgid = (xcd < r ? xcd * (q + 1) : r * (q + 1) + (xcd - r) * q) + off; }
        const int nig = WGM * nN, gid = wgid / nig, fm = gid * WGM, gsz = (nM - fm) < WGM ? (nM - fm) : WGM;
        u.pm = fm + ((wgid % nig) % gsz); u.pn = (wgid % nig) / gsz; return true;
    }
    __device__ __forceinline__ void a_ready(const Unit&) const {}
    __device__ __forceinline__ void done(const Unit&) const {}
};

__device__ __forceinline__ unsigned cvt_pk_bf16(float lo, float hi) { unsigned r; asm volatile("v_cvt_pk_bf16_f32 %0, %1, %2" : "=v"(r) : "v"(lo), "v"(hi)); return r; }
typedef unsigned u32x2 __attribute__((ext_vector_type(2)));
typedef float f32x2 __attribute__((ext_vector_type(2)));
__device__ __forceinline__ float sigm(float x) { return 1.0f / (1.0f + __expf(-x)); }
__device__ __forceinline__ float bflo(unsigned w) { return __uint_as_float(w << 16); }
__device__ __forceinline__ float bfhi(unsigned w) { return __uint_as_float(w & 0xffff0000u); }

struct EpiU {
    static constexpr bool PERM = false, AFTER_DRAIN = false;
    bf16_t* U; const float* cs; float* out;
    __device__ __forceinline__ void operator()(const f32x4 (&acc)[2][2][4][2], const Unit& u, int wr, int wc, int fr, int fq) const {
        const int pn = u.pn, rbase = u.pm * 256 + wr * 64 + fr, cbase = pn * 256 + wc * 32 + 4 * fq;
        if (pn < 12) {
            const bool isk = pn >= 6; const int g = isk ? ((pn - 6) >> 1) : 0;
            const int t0 = (g == 0) ? 16256 : (g == 1 ? 15872 : 14336);
            const size_t offp = (g == 0) ? O_W128P : (g == 1 ? O_W512P : O_W2048P), offs = (g == 0) ? O_W128S : (g == 1 ? O_W512S : O_W2048S);
            const float qs = isk ? 1.0f : 0.125f;
#pragma unroll
            for (int ai = 0; ai < 2; ++ai)
#pragma unroll
                for (int m = 0; m < 4; ++m) { const int row = rbase + ai * 128 + m * 16, pos = row < T_SEQ ? row : 8192;
                    float* dstr = nullptr;
                    if (isk) { if (row < T_SEQ) { if (row >= t0) dstr = out + offp + (size_t)(row - t0) * 1024; } else if (row < T_SEQ + NSAMP) dstr = out + offs + (size_t)(row - T_SEQ) * 1024; }
#pragma unroll
                    for (int bj = 0; bj < 2; ++bj)
#pragma unroll
                        for (int n = 0; n < 2; ++n) { const int vc = cbase + bj * 128 + n * 16, hb = vc & ~63, i = (vc & 63) >> 1;
                            const f32x4 c4 = *(const f32x4*)(cs + ((size_t)pos * 32 + i) * 2); const f32x4 x = acc[ai][bj][m][n];
                            const float lo0 = (x[0] * c4[0] - x[1] * c4[1]) * qs, hi0 = (x[1] * c4[0] + x[0] * c4[1]) * qs, lo1 = (x[2] * c4[2] - x[3] * c4[3]) * qs, hi1 = (x[3] * c4[2] + x[2] * c4[3]) * qs;
                            bf16_t* up = U + (size_t)row * NIN + hb + i;
                            *(unsigned*)up = cvt_pk_bf16(lo0, lo1); *(unsigned*)(up + 32) = cvt_pk_bf16(hi0, hi1);
                            if (dstr) { float* d = dstr + (((hb - C_AK) >> 6) & 7) * 64 + i; *(f32x2*)d = (f32x2){lo0, lo1}; *(f32x2*)(d + 32) = (f32x2){hi0, hi1}; } } }
        } else if (pn < 18) {
            const int g = (pn - 12) >> 1; const int t0 = (g == 0) ? 16256 : (g == 1 ? 15872 : 14336);
            const size_t offp = (g == 0) ? O_W128P : (g == 1 ? O_W512P : O_W2048P), offs = (g == 0) ? O_W128S : (g == 1 ? O_W512S : O_W2048S);
#pragma unroll
            for (int ai = 0; ai < 2; ++ai)
#pragma unroll
                for (int m = 0; m < 4; ++m) { const int row = rbase + ai * 128 + m * 16;
                    float* dstr = nullptr;
                    if (row < T_SEQ) { if (row >= t0) dstr = out + offp + (size_t)(row - t0) * 1024 + 512; } else if (row < T_SEQ + NSAMP) dstr = out + offs + (size_t)(row - T_SEQ) * 1024 + 512;
#pragma unroll
                    for (int bj = 0; bj < 2; ++bj)
#pragma unroll
                        for (int n = 0; n < 2; ++n) { const int vc = cbase + bj * 128 + n * 16; const f32x4 x = acc[ai][bj][m][n];
                            u32x2 w; w.x = cvt_pk_bf16(x[0], x[1]); w.y = cvt_pk_bf16(x[2], x[3]); *(u32x2*)(U + (size_t)row * NIN + vc) = w;
                            if (dstr) *(f32x4*)(dstr + ((vc - C_AV) & 511)) = x; } }
        } else {
            const int act = (pn >= 32) ? 2 : ((pn < 20 || pn == 26 || pn == 27 || pn == 30 || pn == 31) ? 1 : 0);
#pragma unroll
            for (int ai = 0; ai < 2; ++ai)
#pragma unroll
                for (int m = 0; m < 4; ++m) { const int row = rbase + ai * 128 + m * 16;
#pragma unroll
                    for (int bj = 0; bj < 2; ++bj)
#pragma unroll
                        for (int n = 0; n < 2; ++n) { const int vc = cbase + bj * 128 + n * 16; f32x4 x = acc[ai][bj][m][n];
                            if (act) {
#pragma unroll
                                for (int j = 0; j < 4; ++j) { const float s = sigm(x[j]); x[j] = (act == 1) ? x[j] * s : s; } }
                            u32x2 w; w.x = cvt_pk_bf16(x[0], x[1]); w.y = cvt_pk_bf16(x[2], x[3]); *(u32x2*)(U + (size_t)row * NIN + vc) = w; } }
        }
    }
};
struct EpiMem {
    static constexpr bool PERM = false, AFTER_DRAIN = false;
    float* O; bf16_t* B;
    __device__ __forceinline__ void operator()(const f32x4 (&acc)[2][2][4][2], const Unit& u, int wr, int wc, int fr, int fq) const {
        const int rbase = u.pm * 256 + wr * 64 + fr, cbase = u.pn * 256 + wc * 32 + 4 * fq;
#pragma unroll
        for (int ai = 0; ai < 2; ++ai)
#pragma unroll
            for (int m = 0; m < 4; ++m) { const int row = rbase + ai * 128 + m * 16;
#pragma unroll
                for (int bj = 0; bj < 2; ++bj)
#pragma unroll
                    for (int n = 0; n < 2; ++n) { const int c = cbase + bj * 128 + n * 16; const f32x4 x = acc[ai][bj][m][n];
                        *(f32x4*)(O + (size_t)row * 1024 + c) = x; u32x2 w; w.x = cvt_pk_bf16(x[0], x[1]); w.y = cvt_pk_bf16(x[2], x[3]); *(u32x2*)(B + (size_t)row * 1024 + c) = w; } }
    }
};
template <int BR> struct EpiBranch {
    static constexpr bool PERM = false, AFTER_DRAIN = false;
    const bf16_t* U; float* M32; bf16_t* MG;
    __device__ __forceinline__ void operator()(const f32x4 (&acc)[2][2][4][2], const Unit& u, int wr, int wc, int fr, int fq) const {
        const int rbase = u.pm * 256 + wr * 64 + fr, cbase = u.pn * 256 + wc * 32 + 4 * fq;
#pragma unroll
        for (int ai = 0; ai < 2; ++ai)
#pragma unroll
            for (int m = 0; m < 4; ++m) { const int row = rbase + ai * 128 + m * 16;
#pragma unroll
                for (int bj = 0; bj < 2; ++bj)
#pragma unroll
                    for (int n = 0; n < 2; ++n) { const int c = cbase + bj * 128 + n * 16; const f32x4 x = acc[ai][bj][m][n];
                        const u32x2 gw = *(const u32x2*)(U + (size_t)row * NIN + C_GA + BR * 1024 + c);
                        f32x4 v; v[0] = x[0] * bflo(gw.x); v[1] = x[1] * bfhi(gw.x); v[2] = x[2] * bflo(gw.y); v[3] = x[3] * bfhi(gw.y);
                        float* mp = M32 + (size_t)row * 1024 + c;
                        if (BR == 0) *(f32x4*)mp = v;
                        else if (BR == 1) *(f32x4*)mp = *(const f32x4*)mp + v;
                        else { v = *(const f32x4*)mp + v; u32x2 w; w.x = cvt_pk_bf16(v[0], v[1]); w.y = cvt_pk_bf16(v[2], v[3]); *(u32x2*)(MG + (size_t)row * 1024 + c) = w; } } }
    }
};
struct EpiZ {
    static constexpr bool PERM = false, AFTER_DRAIN = false;
    float* Z;
    __device__ __forceinline__ void operator()(const f32x4 (&acc)[2][2][4][2], const Unit& u, int wr, int wc, int fr, int fq) const {
        const int rbase = u.pm * 256 + wr * 64 + fr, cbase = u.pn * 256 + wc * 32 + 4 * fq;
#pragma unroll
        for (int ai = 0; ai < 2; ++ai)
#pragma unroll
            for (int m = 0; m < 4; ++m) { const int row = rbase + ai * 128 + m * 16;
#pragma unroll
                for (int bj = 0; bj < 2; ++bj)
#pragma unroll
                    for (int n = 0; n < 2; ++n) *(f32x4*)(Z + (size_t)row * 1024 + cbase + bj * 128 + n * 16) = acc[ai][bj][m][n]; }
    }
};
template <class Epi, class Sched, bool ALIGN_EPI = false, bool SP2 = false>
__device__ __forceinline__ void gemm_phase(PG8_LAS unsigned char* lds, const Gemm g, const Sched& S, const Epi& E) {
    const int tid = threadIdx.x, wid = __builtin_amdgcn_readfirstlane(tid >> 6), lane = tid & 63, wr = wid >> 2, wc = wid & 3, fr = lane & 15, fq = lane >> 4;
    const int K = g.K, nt = K / BK;
    unsigned voffA[2], voffB[2];
#pragma unroll
    for (int i = 0; i < 2; ++i) { int R, C; stage_rc(tid * 16 + i * 8192, R, C); const int Rb = Epi::PERM ? ((R & ~31) + perm32(R & 31)) : R;
        voffA[i] = (unsigned)(R * K + C) * 2u; voffB[i] = (unsigned)(Rb * K + C) * 2u; }
    const size_t kstep = (size_t)(BK * 2);
    const size_t hstep = (size_t)HALF * K * 2;
    const size_t tstep = 2 * hstep;
    const unsigned ldsw = (unsigned)wid * 1024u;
    const int aoff = lds_byte(wr * 64 + fr, fq * 8), boff = lds_byte(wc * 32 + fr, fq * 8);
#define PG8_SA(b, h) (((b) * 2 + (h)) * HTB)
#define PG8_SB(b, h) ((4 + (b) * 2 + (h)) * HTB)
#define PG8_STAGE(bufoff, gbase, voff) do { _Pragma("unroll") for (int _i = 0; _i < 2; ++_i) \
        __builtin_amdgcn_global_load_lds((const unsigned*)((const char*)(gbase) + (voff)[_i]), (PG8_LAS unsigned*)(lds + (bufoff) + ldsw + _i * 8192), 16, 0, 0); } while (0)
#define PG8_LDA(dst, b, h) do { _Pragma("unroll") for (int m = 0; m < 4; ++m) _Pragma("unroll") for (int k = 0; k < 2; ++k) dst[m][k] = *(const PG8_LAS bf16x8*)(lds + PG8_SA(b, h) + aoff + m * 2048 + k * 1024); } while (0)
#define PG8_LDB(dst, b, h) do { _Pragma("unroll") for (int n = 0; n < 2; ++n) _Pragma("unroll") for (int k = 0; k < 2; ++k) dst[n][k] = *(const PG8_LAS bf16x8*)(lds + PG8_SB(b, h) + boff + n * 2048 + k * 1024); } while (0)
#define PG8_MMA(ai, bj, At, Bt) do { __builtin_amdgcn_s_setprio(1); _Pragma("unroll") for (int m = 0; m < 4; ++m) _Pragma("unroll") for (int n = 0; n < 2; ++n) _Pragma("unroll") for (int k = 0; k < 2; ++k) \
        acc[ai][bj][m][n] = __builtin_amdgcn_mfma_f32_16x16x32_bf16(Bt[n][k], At[m][k], acc[ai][bj][m][n], 0, 0, 0); __builtin_amdgcn_s_setprio(0); } while (0)
#define PG8_WAIT_V(n) asm volatile("s_waitcnt vmcnt(" #n ")" ::: "memory")
#define PG8_WAIT_L(n) asm volatile("s_waitcnt lgkmcnt(" #n ")" ::: "memory")
#define PG8_BAR __builtin_amdgcn_s_barrier()
#define PG8_SCHED __builtin_amdgcn_sched_barrier(0)
    Unit cur, nxt; int ui = 0;
    if (!S.next(0, cur)) return;
    f32x4 acc[2][2][4][2];
#pragma unroll
    for (int a = 0; a < 2; ++a)
#pragma unroll
        for (int b = 0; b < 2; ++b)
#pragma unroll
            for (int m = 0; m < 4; ++m)
#pragma unroll
                for (int n = 0; n < 2; ++n) acc[a][b][m][n] = (f32x4){0.f, 0.f, 0.f, 0.f};
    bf16x8 At[4][2], B0[2][2], B1[2][2];
    const char* cA = (const char*)g.A + (size_t)cur.pm * tstep; const char* cB = (const char*)g.Bt + (size_t)cur.pn * tstep;
    S.a_ready(cur);
    if constexpr (SP2) {
        PG8_STAGE(PG8_SB(0, 0), cB, voffB); PG8_STAGE(PG8_SB(0, 1), cB + hstep, voffB); PG8_STAGE(PG8_SA(0, 0), cA, voffA); PG8_STAGE(PG8_SA(0, 1), cA + hstep, voffA);
        if (wr == 1) PG8_BAR;
        PG8_WAIT_V(2); PG8_BAR;
        PG8_STAGE(PG8_SB(1, 0), cB + kstep, voffB); PG8_STAGE(PG8_SA(1, 0), cA + kstep, voffA); PG8_STAGE(PG8_SB(1, 1), cB + hstep + kstep, voffB);
        PG8_WAIT_V(6); PG8_BAR;
    } else {
        PG8_STAGE(PG8_SB(0, 0), cB, voffB); PG8_STAGE(PG8_SA(0, 0), cA, voffA); PG8_STAGE(PG8_SB(0, 1), cB + hstep, voffB); PG8_STAGE(PG8_SA(0, 1), cA + hstep, voffA);
        if (wr == 1) PG8_BAR;
        PG8_WAIT_V(4); PG8_BAR;
        PG8_STAGE(PG8_SB(1, 0), cB + kstep, voffB); PG8_STAGE(PG8_SA(1, 0), cA + kstep, voffA); PG8_STAGE(PG8_SB(1, 1), cB + hstep + kstep, voffB);
        PG8_WAIT_V(6); PG8_BAR;
    }
    for (;;) {
        const bool has_next = S.next(ui + 1, nxt);
        const char* nA = has_next ? (const char*)g.A + (size_t)nxt.pm * tstep : cA; const char* nB = has_next ? (const char*)g.Bt + (size_t)nxt.pn * tstep : cB;
        for (int t = 0; t < nt; t += 2) {
            const bool last = (t == nt - 2);
            const char* a1 = cA + (size_t)(t + 1) * kstep;
            const char* a2 = last ? nA : cA + (size_t)(t + 2) * kstep; const char* b2 = last ? nB : cB + (size_t)(t + 2) * kstep;
            const char* a3 = a2 + kstep; const char* b3 = b2 + kstep;
            if (last && has_next) S.a_ready(nxt);
            if constexpr (SP2) {
            PG8_LDB(B0, 0, 0); PG8_LDB(B1, 0, 1); PG8_SCHED; PG8_LDA(At, 0, 0); PG8_STAGE(PG8_SA(1, 1), a1 + hstep, voffA);
            PG8_WAIT_V(8); PG8_WAIT_L(0); PG8_BAR; PG8_MMA(0, 0, At, B0); PG8_MMA(0, 1, At, B1); PG8_BAR; PG8_SCHED;
            PG8_LDA(At, 0, 1); PG8_STAGE(PG8_SB(0, 0), b2, voffB); PG8_STAGE(PG8_SB(0, 1), b2 + hstep, voffB); PG8_STAGE(PG8_SA(0, 0), a2, voffA);
            PG8_WAIT_V(8); PG8_WAIT_L(0); PG8_BAR; PG8_MMA(1, 0, At, B0); PG8_MMA(1, 1, At, B1); PG8_BAR; PG8_SCHED;
            PG8_LDB(B0, 1, 0); PG8_LDB(B1, 1, 1); PG8_SCHED; PG8_LDA(At, 1, 0); PG8_STAGE(PG8_SA(0, 1), a2 + hstep, voffA);
            PG8_WAIT_V(8); PG8_WAIT_L(0); PG8_BAR; PG8_MMA(0, 0, At, B0); PG8_MMA(0, 1, At, B1); PG8_BAR; PG8_SCHED;
            PG8_LDA(At, 1, 1); PG8_STAGE(PG8_SB(1, 0), b3, voffB); PG8_STAGE(PG8_SB(1, 1), b3 + hstep, voffB); PG8_STAGE(PG8_SA(1, 0), a3, voffA);
            PG8_WAIT_V(8); PG8_WAIT_L(0); PG8_BAR; PG8_MMA(1, 0, At, B0); PG8_MMA(1, 1, At, B1); PG8_BAR; PG8_SCHED;
            } else {
            PG8_LDB(B0, 0, 0); PG8_SCHED; PG8_LDA(At, 0, 0); PG8_STAGE(PG8_SA(1, 1), a1 + hstep, voffA);
            PG8_WAIT_L(8); PG8_BAR; PG8_WAIT_L(0); PG8_MMA(0, 0, At, B0); PG8_BAR; PG8_SCHED;
            PG8_LDB(B1, 0, 1); PG8_STAGE(PG8_SB(0, 0), b2, voffB);
            PG8_BAR; PG8_WAIT_L(0); PG8_MMA(0, 1, At, B1); PG8_BAR;
            PG8_LDA(At, 0, 1); PG8_STAGE(PG8_SA(0, 0), a2, voffA);
            PG8_BAR; PG8_WAIT_L(0); PG8_MMA(1, 0, At, B0); PG8_BAR; PG8_SCHED;
            PG8_STAGE(PG8_SB(0, 1), b2 + hstep, voffB);
            PG8_WAIT_V(6); PG8_BAR; PG8_MMA(1, 1, At, B1); PG8_BAR;
            PG8_LDB(B0, 1, 0); PG8_SCHED; PG8_LDA(At, 1, 0); PG8_STAGE(PG8_SA(0, 1), a2 + hstep, voffA);
            PG8_WAIT_L(8); PG8_BAR; PG8_WAIT_L(0); PG8_MMA(0, 0, At, B0); PG8_BAR; PG8_SCHED;
            PG8_LDB(B1, 1, 1); PG8_STAGE(PG8_SB(1, 0), b3, voffB);
            PG8_BAR; PG8_WAIT_L(0); PG8_MMA(0, 1, At, B1); PG8_BAR;
            PG8_LDA(At, 1, 1); PG8_STAGE(PG8_SA(1, 0), a3, voffA);
            PG8_BAR; PG8_WAIT_L(0); PG8_MMA(1, 0, At, B0); PG8_BAR; PG8_SCHED;
            PG8_STAGE(PG8_SB(1, 1), b3 + hstep, voffB);
            PG8_WAIT_V(6); PG8_BAR; PG8_MMA(1, 1, At, B1); PG8_BAR;
            }
        }
        if constexpr (ALIGN_EPI) { if (wr == 0) PG8_BAR; }
        if constexpr (!Epi::AFTER_DRAIN) { E(acc, cur, wr, wc, fr, fq); S.done(cur); }
        if (!has_next) break;
#pragma unroll
        for (int a = 0; a < 2; ++a)
#pragma unroll
            for (int b = 0; b < 2; ++b)
#pragma unroll
                for (int m = 0; m < 4; ++m)
#pragma unroll
                    for (int n = 0; n < 2; ++n) acc[a][b][m][n] = (f32x4){0.f, 0.f, 0.f, 0.f};
        cur = nxt; cA = nA; cB = nB; ++ui;
        if constexpr (ALIGN_EPI) { if (wr == 1) PG8_BAR; }
    }
    PG8_WAIT_V(0);
    if constexpr (!ALIGN_EPI) { if (wr == 0) PG8_BAR; }
    PG8_BAR;
    if constexpr (Epi::AFTER_DRAIN) { E.fused(acc, cur, wr, wc, fr, fq, lds, wid, lane); S.done(cur); }
#undef PG8_SA
#undef PG8_SB
#undef PG8_STAGE
#undef PG8_LDA
#undef PG8_LDB
#undef PG8_MMA
#undef PG8_WAIT_V
#undef PG8_WAIT_L
#undef PG8_BAR
#undef PG8_SCHED
}
}
#ifndef PG8_SP2
#define PG8_SP2 true
#endif
#ifndef PG8_ALIGN
#define PG8_ALIGN true
#endif
constexpr int RING_BYTES = 131072;
constexpr int LDSCTL_OFF = RING_BYTES, MISC_OFF = LDSCTL_OFF + 320;
constexpr int LDS_BYTES = 147456;
#define GAS __attribute__((address_space(1)))
#define LAS __attribute__((address_space(3)))
#define XB_TMO      128
#define XB_XCNT(j)  (256  + 64 * (j))
#define XB_XSUB(j)  (1280 + 64 * (j))
#define XB_XGEN(j)  (2304 + 64 * (j))
#define XB_TOP      3328
#define XB_TOPGEN   3392
#define XCD_BAR_WORDS 3456
#define XB_SPIN_CAP (1u << 18)

__device__ __forceinline__ unsigned xb_ld(unsigned* p)              { return __hip_atomic_load(p, __ATOMIC_RELAXED, __HIP_MEMORY_SCOPE_AGENT); }
__device__ __forceinline__ unsigned xb_add(unsigned* p, unsigned v) { return __hip_atomic_fetch_add(p, v, __ATOMIC_RELAXED, __HIP_MEMORY_SCOPE_AGENT); }
__device__ __forceinline__ unsigned xb_xcc_id() { return (unsigned)__builtin_amdgcn_s_getreg((3 << 11) | 20) & 0xFu; }
#define XB_SPIN(cond, bar) do { unsigned _sp = 0; while (cond) { __builtin_amdgcn_s_sleep(1); \
    if ((++_sp & 255u) == 0u) { if (xb_ld(&(bar)[XB_TMO])) break; if (_sp > XB_SPIN_CAP) { atomicAdd(&(bar)[XB_TMO], 1u); break; } } } } while (0)

struct XcdBarrier {
    unsigned* bar; unsigned x;
    volatile LAS unsigned* st;
};

__device__ __forceinline__ XcdBarrier xcd_barrier_post(unsigned* bar, volatile LAS unsigned* st) {
    XcdBarrier b; b.bar = bar; b.x = xb_xcc_id(); b.st = st;
    if (threadIdx.x == 0) (void)xb_add(&bar[XB_XCNT(b.x)], 1u);
    return b;
}
__device__ __forceinline__ void xcd_barrier_complete(unsigned* bar, unsigned x, unsigned& nloc, unsigned& nx) {
    const unsigned G = gridDim.x * gridDim.y * gridDim.z;
    unsigned sum, cnt, mine, sp = 0u;
    for (;;) {
        sum = 0u; cnt = 0u; mine = 0u;
#pragma unroll
        for (unsigned j = 0; j < 16; ++j) { const unsigned c = xb_ld(&bar[XB_XCNT(j)]); sum += c; cnt += (c > 0u) ? 1u : 0u; mine = (j == x) ? c : mine; }
        if (sum == G) break;
        __builtin_amdgcn_s_sleep(1);
        if ((++sp & 255u) == 0u) { if (xb_ld(&bar[XB_TMO])) break; if (sp > XB_SPIN_CAP) { atomicAdd(&bar[XB_TMO], 1u); break; } }
    }
    nloc = mine > 0u ? mine : 1u; nx = cnt > 0u ? cnt : 1u;
}

__device__ __forceinline__ void xcd_barrier(const XcdBarrier& b) {
    asm volatile("s_waitcnt vmcnt(0)" ::: "memory");
    __syncthreads();
    if (threadIdx.x == 0) {
        unsigned* bar = b.bar;
        __builtin_amdgcn_s_waitcnt(0);
        unsigned nloc = b.st[0], nx = b.st[1];
        if (nloc == 0u) { xcd_barrier_complete(bar, b.x, nloc, nx); b.st[0] = nloc; b.st[1] = nx; }
        const unsigned old = xb_add(&bar[XB_XSUB(b.x)], 1u);
        const unsigned gen = old / nloc;
        if (old + 1u == (gen + 1u) * nloc) {
            __builtin_amdgcn_fence(__ATOMIC_RELEASE, "agent");
            asm volatile("s_waitcnt vmcnt(0)" ::: "memory");
            const unsigned og = xb_add(&bar[XB_TOP], 1u);
            const unsigned tg = og / nx;
            if (og + 1u == (tg + 1u) * nx) xb_add(&bar[XB_TOPGEN], 1u);
            else XB_SPIN(xb_ld(&bar[XB_TOPGEN]) == tg, bar);
            __builtin_amdgcn_fence(__ATOMIC_ACQUIRE, "agent");
            xb_add(&bar[XB_XGEN(b.x)], 1u);
            asm volatile("s_waitcnt vmcnt(0)" ::: "memory");
        } else {
            XB_SPIN(xb_ld(&bar[XB_XGEN(b.x)]) == gen, bar);
            __builtin_amdgcn_fence(__ATOMIC_ACQUIRE, "agent");
            asm volatile("s_waitcnt vmcnt(0)" ::: "memory");
        }
    }
    __syncthreads();
}
typedef unsigned short bf16;
typedef unsigned v4u __attribute__((ext_vector_type(4)));
typedef unsigned v2u __attribute__((ext_vector_type(2)));
typedef float f32x4 __attribute__((ext_vector_type(4)));
typedef short bf16x8 __attribute__((ext_vector_type(8)));
typedef LAS unsigned char* ldsp;
#define LDS_WAIT() asm volatile("s_waitcnt lgkmcnt(0)" ::: "memory")
__device__ __forceinline__ unsigned f2bf(float f) { unsigned u = __builtin_bit_cast(unsigned, f); return (u + 0x7fffu + ((u >> 16) & 1u)) >> 16; }
__device__ __forceinline__ unsigned pk2(float lo, float hi) { return f2bf(lo) | (f2bf(hi) << 16); }
__device__ __forceinline__ float blo(unsigned w) { return __uint_as_float(w << 16); }
__device__ __forceinline__ float bhi(unsigned w) { return __uint_as_float(w & 0xffff0000u); }
__device__ __forceinline__ float b2f(bf16 b) { return __uint_as_float(((unsigned)b) << 16); }
__device__ __forceinline__ float sigmoid_f(float x) { return 1.0f / (1.0f + __expf(-x)); }
__device__ __forceinline__ float wave_sum(float v) {
#pragma unroll
    for (int o = 1; o < 64; o <<= 1) v += __shfl_xor(v, o);
    return v;
}
#define MFMA16(a, b, c) __builtin_amdgcn_mfma_f32_16x16x32_bf16((a), (b), (c), 0, 0, 0)

struct Args {
    const float *xp, *xs, *memp, *c128, *c512, *c2048, *sth, *cmem, *npre, *npost, *win, *lbl, *hgn, *mnorm, *wmem, *wpa, *wpb, *wpc, *wout;
    float* out; unsigned char* ws;
};

__device__ __forceinline__ int win_vrow(int n) { if (n < 3072) { const int d = n & 63; return (n & ~63) + (((d & 31) << 1) | (d >> 5)); } return n; }
__device__ __forceinline__ void transpose_item(const float* W, int K, int N, bf16* WT, bool rope, LAS float* scr, int item, int lane) {
    const int nblk = N / 32, kb = item / nblk, nb = item % nblk, k0 = 64 * kb, n0 = 32 * nb;
#pragma unroll 8
    for (int i = 0; i < 32; ++i) { const int kk = 2 * i + (lane >> 5); scr[kk * 33 + (lane & 31)] = W[(size_t)(k0 + kk) * N + n0 + (lane & 31)]; }
    LDS_WAIT(); asm volatile("" ::: "memory");
    const int c = lane & 7;
#pragma unroll
    for (int j = 0; j < 4; ++j) { const int n = (lane >> 3) + 8 * j; const LAS float* s = scr + (8 * c) * 33 + n;
        v4u o; o.x = pk2(s[0 * 33], s[1 * 33]); o.y = pk2(s[2 * 33], s[3 * 33]); o.z = pk2(s[4 * 33], s[5 * 33]); o.w = pk2(s[6 * 33], s[7 * 33]);
        const int dr = rope ? win_vrow(n0 + n) : (n0 + n);
        *(v4u*)(WT + (size_t)dr * K + k0 + 8 * c) = o; }
    LDS_WAIT(); asm volatile("" ::: "memory");
}
__device__ __forceinline__ void rms_row_to_bf16(const float* xrow, const float* g, bf16* orow, int lane) {
    const f32x4* xr = (const f32x4*)xrow + lane; const f32x4* gr = (const f32x4*)g + lane;
    f32x4 v[4]; float s = 0.f;
#pragma unroll
    for (int j = 0; j < 4; ++j) { v[j] = xr[64 * j]; s += (v[j].x * v[j].x + v[j].y * v[j].y) + (v[j].z * v[j].z + v[j].w * v[j].w); }
    const float rstd = rsqrtf(wave_sum(s) * (1.f / 1024.f) + EPS);
    v2u* o8 = (v2u*)orow + lane;
#pragma unroll
    for (int j = 0; j < 4; ++j) { const f32x4 gv = gr[64 * j]; v2u w; w.x = pk2(v[j].x * rstd * gv.x, v[j].y * rstd * gv.y); w.y = pk2(v[j].z * rstd * gv.z, v[j].w * rstd * gv.w); o8[64 * j] = w; }
}
__device__ __forceinline__ void sincos_entry(int pos, int i, float& c, float& s) {
    const float invf[32] = {1.000000000e+00f, 7.498942018e-01f, 5.623413324e-01f, 4.216965139e-01f, 3.162277639e-01f, 2.371373773e-01f, 1.778279394e-01f, 1.333521456e-01f, 1.000000015e-01f, 7.498942316e-02f, 5.623413250e-02f, 4.216964915e-02f, 3.162277490e-02f, 2.371373773e-02f, 1.778279431e-02f, 1.333521400e-02f, 9.999999776e-03f, 7.498942316e-03f, 5.623413250e-03f, 4.216964822e-03f, 3.162277630e-03f, 2.371373819e-03f, 1.778279431e-03f, 1.333521446e-03f, 1.000000047e-03f, 7.498941850e-04f, 5.623413017e-04f, 4.216965172e-04f, 3.162277571e-04f, 2.371373703e-04f, 1.778279402e-04f, 1.333521504e-04f};
    const float ang = (float)pos * invf[i];
    const double x = (double)ang, kq = rint(x * 0.63661977236758134308);
    double r = fma(-kq, 1.57079632679489655800, x); r = fma(-kq, 6.12323399573676603587e-17, r);
    const float rf = (float)r, r2 = rf * rf; const int q = ((int)kq) & 3;
    const float sp = rf + rf * r2 * (-1.6666654611e-1f + r2 * (8.3321608736e-3f + r2 * (-1.9515295891e-4f)));
    const float cp = 1.0f - 0.5f * r2 + r2 * r2 * (4.166664568298827e-2f + r2 * (-1.388731625493765e-3f + r2 * 2.443315711809948e-5f));
    c = (q == 0) ? cp : (q == 1 ? -sp : (q == 2 ? -cp : sp));
    s = (q == 0) ? sp : (q == 1 ? cp : (q == 2 ? -sp : -cp));
}
__device__ __forceinline__ void p0_prologue(const Args& A, ldsp lds, int tid, int G) {
    const int lane = tid & 63, wave = tid >> 6;
    unsigned char* ws = A.ws;
    LAS float* scr = (LAS float*)(lds + wave * 16384);
    const int gw = blockIdx.x * 8 + wave, NGW = G * 8;
    constexpr int I_IN = 16 * 352, I_MEM = 16 * 32, I_BR = 8 * 32, I_OUT = 16 * 32, NITEMS = I_IN + I_MEM + 3 * I_BR + I_OUT;
    for (int it = gw; it < NITEMS; it += NGW) {
        int r = it;
        if (r < I_IN) { transpose_item(A.win, 1024, NIN, (bf16*)(ws + WS_WIN), true, scr, r, lane); continue; } r -= I_IN;
        if (r < I_MEM) { transpose_item(A.wmem, 1024, 1024, (bf16*)(ws + WS_WMEM), false, scr, r, lane); continue; } r -= I_MEM;
        if (r < I_BR) { transpose_item(A.wpa, 512, 1024, (bf16*)(ws + WS_WPA), false, scr, r, lane); continue; } r -= I_BR;
        if (r < I_BR) { transpose_item(A.wpb, 512, 1024, (bf16*)(ws + WS_WPB), false, scr, r, lane); continue; } r -= I_BR;
        if (r < I_BR) { transpose_item(A.wpc, 512, 1024, (bf16*)(ws + WS_WPC), false, scr, r, lane); continue; } r -= I_BR;
        transpose_item(A.wout, 1024, 1024, (bf16*)(ws + WS_WOUT), false, scr, r, lane);
    }
    bf16* XN = (bf16*)(ws + WS_XN); bf16* MN = (bf16*)(ws + WS_MN);
    for (int m = gw; m < T_SEQ + NSAMP + 256; m += NGW) {
        if (m < T_SEQ) rms_row_to_bf16(A.xp + (size_t)m * 1024, A.npre, XN + (size_t)m * 1024, lane);
        else if (m < T_SEQ + NSAMP) rms_row_to_bf16(A.xs + (size_t)(m - T_SEQ) * 1024, A.npre, XN + (size_t)m * 1024, lane);
        else rms_row_to_bf16(A.memp + (size_t)(m - T_SEQ - NSAMP) * 1024, A.mnorm, MN + (size_t)(m - T_SEQ - NSAMP) * 1024, lane);
    }
    float* cs = (float*)(ws + WS_CS);
    for (int e = blockIdx.x * 512 + tid; e < T_SEQ * 32; e += G * 512) { float c, s; sincos_entry(e >> 5, e & 31, c, s); *(float2*)(cs + (size_t)e * 2) = make_float2(c, s); }
}

constexpr int VT_STRIDE = 276;
__device__ __forceinline__ void attn_dil_unit(ldsp lds, const bf16* U, bf16* OG, float* LSE, int g, int dil, int r, int nb, int h, int tid) {
    const int lane = tid & 63, w = __builtin_amdgcn_readfirstlane(tid >> 6), l15 = lane & 15, q4 = lane >> 4;
    LAS bf16* VT = (LAS bf16*)lds;
    const int colq = C_AQ + g * 512 + h * 64, colk = C_AK + g * 512 + h * 64, colv = C_AV + g * 512 + h * 64;
    __syncthreads();
#pragma unroll
    for (int it = 0; it < 4; ++it) { const int key = (tid >> 3) + 64 * it, d8 = (tid & 7) * 8, kp = (nb - 1) * 128 + key;
        bf16x8 v = (bf16x8){0, 0, 0, 0, 0, 0, 0, 0};
        if (kp >= 0) v = *(const bf16x8*)(U + (size_t)(kp * dil + r) * NIN + colv + d8);
#pragma unroll
        for (int j = 0; j < 8; ++j) VT[(d8 + j) * VT_STRIDE + key] = (bf16)v[j]; }
    for (int e = tid; e < 64 * 20; e += 512) VT[(e / 20) * VT_STRIDE + 256 + (e % 20)] = 0;
    __syncthreads();
    const int tq = (nb * 128 + w * 16 + l15) * dil + r;
    bf16x8 qf[2];
#pragma unroll
    for (int kk = 0; kk < 2; ++kk) qf[kk] = *(const bf16x8*)(U + (size_t)tq * NIN + colq + 32 * kk + 8 * q4);
    f32x4 s[9];
#pragma unroll
    for (int kt = 0; kt < 9; ++kt) { int kp = (nb - 1) * 128 + 16 * w + 16 * kt + l15; kp = kp < 0 ? 0 : kp;
        const bf16* kr = U + (size_t)(kp * dil + r) * NIN + colk + 8 * q4;
        f32x4 a = (f32x4){0.f, 0.f, 0.f, 0.f};
#pragma unroll
        for (int kk = 0; kk < 2; ++kk) a = MFMA16(*(const bf16x8*)(kr + 32 * kk), qf[kk], a);
        s[kt] = a; }
    float m = -1e30f;
#pragma unroll
    for (int kt = 0; kt < 9; ++kt)
#pragma unroll
        for (int j = 0; j < 4; ++j) { const int klr = 16 * kt + 4 * q4 + j, dist = l15 + 128 - klr;
            const bool ok = dist >= 0 && dist <= 128 && (nb > 0 || (16 * w + klr) >= 128);
            s[kt][j] = ok ? s[kt][j] : -1e30f; m = fmaxf(m, s[kt][j]); }
    m = fmaxf(m, __shfl_xor(m, 16)); m = fmaxf(m, __shfl_xor(m, 32));
    float l = 0.f;
#pragma unroll
    for (int kt = 0; kt < 9; ++kt)
#pragma unroll
        for (int j = 0; j < 4; ++j) { const float p = __expf(s[kt][j] - m); s[kt][j] = p; l += p; }
    l += __shfl_xor(l, 16); l += __shfl_xor(l, 32);
    f32x4 o[4];
#pragma unroll
    for (int dt = 0; dt < 4; ++dt) o[dt] = (f32x4){0.f, 0.f, 0.f, 0.f};
#pragma unroll
    for (int ks = 0; ks < 5; ++ks) {
        v4u pw; pw.x = pk2(s[2 * ks][0], s[2 * ks][1]); pw.y = pk2(s[2 * ks][2], s[2 * ks][3]);
        if (ks < 4) { pw.z = pk2(s[2 * ks + 1][0], s[2 * ks + 1][1]); pw.w = pk2(s[2 * ks + 1][2], s[2 * ks + 1][3]); } else { pw.z = 0u; pw.w = 0u; }
        const bf16x8 pf = __builtin_bit_cast(bf16x8, pw);
#pragma unroll
        for (int dt = 0; dt < 4; ++dt) { const LAS bf16* vp = VT + (16 * dt + l15) * VT_STRIDE + 16 * w + 32 * ks + 4 * q4;
            const v2u lo = *(const LAS v2u*)vp, hi = *(const LAS v2u*)(vp + 16);
            v4u vw; vw.x = lo.x; vw.y = lo.y; vw.z = hi.x; vw.w = hi.y;
            o[dt] = MFMA16(__builtin_bit_cast(bf16x8, vw), pf, o[dt]); } }
    const float inv = 1.0f / l;
    bf16* op = OG + ((size_t)g * MROWS + tq) * 512 + h * 64 + 4 * q4;
#pragma unroll
    for (int dt = 0; dt < 4; ++dt) { v2u wv; wv.x = pk2(o[dt][0] * inv, o[dt][1] * inv); wv.y = pk2(o[dt][2] * inv, o[dt][3] * inv); *(v2u*)(op + 16 * dt) = wv; }
    if (q4 == 0) LSE[((size_t)g * MROWS + tq) * 8 + h] = m + __logf(l);
}
__device__ __forceinline__ void xattn_unit(ldsp lds, const bf16* U, const bf16* MKV, bf16* YC, int tile, int h, int tid) {
    const int lane = tid & 63, w = __builtin_amdgcn_readfirstlane(tid >> 6), l15 = lane & 15, q4 = lane >> 4;
    LAS bf16* VT = (LAS bf16*)lds;
    __syncthreads();
#pragma unroll
    for (int it = 0; it < 8; ++it) { const int key = (tid >> 4) + 32 * it, d8 = (tid & 15) * 8;
        const bf16x8 v = *(const bf16x8*)(MKV + (size_t)key * 1024 + 512 + h * 128 + d8);
#pragma unroll
        for (int j = 0; j < 8; ++j) VT[(d8 + j) * VT_STRIDE + key] = (bf16)v[j]; }
    __syncthreads();
    const int row = tile * 128 + w * 16 + l15;
    bf16x8 qf[4];
#pragma unroll
    for (int kk = 0; kk < 4; ++kk) qf[kk] = *(const bf16x8*)(U + (size_t)row * NIN + C_CQ + h * 128 + 32 * kk + 8 * q4);
    f32x4 s[16];
#pragma unroll
    for (int kt = 0; kt < 16; ++kt) { const bf16* kr = MKV + (size_t)(16 * kt + l15) * 1024 + h * 128 + 8 * q4;
        f32x4 a = (f32x4){0.f, 0.f, 0.f, 0.f};
#pragma unroll
        for (int kk = 0; kk < 4; ++kk) a = MFMA16(*(const bf16x8*)(kr + 32 * kk), qf[kk], a);
        s[kt] = a * 0.08838834764831845f; }
    float m = -1e30f;
#pragma unroll
    for (int kt = 0; kt < 16; ++kt)
#pragma unroll
        for (int j = 0; j < 4; ++j) m = fmaxf(m, s[kt][j]);
    m = fmaxf(m, __shfl_xor(m, 16)); m = fmaxf(m, __shfl_xor(m, 32));
    float l = 0.f;
#pragma unroll
    for (int kt = 0; kt < 16; ++kt)
#pragma unroll
        for (int j = 0; j < 4; ++j) { const float p = __expf(s[kt][j] - m); s[kt][j] = p; l += p; }
    l += __shfl_xor(l, 16); l += __shfl_xor(l, 32);
    f32x4 o[8];
#pragma unroll
    for (int dt = 0; dt < 8; ++dt) o[dt] = (f32x4){0.f, 0.f, 0.f, 0.f};
#pragma unroll
    for (int ks = 0; ks < 8; ++ks) {
        v4u pw; pw.x = pk2(s[2 * ks][0], s[2 * ks][1]); pw.y = pk2(s[2 * ks][2], s[2 * ks][3]); pw.z = pk2(s[2 * ks + 1][0], s[2 * ks + 1][1]); pw.w = pk2(s[2 * ks + 1][2], s[2 * ks + 1][3]);
        const bf16x8 pf = __builtin_bit_cast(bf16x8, pw);
#pragma unroll
        for (int dt = 0; dt < 8; ++dt) { const LAS bf16* vp = VT + (16 * dt + l15) * VT_STRIDE + 32 * ks + 4 * q4;
            const v2u lo = *(const LAS v2u*)vp, hi = *(const LAS v2u*)(vp + 16);
            v4u vw; vw.x = lo.x; vw.y = lo.y; vw.z = hi.x; vw.w = hi.y;
            o[dt] = MFMA16(__builtin_bit_cast(bf16x8, vw), pf, o[dt]); } }
    const float inv = 1.0f / l;
    const bf16* zp = U + (size_t)row * NIN + C_CZ + h * 128 + 4 * q4; bf16* op = YC + (size_t)row * 512 + h * 128 + 4 * q4;
#pragma unroll
    for (int dt = 0; dt < 8; ++dt) { const v2u z = *(const v2u*)(zp + 16 * dt); v2u wv;
        wv.x = pk2(o[dt][0] * inv * blo(z.x), o[dt][1] * inv * bhi(z.x)); wv.y = pk2(o[dt][2] * inv * blo(z.y), o[dt][3] * inv * bhi(z.y)); *(v2u*)(op + 16 * dt) = wv; }
}
__device__ __forceinline__ float lb_of(const float* lbl, int c) { return 1.0f / (1.0f + __expf(lbl[512 + c] - lbl[c])); }
__device__ __forceinline__ void hgrn_pass1_unit(ldsp lds, const bf16* U, const float* lbl, float* HU, float* HP, int h, int j, int tid) {
    LAS float* fb = (LAS float*)lds; LAS float* kb = fb + 32 * 128; LAS float* vb = kb + 32 * 128;
    const int v = tid & 127, kq = __builtin_amdgcn_readfirstlane(tid >> 7), tok = tid >> 4, c8 = (tid & 15) * 8;
    float s[32], lbr[8];
#pragma unroll
    for (int i = 0; i < 32; ++i) s[i] = 0.f;
#pragma unroll
    for (int e = 0; e < 8; ++e) lbr[e] = lb_of(lbl, h * 128 + c8 + e);
    float pacc = 1.f;
    for (int ch = 0; ch < 8; ++ch) {
        __syncthreads();
        { const size_t ro = (size_t)(j * 256 + ch * 32 + tok) * NIN + h * 128 + c8;
          const v4u fw = *(const v4u*)(U + ro + C_BF), vw = *(const v4u*)(U + ro + C_BI);
          const unsigned fa[4] = {fw.x, fw.y, fw.z, fw.w}, va[4] = {vw.x, vw.y, vw.z, vw.w};
#pragma unroll
          for (int e = 0; e < 4; ++e) { const float x0 = blo(fa[e]), x1 = bhi(fa[e]);
              const float f0 = lbr[2 * e] + (1.f - lbr[2 * e]) * sigmoid_f(x0), f1 = lbr[2 * e + 1] + (1.f - lbr[2 * e + 1]) * sigmoid_f(x1);
              const int o = tok * 128 + c8 + 2 * e;
              fb[o] = f0; fb[o + 1] = f1; kb[o] = 1.f - f0; kb[o + 1] = 1.f - f1; vb[o] = blo(va[e]); vb[o + 1] = bhi(va[e]); } }
        __syncthreads();
        for (int tt = 0; tt < 32; ++tt) { const float vv = vb[tt * 128 + v]; const LAS f32x4* f4 = (const LAS f32x4*)(fb + tt * 128 + kq * 32); const LAS f32x4* k4 = (const LAS f32x4*)(kb + tt * 128 + kq * 32);
#pragma unroll
            for (int i4 = 0; i4 < 8; ++i4) { const f32x4 f = f4[i4], k = k4[i4];
#pragma unroll
                for (int e = 0; e < 4; ++e) s[4 * i4 + e] = f[e] * s[4 * i4 + e] + k[e] * vv; } }
        if (tid < 128) { for (int tt = 0; tt < 32; ++tt) pacc *= fb[tt * 128 + tid]; }
    }
    float* up = HU + ((size_t)(j * 4 + h) * 128 + kq * 32) * 128 + v;
#pragma unroll
    for (int i = 0; i < 32; ++i) up[(size_t)i * 128] = s[i];
    if (tid < 128) HP[(size_t)(j * 4 + h) * 128 + tid] = pacc;
}
__device__ __forceinline__ void hgrn_scan_unit(const float* HU, const float* HP, float* HS, float* outS, int e, int tid) {
    const int idx = e * 512 + tid, h = idx >> 14, k = (idx >> 7) & 127, vk = idx & 16383;
    float S = 0.f;
    for (int j = 0; j < 64; ++j) { const size_t o = (size_t)(j * 4 + h) * 16384 + vk; HS[o] = S; S = HP[(size_t)(j * 4 + h) * 128 + k] * S + HU[o]; }
    outS[idx] = S;
}
__device__ __forceinline__ void hgrn_pass3_unit(ldsp lds, const bf16* U, const float* lbl, const float* hgn, const float* HS, bf16* YB, int h, int j, int tid) {
    LAS float* fb = (LAS float*)lds; LAS float* kb = fb + 32 * 128; LAS float* vb = kb + 32 * 128; LAS float* qb = vb + 32 * 128; LAS float* ob = qb + 32 * 128;
    const int lane = tid & 63, wv = tid >> 6, v = tid & 127, kq = __builtin_amdgcn_readfirstlane(tid >> 7), tok = tid >> 4, c8 = (tid & 15) * 8;
    float s[32], lbr[8];
    { const float* sp = HS + ((size_t)(j * 4 + h) * 128 + kq * 32) * 128 + v;
#pragma unroll
      for (int i = 0; i < 32; ++i) s[i] = sp[(size_t)i * 128]; }
#pragma unroll
    for (int e = 0; e < 8; ++e) lbr[e] = lb_of(lbl, h * 128 + c8 + e);
    const float g0 = hgn[h * 128 + lane], g1 = hgn[h * 128 + 64 + lane];
    for (int ch = 0; ch < 8; ++ch) {
        __syncthreads();
        { const size_t ro = (size_t)(j * 256 + ch * 32 + tok) * NIN + h * 128 + c8;
          const v4u fw = *(const v4u*)(U + ro + C_BF), vw = *(const v4u*)(U + ro + C_BI), qw = *(const v4u*)(U + ro + C_BQ);
          const unsigned fa[4] = {fw.x, fw.y, fw.z, fw.w}, va[4] = {vw.x, vw.y, vw.z, vw.w}, qa[4] = {qw.x, qw.y, qw.z, qw.w};
#pragma unroll
          for (int e = 0; e < 4; ++e) { const float x0 = blo(fa[e]), x1 = bhi(fa[e]);
              const float f0 = lbr[2 * e] + (1.f - lbr[2 * e]) * sigmoid_f(x0), f1 = lbr[2 * e + 1] + (1.f - lbr[2 * e + 1]) * sigmoid_f(x1);
              const int o = tok * 128 + c8 + 2 * e;
              fb[o] = f0; fb[o + 1] = f1; kb[o] = 1.f - f0; kb[o + 1] = 1.f - f1; vb[o] = blo(va[e]); vb[o + 1] = bhi(va[e]); qb[o] = blo(qa[e]); qb[o + 1] = bhi(qa[e]); } }
        __syncthreads();
        for (int tt = 0; tt < 32; ++tt) { const float vv = vb[tt * 128 + v]; const LAS f32x4* f4 = (const LAS f32x4*)(fb + tt * 128 + kq * 32); const LAS f32x4* k4 = (const LAS f32x4*)(kb + tt * 128 + kq * 32); const LAS f32x4* q4p = (const LAS f32x4*)(qb + tt * 128 + kq * 32);
            float acc = 0.f;
#pragma unroll
            for (int i4 = 0; i4 < 8; ++i4) { const f32x4 f = f4[i4], k = k4[i4], q = q4p[i4];
#pragma unroll
                for (int e = 0; e < 4; ++e) { s[4 * i4 + e] = f[e] * s[4 * i4 + e] + k[e] * vv; acc += s[4 * i4 + e] * q[e]; } }
            ob[(tt * 4 + kq) * 128 + v] = acc; }
        __syncthreads();
#pragma unroll
        for (int q = 0; q < 4; ++q) { const int tt = wv * 4 + q; const LAS float* op = ob + tt * 512;
            const float o0 = (op[lane] + op[128 + lane]) + (op[256 + lane] + op[384 + lane]), o1 = (op[64 + lane] + op[192 + lane]) + (op[320 + lane] + op[448 + lane]);
            const float rstd = rsqrtf(wave_sum(o0 * o0 + o1 * o1) * (1.f / 128.f) + EPS);
            const size_t t = (size_t)(j * 256 + ch * 32 + tt);
            const bf16* zp = U + t * NIN + C_BZ + h * 128; bf16* yp = YB + t * 512 + h * 128;
            yp[lane] = (bf16)f2bf(o0 * rstd * g0 * b2f(zp[lane])); yp[64 + lane] = (bf16)f2bf(o1 * rstd * g1 * b2f(zp[64 + lane])); }
    }
}
__device__ __forceinline__ void attn_merge_row(const bf16* U, const bf16* OG, const float* LSE, bf16* YA, int t, int lane) {
    const int hd = lane >> 3, c8 = lane * 8;
    const float l0 = LSE[((size_t)0 * MROWS + t) * 8 + hd], l1 = LSE[((size_t)1 * MROWS + t) * 8 + hd], l2 = LSE[((size_t)2 * MROWS + t) * 8 + hd];
    const float mx = fmaxf(l0, fmaxf(l1, l2)); float w0 = __expf(l0 - mx), w1 = __expf(l1 - mx), w2 = __expf(l2 - mx); const float inv = 1.f / (w0 + w1 + w2); w0 *= inv; w1 *= inv; w2 *= inv;
    const v4u a = *(const v4u*)(OG + ((size_t)0 * MROWS + t) * 512 + c8), b = *(const v4u*)(OG + ((size_t)1 * MROWS + t) * 512 + c8), c = *(const v4u*)(OG + ((size_t)2 * MROWS + t) * 512 + c8);
    const v4u z = *(const v4u*)(U + (size_t)t * NIN + C_AZ + c8);
    const unsigned aa[4] = {a.x, a.y, a.z, a.w}, ba[4] = {b.x, b.y, b.z, b.w}, ca[4] = {c.x, c.y, c.z, c.w}, za[4] = {z.x, z.y, z.z, z.w}; unsigned oa[4];
#pragma unroll
    for (int e = 0; e < 4; ++e) oa[e] = pk2((w0 * blo(aa[e]) + w1 * blo(ba[e]) + w2 * blo(ca[e])) * blo(za[e]), (w0 * bhi(aa[e]) + w1 * bhi(ba[e]) + w2 * bhi(ca[e])) * bhi(za[e]));
    v4u o; o.x = oa[0]; o.y = oa[1]; o.z = oa[2]; o.w = oa[3]; *(v4u*)(YA + (size_t)t * 512 + c8) = o;
}
__device__ __forceinline__ void samp_attn_unit(const Args& A, const bf16* U, bf16* YA, int b, int tid) {
    const int lane = tid & 63, h = tid >> 6, ks = lane >> 4, dp = lane & 15; const size_t row = T_SEQ + b; const bf16* ur = U + row * NIN;
    float m = -1e30f, l = 0.f; f32x4 acc = (f32x4){0.f, 0.f, 0.f, 0.f};
#pragma unroll
    for (int g = 0; g < 3; ++g) { const int dil = (g == 0) ? 1 : (g == 1 ? 4 : 16), Wb = 128 * dil; const float* cache = ((g == 0) ? A.c128 : (g == 1 ? A.c512 : A.c2048)) + (size_t)b * Wb * 1024 + h * 64 + 4 * dp;
        const v2u qw = *(const v2u*)(ur + C_AQ + g * 512 + h * 64 + 4 * dp); const f32x4 q = (f32x4){blo(qw.x), bhi(qw.x), blo(qw.y), bhi(qw.y)};
        if (ks == 0) { const v2u kw = *(const v2u*)(ur + C_AK + g * 512 + h * 64 + 4 * dp), vw = *(const v2u*)(ur + C_AV + g * 512 + h * 64 + 4 * dp);
            float sc = q[0] * blo(kw.x) + q[1] * bhi(kw.x) + q[2] * blo(kw.y) + q[3] * bhi(kw.y);
            sc += __shfl_xor(sc, 1); sc += __shfl_xor(sc, 2); sc += __shfl_xor(sc, 4); sc += __shfl_xor(sc, 8);
            const float mn = fmaxf(m, sc), corr = __expf(m - mn), pe = __expf(sc - mn); l = l * corr + pe;
            acc = acc * corr + pe * (f32x4){blo(vw.x), bhi(vw.x), blo(vw.y), bhi(vw.y)}; m = mn; }
#pragma unroll 4
        for (int it = 0; it < 32; ++it) { const int jj = 1 + ks + 4 * it, idx = Wb - dil * jj; const float* kp = cache + (size_t)idx * 1024;
            const f32x4 k4 = *(const f32x4*)kp, v4 = *(const f32x4*)(kp + 512);
            float sc = (q[0] * k4[0] + q[1] * k4[1]) + (q[2] * k4[2] + q[3] * k4[3]);
            sc += __shfl_xor(sc, 1); sc += __shfl_xor(sc, 2); sc += __shfl_xor(sc, 4); sc += __shfl_xor(sc, 8);
            const float mn = fmaxf(m, sc), corr = __expf(m - mn), pe = __expf(sc - mn); l = l * corr + pe; acc = acc * corr + pe * v4; m = mn; } }
    float ma = fmaxf(m, __shfl_xor(m, 16)); ma = fmaxf(ma, __shfl_xor(ma, 32));
    const float sc = __expf(m - ma); l *= sc; acc = acc * sc;
    l += __shfl_xor(l, 16); l += __shfl_xor(l, 32);
#pragma unroll
    for (int e = 0; e < 4; ++e) { acc[e] += __shfl_xor(acc[e], 16); acc[e] += __shfl_xor(acc[e], 32); }
    if (ks == 0) { const float inv = 1.f / l; const v2u z = *(const v2u*)(ur + C_AZ + h * 64 + 4 * dp); v2u o;
        o.x = pk2(acc[0] * inv * blo(z.x), acc[1] * inv * bhi(z.x)); o.y = pk2(acc[2] * inv * blo(z.y), acc[3] * inv * bhi(z.y)); *(v2u*)(YA + row * 512 + h * 64 + 4 * dp) = o; }
}
__device__ __forceinline__ void samp_hgrn_unit(ldsp lds, const Args& A, const bf16* U, bf16* YB, int b, int h, int tid) {
    LAS float* fb = (LAS float*)lds; LAS float* kb = fb + 128; LAS float* qb = kb + 128; LAS float* red = qb + 128;
    const size_t row = T_SEQ + b; const bf16* ur = U + row * NIN;
    __syncthreads();
    if (tid < 128) { const float lb = lb_of(A.lbl, h * 128 + tid), f = lb + (1.f - lb) * sigmoid_f(b2f(ur[C_BF + h * 128 + tid])); fb[tid] = f; kb[tid] = 1.f - f; qb[tid] = b2f(ur[C_BQ + h * 128 + tid]); }
    __syncthreads();
    const int v4i = (tid & 31) * 4, kk = tid >> 5;
    const v2u vw = *(const v2u*)(ur + C_BI + h * 128 + v4i); const f32x4 vv = (f32x4){blo(vw.x), bhi(vw.x), blo(vw.y), bhi(vw.y)};
    const float* sp = A.sth + (size_t)(b * 4 + h) * 16384; float* dp = A.out + O_HGS + (size_t)(b * 4 + h) * 16384;
    f32x4 oacc = (f32x4){0.f, 0.f, 0.f, 0.f};
#pragma unroll
    for (int p = 0; p < 8; ++p) { const int k = kk + 16 * p; const f32x4 S = *(const f32x4*)(sp + k * 128 + v4i); const f32x4 Sn = fb[k] * S + kb[k] * vv; *(f32x4*)(dp + k * 128 + v4i) = Sn; oacc += Sn * qb[k]; }
    *(LAS f32x4*)(red + kk * 128 + v4i) = oacc;
    __syncthreads();
    if (tid < 64) { float o0 = 0.f, o1 = 0.f;
#pragma unroll
        for (int q = 0; q < 16; ++q) { o0 += red[q * 128 + tid]; o1 += red[q * 128 + 64 + tid]; }
        const float rstd = rsqrtf(wave_sum(o0 * o0 + o1 * o1) * (1.f / 128.f) + EPS);
        bf16* yp = YB + row * 512 + h * 128;
        yp[tid] = (bf16)f2bf(o0 * rstd * A.hgn[h * 128 + tid] * b2f(ur[C_BZ + h * 128 + tid])); yp[64 + tid] = (bf16)f2bf(o1 * rstd * A.hgn[h * 128 + 64 + tid] * b2f(ur[C_BZ + h * 128 + 64 + tid])); }
}
__device__ __forceinline__ void samp_xattn_unit(ldsp lds, const Args& A, const bf16* U, bf16* YC, int b, int h, int tid) {
    LAS float* part = (LAS float*)lds;
    const int lane = tid & 63, w = tid >> 6, sub = lane >> 5, dp = lane & 31; const size_t row = T_SEQ + b; const bf16* ur = U + row * NIN;
    const v2u qw = *(const v2u*)(ur + C_CQ + h * 128 + 4 * dp); const f32x4 q = (f32x4){blo(qw.x), bhi(qw.x), blo(qw.y), bhi(qw.y)} * 0.08838834764831845f;
    const float* mem = A.cmem + (size_t)b * 256 * 1024 + h * 128 + 4 * dp;
    float m = -1e30f, l = 0.f; f32x4 acc = (f32x4){0.f, 0.f, 0.f, 0.f};
#pragma unroll 4
    for (int it = 0; it < 16; ++it) { const float* kp = mem + (size_t)(32 * w + 2 * it + sub) * 1024; const f32x4 k4 = *(const f32x4*)kp, v4 = *(const f32x4*)(kp + 512);
        float sc = (q[0] * k4[0] + q[1] * k4[1]) + (q[2] * k4[2] + q[3] * k4[3]);
        sc += __shfl_xor(sc, 1); sc += __shfl_xor(sc, 2); sc += __shfl_xor(sc, 4); sc += __shfl_xor(sc, 8); sc += __shfl_xor(sc, 16);
        const float mn = fmaxf(m, sc), corr = __expf(m - mn), pe = __expf(sc - mn); l = l * corr + pe; acc = acc * corr + pe * v4; m = mn; }
    const float ma = fmaxf(m, __shfl_xor(m, 32)); const float sc = __expf(m - ma); l *= sc; acc = acc * sc; l += __shfl_xor(l, 32);
#pragma unroll
    for (int e = 0; e < 4; ++e) acc[e] += __shfl_xor(acc[e], 32);
    __syncthreads();
    if (sub == 0) { *(LAS f32x4*)(part + w * 132 + 4 * dp) = acc; if (dp == 0) { part[w * 132 + 128] = ma; part[w * 132 + 129] = l; } }
    __syncthreads();
    if (tid < 128) { float M = -1e30f;
#pragma unroll
        for (int q8 = 0; q8 < 8; ++q8) M = fmaxf(M, part[q8 * 132 + 128]);
        float L = 0.f, O = 0.f;
#pragma unroll
        for (int q8 = 0; q8 < 8; ++q8) { const float e = __expf(part[q8 * 132 + 128] - M); L += part[q8 * 132 + 129] * e; O += part[q8 * 132 + tid] * e; }
        YC[row * 512 + h * 128 + tid] = (bf16)f2bf(O / L * b2f(ur[C_CZ + h * 128 + tid])); }
}
__device__ __forceinline__ void final_row(const float* z, const float* hrow, const float* g, float* yrow, int lane) {
    const f32x4* zr = (const f32x4*)z + lane; const f32x4* hr = (const f32x4*)hrow + lane; const f32x4* gr = (const f32x4*)g + lane; f32x4* yr = (f32x4*)yrow + lane;
    f32x4 v[4]; float s = 0.f;
#pragma unroll
    for (int j = 0; j < 4; ++j) { v[j] = zr[64 * j]; s += (v[j].x * v[j].x + v[j].y * v[j].y) + (v[j].z * v[j].z + v[j].w * v[j].w); }
    const float rstd = rsqrtf(wave_sum(s) * (1.f / 1024.f) + EPS);
#pragma unroll
    for (int j = 0; j < 4; ++j) yr[64 * j] = hr[64 * j] + v[j] * rstd * gr[64 * j];
}
__global__ void __launch_bounds__(512, 2) fwd_kernel(Args A) {
    extern __shared__ __attribute__((aligned(16))) unsigned char lds_raw[];
    ldsp lds = (ldsp)lds_raw;
    volatile LAS unsigned* MISC = (volatile LAS unsigned*)(lds + MISC_OFF);
    const int tid = threadIdx.x, lane = tid & 63, wave = tid >> 6, G = gridDim.x, bid = blockIdx.x;
    for (int u = tid; u < (LDS_BYTES - LDSCTL_OFF) / 4; u += 512) ((LAS unsigned*)(lds + LDSCTL_OFF))[u] = 0u;
    __syncthreads();
    unsigned char* ws = A.ws;
    unsigned* ctl = (unsigned*)(ws + WS_CTL);
    XcdBarrier bar = xcd_barrier_post(ctl + CW_BAR, MISC + 8);
    bf16* U = (bf16*)(ws + WS_U); bf16* MKV = (bf16*)(ws + WS_MEMKV);
    bf16* YA = (bf16*)(ws + WS_YA); bf16* YB = (bf16*)(ws + WS_YB); bf16* YC = (bf16*)(ws + WS_YC);
    bf16* OG = (bf16*)(ws + WS_OG); float* LSE = (float*)(ws + WS_LSE);
    float* HU = (float*)(ws + WS_HU); float* HP = (float*)(ws + WS_HP); float* HS = (float*)(ws + WS_HS);

    p0_prologue(A, lds, tid, G);
    xcd_barrier(bar);

    { pg8::Gemm g{(const pg8::bf16_t*)(ws + WS_MN), (const pg8::bf16_t*)(ws + WS_WMEM), 256, 1024, 1024}; pg8::StaticOrder S; S.init(256, 1024, G, (bid + 4) % G);
      pg8::EpiMem E{A.out + O_MEMKV, (pg8::bf16_t*)MKV};
      pg8::gemm_phase<pg8::EpiMem, pg8::StaticOrder, false, PG8_SP2>(lds, g, S, E); }
    __syncthreads();
    { pg8::Gemm g{(const pg8::bf16_t*)(ws + WS_XN), (const pg8::bf16_t*)(ws + WS_WIN), MROWS, NIN, 1024}; pg8::StaticOrder S; S.init(MROWS, NIN, G, bid);
      pg8::EpiU E{(pg8::bf16_t*)U, (const float*)(ws + WS_CS), A.out};
      pg8::gemm_phase<pg8::EpiU, pg8::StaticOrder, PG8_ALIGN, PG8_SP2>(lds, g, S, E); }
    xcd_barrier(bar);

    for (int u = bid; u < 128; u += G) samp_attn_unit(A, U, YA, u, tid);
    for (int u = bid; u < 512; u += G) samp_xattn_unit(lds, A, U, YC, u >> 2, u & 3, tid);
    for (int u = bid; u < 512; u += G) samp_hgrn_unit(lds, A, U, YB, u >> 2, u & 3, tid);
    for (int u = bid; u < 256; u += G) hgrn_pass1_unit(lds, U, A.lbl, HU, HP, u & 3, u >> 2, tid);
    for (int u = bid; u < 3072; u += G) { const int g = u >> 10, rem = u & 1023, h = rem & 7, rb = rem >> 3, dil = (g == 0) ? 1 : (g == 1 ? 4 : 16), nblk = 128 / dil;
        attn_dil_unit(lds, U, OG, LSE, g, dil, rb / nblk, rb % nblk, h, tid); }
    for (int u = bid; u < 512; u += G) xattn_unit(lds, U, MKV, YC, u >> 2, u & 3, tid);
    xcd_barrier(bar);

    for (int u = bid; u < 128; u += G) hgrn_scan_unit(HU, HP, HS, A.out + O_HGP, u, tid);
    for (int t = bid * 8 + wave; t < T_SEQ; t += G * 8) attn_merge_row(U, OG, LSE, YA, t, lane);
    xcd_barrier(bar);

    for (int u = bid; u < 256; u += G) hgrn_pass3_unit(lds, U, A.lbl, A.hgn, HS, YB, u & 3, u >> 2, tid);
    xcd_barrier(bar);

    { pg8::StaticOrder S; S.init(MROWS, 1024, G, bid);
      { pg8::Gemm g{(const pg8::bf16_t*)YA, (const pg8::bf16_t*)(ws + WS_WPA), MROWS, 1024, 512}; pg8::EpiBranch<0> E{(const pg8::bf16_t*)U, (float*)(ws + WS_M32), (pg8::bf16_t*)(ws + WS_MG)};
        pg8::gemm_phase<pg8::EpiBranch<0>, pg8::StaticOrder, PG8_ALIGN, PG8_SP2>(lds, g, S, E); }
      __syncthreads();
      { pg8::Gemm g{(const pg8::bf16_t*)YB, (const pg8::bf16_t*)(ws + WS_WPB), MROWS, 1024, 512}; pg8::EpiBranch<1> E{(const pg8::bf16_t*)U, (float*)(ws + WS_M32), (pg8::bf16_t*)(ws + WS_MG)};
        pg8::gemm_phase<pg8::EpiBranch<1>, pg8::StaticOrder, PG8_ALIGN, PG8_SP2>(lds, g, S, E); }
      __syncthreads();
      { pg8::Gemm g{(const pg8::bf16_t*)YC, (const pg8::bf16_t*)(ws + WS_WPC), MROWS, 1024, 512}; pg8::EpiBranch<2> E{(const pg8::bf16_t*)U, (float*)(ws + WS_M32), (pg8::bf16_t*)(ws + WS_MG)};
        pg8::gemm_phase<pg8::EpiBranch<2>, pg8::StaticOrder, PG8_ALIGN, PG8_SP2>(lds, g, S, E); } }
    xcd_barrier(bar);

    { pg8::Gemm g{(const pg8::bf16_t*)(ws + WS_MG), (const pg8::bf16_t*)(ws + WS_WOUT), MROWS, 1024, 1024}; pg8::StaticOrder S; S.init(MROWS, 1024, G, bid);
      pg8::EpiZ E{(float*)(ws + WS_Z)};
      pg8::gemm_phase<pg8::EpiZ, pg8::StaticOrder, PG8_ALIGN, PG8_SP2>(lds, g, S, E); }
    xcd_barrier(bar);

    { const float* Z = (const float*)(ws + WS_Z);
      for (int m = bid * 8 + wave; m < T_SEQ + NSAMP; m += G * 8) {
          if (m < T_SEQ) final_row(Z + (size_t)m * 1024, A.xp + (size_t)m * 1024, A.npost, A.out + O_YP + (size_t)m * 1024, lane);
          else final_row(Z + (size_t)m * 1024, A.xs + (size_t)(m - T_SEQ) * 1024, A.npost, A.out + O_YS + (size_t)(m - T_SEQ) * 1024, lane); } }
}

extern "C" void kernel_launch(void* const* d_in, const int* in_sizes, int n_in, void* d_out, int out_size, void* d_ws, size_t ws_size, hipStream_t stream) {
    static int grid = 0;
    if (grid == 0) {
        if (n_in != 19 || out_size != (int)O_END || ws_size < WS_END) { fprintf(stderr, "kernel_launch: unexpected shapes (n_in %d, out %d, ws %zu); nothing launched\n", n_in, out_size, ws_size); grid = -1; return; }
        int dev = 0, cus = 0, per_cu = 0;
        if (hipGetDevice(&dev) != hipSuccess || hipDeviceGetAttribute(&cus, hipDeviceAttributeMultiprocessorCount, dev) != hipSuccess) { grid = -1; return; }
        if (hipFuncSetAttribute((const void*)fwd_kernel, hipFuncAttributeMaxDynamicSharedMemorySize, LDS_BYTES) != hipSuccess) { fprintf(stderr, "kernel_launch: hipFuncSetAttribute failed\n"); grid = -1; return; }
        if (hipOccupancyMaxActiveBlocksPerMultiprocessor(&per_cu, (const void*)fwd_kernel, 512, LDS_BYTES) != hipSuccess || per_cu < 1) { fprintf(stderr, "kernel_launch: occupancy query says %d blocks per CU\n", per_cu); per_cu = 1; }
        (void)hipGetLastError();
        grid = cus;
    }
    if (grid < 0) return;
    if (hipMemsetAsync((char*)d_ws + WS_CTL, 0, CTL_ZERO_BYTES, stream) != hipSuccess) return;
    Args a{};
    a.xp = (const float*)d_in[0]; a.xs = (const float*)d_in[1]; a.memp = (const float*)d_in[2]; a.c128 = (const float*)d_in[3]; a.c512 = (const float*)d_in[4]; a.c2048 = (const float*)d_in[5];
    a.sth = (const float*)d_in[6]; a.cmem = (const float*)d_in[7]; a.npre = (const float*)d_in[8]; a.npost = (const float*)d_in[9]; a.win = (const float*)d_in[10]; a.lbl = (const float*)d_in[11];
    a.hgn = (const float*)d_in[12]; a.mnorm = (const float*)d_in[13]; a.wmem = (const float*)d_in[14]; a.wpa = (const float*)d_in[15]; a.wpb = (const float*)d_in[16]; a.wpc = (const float*)d_in[17]; a.wout = (const float*)d_in[18];
    a.out = (float*)d_out; a.ws = (unsigned char*)d_ws;
    hipLaunchKernelGGL(fwd_kernel, dim3(grid), dim3(512), LDS_BYTES, stream, a);
    const hipError_t le = hipPeekAtLastError();
    if (le != hipSuccess) fprintf(stderr, "kernel_launch: launch failed: %s\n", hipGetErrorName(le));
}
```

```cpp
#include <hip/hip_runtime.h>
#include <cstdio>
#include <cstdint>
constexpr int T_SEQ = 16384, DMODEL = 1024, NSAMP = 128, MROWS = 16640  , NIN = 11264;
constexpr int C_AQ = 0, C_AK = 1536, C_AV = 3072, C_AZ = 4608, C_BQ = 5120, C_BF = 5632, C_BI = 6144, C_BZ = 6656, C_CQ = 7168, C_CZ = 7680, C_GA = 8192;
constexpr float EPS = 1e-6f;
constexpr size_t O_YP = 0, O_YS = 16777216, O_W128P = 16908288, O_W512P = 17039360, O_W2048P = 17563648, O_HGP = 19660800, O_MEMKV = 19726336,
                 O_W128S = 19988480, O_W512S = 20119552, O_W2048S = 20250624, O_HGS = 20381696, O_END = 28770304;
constexpr size_t MiB = 1u << 20;
constexpr size_t WS_CTL = 0, CTL_ZERO_BYTES = 1 * MiB;
constexpr size_t WS_WIN = 2 * MiB, WS_WMEM = 24 * MiB, WS_WPA = 26 * MiB, WS_WPB = 27 * MiB, WS_WPC = 28 * MiB, WS_WOUT = 29 * MiB, WS_MN = 31 * MiB, WS_MEMKV = 31 * MiB + 512 * 1024;
constexpr size_t WS_CS = 32 * MiB, WS_XN = 36 * MiB, WS_U = 70 * MiB, WS_OG = 428 * MiB, WS_LSE = 477 * MiB, WS_HU = 479 * MiB, WS_HP = 495 * MiB, WS_HS = 496 * MiB;
constexpr size_t WS_YA = 512 * MiB, WS_YB = 529 * MiB, WS_YC = 546 * MiB, WS_M32 = 563 * MiB, WS_MG = 628 * MiB, WS_Z = 661 * MiB, WS_END = 726 * MiB;
constexpr int CW_BAR = 4096;
namespace pg8 {
#define PG8_LAS __attribute__((address_space(3)))
typedef unsigned short bf16_t;
typedef short bf16x8 __attribute__((ext_vector_type(8)));
typedef float f32x4 __attribute__((ext_vector_type(4)));
typedef unsigned u32x4 __attribute__((ext_vector_type(4)));
constexpr int BM = 256, BK = 64, HALF = 128, HTB = HALF * BK * 2  , STAGE_BYTES = 8 * HTB, NXCD = 8, WGM = 8;

__host__ __device__ __forceinline__ int lds_byte(int r, int c) { const int st = (r >> 4) * 2 + (c >> 5), rr = r & 15, cc = c & 31, ob = rr * 64 + cc * 2; return st * 1024 + (ob ^ (((ob >> 9) & 1) << 5)); }
__host__ __device__ __forceinline__ void stage_rc(int b, int& R, int& C) { const int st = b / 1024, sb = b % 1024, swz = sb ^ (((sb >> 9) & 1) << 5); R = (st >> 1) * 16 + swz / 64; C = (st & 1) * 32 + (swz % 64) / 2; }
__host__ __device__ __forceinline__ int perm32(int rho) { const int n = rho >> 4, i = rho & 15; return 8 * (i >> 2) + 4 * n + (i & 3); }

struct Unit { int pm, pn; };
struct Gemm { const bf16_t* A; const bf16_t* Bt; int M, N, K; };

struct StaticOrder {
    int nM, nN, nwg, G, c;
    __host__ __device__ void init(int M, int N, int G_, int c_) { nM = M / BM; nN = N / BM; nwg = nM * nN; G = G_; c = c_; }
    __host__ __device__ bool next(int i, Unit& u) const {
        const long L = (long)i * G + c; if (L >= nwg) return false;
        int wgid = (int)L; { const int q = nwg / NXCD, r = nwg % NXCD, xcd = wgid % NXCD, off = wgid / NXCD; wgid = (xcd < r ? xcd * (q + 1) : r * (q + 1) + (xcd - r) * q) + off; }
        const int nig = WGM * nN, gid = wgid / nig, fm = gid * WGM, gsz = (nM - fm) < WGM ? (nM - fm) : WGM;
        u.pm = fm + ((wgid % nig) % gsz); u.pn = (wgid % nig) / gsz; return true;
    }
    __device__ __forceinline__ void a_ready(const Unit&) const {}
    __device__ __forceinline__ void done(const Unit&) const {}
};

__device__ __forceinline__ unsigned cvt_pk_bf16(float lo, float hi) { unsigned r; asm volatile("v_cvt_pk_bf16_f32 %0, %1, %2" : "=v"(r) : "v"(lo), "v"(hi)); return r; }
typedef unsigned u32x2 __attribute__((ext_vector_type(2)));
typedef float f32x2 __attribute__((ext_vector_type(2)));
__device__ __forceinline__ float sigm(float x) { return 1.0f / (1.0f + __expf(-x)); }
__device__ __forceinline__ float bflo(unsigned w) { return __uint_as_float(w << 16); }
__device__ __forceinline__ float bfhi(unsigned w) { return __uint_as_float(w & 0xffff0000u); }

struct EpiU {
    static constexpr bool PERM = false, AFTER_DRAIN = false;
    bf16_t* U; const float* cs; float* out;
    __device__ __forceinline__ void operator()(const f32x4 (&acc)[2][2][4][2], const Unit& u, int wr, int wc, int fr, int fq) const {
        const int pn = u.pn, rbase = u.pm * 256 + wr * 64 + fr, cbase = pn * 256 + wc * 32 + 4 * fq;
        if (pn < 12) {
            const bool isk = pn >= 6; const int g = isk ? ((pn - 6) >> 1) : 0;
            const int t0 = (g == 0) ? 16256 : (g == 1 ? 15872 : 14336);
            const size_t offp = (g == 0) ? O_W128P : (g == 1 ? O_W512P : O_W2048P), offs = (g == 0) ? O_W128S : (g == 1 ? O_W512S : O_W2048S);
            const float qs = isk ? 1.0f : 0.125f;
#pragma unroll
            for (int ai = 0; ai < 2; ++ai)
#pragma unroll
                for (int m = 0; m < 4; ++m) { const int row = rbase + ai * 128 + m * 16, pos = row < T_SEQ ? row : 8192;
                    float* dstr = nullptr;
                    if (isk) { if (row < T_SEQ) { if (row >= t0) dstr = out + offp + (size_t)(row - t0) * 1024; } else if (row < T_SEQ + NSAMP) dstr = out + offs + (size_t)(row - T_SEQ) * 1024; }
#pragma unroll
                    for (int bj = 0; bj < 2; ++bj)
#pragma unroll
                        for (int n = 0; n < 2; ++n) { const int vc = cbase + bj * 128 + n * 16, hb = vc & ~63, i = (vc & 63) >> 1;
                            const f32x4 c4 = *(const f32x4*)(cs + ((size_t)pos * 32 + i) * 2); const f32x4 x = acc[ai][bj][m][n];
                            const float lo0 = (x[0] * c4[0] - x[1] * c4[1]) * qs, hi0 = (x[1] * c4[0] + x[0] * c4[1]) * qs, lo1 = (x[2] * c4[2] - x[3] * c4[3]) * qs, hi1 = (x[3] * c4[2] + x[2] * c4[3]) * qs;
                            bf16_t* up = U + (size_t)row * NIN + hb + i;
                            *(unsigned*)up = cvt_pk_bf16(lo0, lo1); *(unsigned*)(up + 32) = cvt_pk_bf16(hi0, hi1);
                            if (dstr) { float* d = dstr + (((hb - C_AK) >> 6) & 7) * 64 + i; *(f32x2*)d = (f32x2){lo0, lo1}; *(f32x2*)(d + 32) = (f32x2){hi0, hi1}; } } }
        } else if (pn < 18) {
            const int g = (pn - 12) >> 1; const int t0 = (g == 0) ? 16256 : (g == 1 ? 15872 : 14336);
            const size_t offp = (g == 0) ? O_W128P : (g == 1 ? O_W512P : O_W2048P), offs = (g == 0) ? O_W128S : (g == 1 ? O_W512S : O_W2048S);
#pragma unroll
            for (int ai = 0; ai < 2; ++ai)
#pragma unroll
                for (int m = 0; m < 4; ++m) { const int row = rbase + ai * 128 + m * 16;
                    float* dstr = nullptr;
                    if (row < T_SEQ) { if (row >= t0) dstr = out + offp + (size_t)(row - t0) * 1024 + 512; } else if (row < T_SEQ + NSAMP) dstr = out + offs + (size_t)(row - T_SEQ) * 1024 + 512;
#pragma unroll
                    for (int bj = 0; bj < 2; ++bj)
#pragma unroll
                        for (int n = 0; n < 2; ++n) { const int vc = cbase + bj * 128 + n * 16; const f32x4 x = acc[ai][bj][m][n];
                            u32x2 w; w.x = cvt_pk_bf16(x[0], x[1]); w.y = cvt_pk_bf16(x[2], x[3]); *(u32x2*)(U + (size_t)row * NIN + vc) = w;
                            if (dstr) *(f32x4*)(dstr + ((vc - C_AV) & 511)) = x; } }
        } else {
            const int act = (pn >= 32) ? 2 : ((pn < 20 || pn == 26 || pn == 27 || pn == 30 || pn == 31) ? 1 : 0);
#pragma unroll
            for (int ai = 0; ai < 2; ++ai)
#pragma unroll
                for (int m = 0; m < 4; ++m) { const int row = rbase + ai * 128 + m * 16;
#pragma unroll
                    for (int bj = 0; bj < 2; ++bj)
#pragma unroll
                        for (int n = 0; n < 2; ++n) { const int vc = cbase + bj * 128 + n * 16; f32x4 x = acc[ai][bj][m][n];
                            if (act) {
#pragma unroll
                                for (int j = 0; j < 4; ++j) { const float s = sigm(x[j]); x[j] = (act == 1) ? x[j] * s : s; } }
                            u32x2 w; w.x = cvt_pk_bf16(x[0], x[1]); w.y = cvt_pk_bf16(x[2], x[3]); *(u32x2*)(U + (size_t)row * NIN + vc) = w; } }
        }
    }
};
struct EpiMem {
    static constexpr bool PERM = false, AFTER_DRAIN = false;
    float* O; bf16_t* B;
    __device__ __forceinline__ void operator()(const f32x4 (&acc)[2][2][4][2], const Unit& u, int wr, int wc, int fr, int fq) const {
        const int rbase = u.pm * 256 + wr * 64 + fr, cbase = u.pn * 256 + wc * 32 + 4 * fq;
#pragma unroll
        for (int ai = 0; ai < 2; ++ai)
#pragma unroll
            for (int m = 0; m < 4; ++m) { const int row = rbase + ai * 128 + m * 16;
#pragma unroll
                for (int bj = 0; bj < 2; ++bj)
#pragma unroll
                    for (int n = 0; n < 2; ++n) { const int c = cbase + bj * 128 + n * 16; const f32x4 x = acc[ai][bj][m][n];
                        *(f32x4*)(O + (size_t)row * 1024 + c) = x; u32x2 w; w.x = cvt_pk_bf16(x[0], x[1]); w.y = cvt_pk_bf16(x[2], x[3]); *(u32x2*)(B + (size_t)row * 1024 + c) = w; } }
    }
};
template <int BR> struct EpiBranch {
    static constexpr bool PERM = false, AFTER_DRAIN = false;
    const bf16_t* U; float* M32; bf16_t* MG;
    __device__ __forceinline__ void operator()(const f32x4 (&acc)[2][2][4][2], const Unit& u, int wr, int wc, int fr, int fq) const {
        const int rbase = u.pm * 256 + wr * 64 + fr, cbase = u.pn * 256 + wc * 32 + 4 * fq;
#pragma unroll
        for (int ai = 0; ai < 2; ++ai)
#pragma unroll
            for (int m = 0; m < 4; ++m) { const int row = rbase + ai * 128 + m * 16;
#pragma unroll
                for (int bj = 0; bj < 2; ++bj)
#pragma unroll
                    for (int n = 0; n < 2; ++n) { const int c = cbase + bj * 128 + n * 16; const f32x4 x = acc[ai][bj][m][n];
                        const u32x2 gw = *(const u32x2*)(U + (size_t)row * NIN + C_GA + BR * 1024 + c);
                        f32x4 v; v[0] = x[0] * bflo(gw.x); v[1] = x[1] * bfhi(gw.x); v[2] = x[2] * bflo(gw.y); v[3] = x[3] * bfhi(gw.y);
                        float* mp = M32 + (size_t)row * 1024 + c;
                        if (BR == 0) *(f32x4*)mp = v;
                        else if (BR == 1) *(f32x4*)mp = *(const f32x4*)mp + v;
                        else { v = *(const f32x4*)mp + v; u32x2 w; w.x = cvt_pk_bf16(v[0], v[1]); w.y = cvt_pk_bf16(v[2], v[3]); *(u32x2*)(MG + (size_t)row * 1024 + c) = w; } } }
    }
};
struct EpiZ {
    static constexpr bool PERM = false, AFTER_DRAIN = false;
    float* Z;
    __device__ __forceinline__ void operator()(const f32x4 (&acc)[2][2][4][2], const Unit& u, int wr, int wc, int fr, int fq) const {
        const int rbase = u.pm * 256 + wr * 64 + fr, cbase = u.pn * 256 + wc * 32 + 4 * fq;
#pragma unroll
        for (int ai = 0; ai < 2; ++ai)
#pragma unroll
            for (int m = 0; m < 4; ++m) { const int row = rbase + ai * 128 + m * 16;
#pragma unroll
                for (int bj = 0; bj < 2; ++bj)
#pragma unroll
                    for (int n = 0; n < 2; ++n) *(f32x4*)(Z + (size_t)row * 1024 + cbase + bj * 128 + n * 16) = acc[ai][bj][m][n]; }
    }
};
template <class Epi, class Sched, bool ALIGN_EPI = false, bool SP2 = false>
__device__ __forceinline__ void gemm_phase(PG8_LAS unsigned char* lds, const Gemm g, const Sched& S, const Epi& E) {
    const int tid = threadIdx.x, wid = __builtin_amdgcn_readfirstlane(tid >> 6), lane = tid & 63, wr = wid >> 2, wc = wid & 3, fr = lane & 15, fq = lane >> 4;
    const int K = g.K, nt = K / BK;
    unsigned voffA[2], voffB[2];
#pragma unroll
    for (int i = 0; i < 2; ++i) { int R, C; stage_rc(tid * 16 + i * 8192, R, C); const int Rb = Epi::PERM ? ((R & ~31) + perm32(R & 31)) : R;
        voffA[i] = (unsigned)(R * K + C) * 2u; voffB[i] = (unsigned)(Rb * K + C) * 2u; }
    const size_t kstep = (size_t)(BK * 2);
    const size_t hstep = (size_t)HALF * K * 2;
    const size_t tstep = 2 * hstep;
    const unsigned ldsw = (unsigned)wid * 1024u;
    const int aoff = lds_byte(wr * 64 + fr, fq * 8), boff = lds_byte(wc * 32 + fr, fq * 8);
#define PG8_SA(b, h) (((b) * 2 + (h)) * HTB)
#define PG8_SB(b, h) ((4 + (b) * 2 + (h)) * HTB)
#define PG8_STAGE(bufoff, gbase, voff) do { _Pragma("unroll") for (int _i = 0; _i < 2; ++_i) \
        __builtin_amdgcn_global_load_lds((const unsigned*)((const char*)(gbase) + (voff)[_i]), (PG8_LAS unsigned*)(lds + (bufoff) + ldsw + _i * 8192), 16, 0, 0); } while (0)
#define PG8_LDA(dst, b, h) do { _Pragma("unroll") for (int m = 0; m < 4; ++m) _Pragma("unroll") for (int k = 0; k < 2; ++k) dst[m][k] = *(const PG8_LAS bf16x8*)(lds + PG8_SA(b, h) + aoff + m * 2048 + k * 1024); } while (0)
#define PG8_LDB(dst, b, h) do { _Pragma("unroll") for (int n = 0; n < 2; ++n) _Pragma("unroll") for (int k = 0; k < 2; ++k) dst[n][k] = *(const PG8_LAS bf16x8*)(lds + PG8_SB(b, h) + boff + n * 2048 + k * 1024); } while (0)
#define PG8_MMA(ai, bj, At, Bt) do { __builtin_amdgcn_s_setprio(1); _Pragma("unroll") for (int m = 0; m < 4; ++m) _Pragma("unroll") for (int n = 0; n < 2; ++n) _Pragma("unroll") for (int k = 0; k < 2; ++k) \
        acc[ai][bj][m][n] = __builtin_amdgcn_mfma_f32_16x16x32_bf16(Bt[n][k], At[m][k], acc[ai][bj][m][n], 0, 0, 0); __builtin_amdgcn_s_setprio(0); } while (0)
#define PG8_WAIT_V(n) asm volatile("s_waitcnt vmcnt(" #n ")" ::: "memory")
#define PG8_WAIT_L(n) asm volatile("s_waitcnt lgkmcnt(" #n ")" ::: "memory")
#define PG8_BAR __builtin_amdgcn_s_barrier()
#define PG8_SCHED __builtin_amdgcn_sched_barrier(0)
    Unit cur, nxt; int ui = 0;
    if (!S.next(0, cur)) return;
    f32x4 acc[2][2][4][2];
#pragma unroll
    for (int a = 0; a < 2; ++a)
#pragma unroll
        for (int b = 0; b < 2; ++b)
#pragma unroll
            for (int m = 0; m < 4; ++m)
#pragma unroll
                for (int n = 0; n < 2; ++n) acc[a][b][m][n] = (f32x4){0.f, 0.f, 0.f, 0.f};
    bf16x8 At[4][2], B0[2][2], B1[2][2];
    const char* cA = (const char*)g.A + (size_t)cur.pm * tstep; const char* cB = (const char*)g.Bt + (size_t)cur.pn * tstep;
    S.a_ready(cur);
    if constexpr (SP2) {
        PG8_STAGE(PG8_SB(0, 0), cB, voffB); PG8_STAGE(PG8_SB(0, 1), cB + hstep, voffB); PG8_STAGE(PG8_SA(0, 0), cA, voffA); PG8_STAGE(PG8_SA(0, 1), cA + hstep, voffA);
        if (wr == 1) PG8_BAR;
        PG8_WAIT_V(2); PG8_BAR;
        PG8_STAGE(PG8_SB(1, 0), cB + kstep, voffB); PG8_STAGE(PG8_SA(1, 0), cA + kstep, voffA); PG8_STAGE(PG8_SB(1, 1), cB + hstep + kstep, voffB);
        PG8_WAIT_V(6); PG8_BAR;
    } else {
        PG8_STAGE(PG8_SB(0, 0), cB, voffB); PG8_STAGE(PG8_SA(0, 0), cA, voffA); PG8_STAGE(PG8_SB(0, 1), cB + hstep, voffB); PG8_STAGE(PG8_SA(0, 1), cA + hstep, voffA);
        if (wr == 1) PG8_BAR;
        PG8_WAIT_V(4); PG8_BAR;
        PG8_STAGE(PG8_SB(1, 0), cB + kstep, voffB); PG8_STAGE(PG8_SA(1, 0), cA + kstep, voffA); PG8_STAGE(PG8_SB(1, 1), cB + hstep + kstep, voffB);
        PG8_WAIT_V(6); PG8_BAR;
    }
    for (;;) {
        const bool has_next = S.next(ui + 1, nxt);
        const char* nA = has_next ? (const char*)g.A + (size_t)nxt.pm * tstep : cA; const char* nB = has_next ? (const char*)g.Bt + (size_t)nxt.pn * tstep : cB;
        for (int t = 0; t < nt; t += 2) {
            const bool last = (t == nt - 2);
            const char* a1 = cA + (size_t)(t + 1) * kstep;
            const char* a2 = last ? nA : cA + (size_t)(t + 2) * kstep; const char* b2 = last ? nB : cB + (size_t)(t + 2) * kstep;
            const char* a3 = a2 + kstep; const char* b3 = b2 + kstep;
            if (last && has_next) S.a_ready(nxt);
            if constexpr (SP2) {
            PG8_LDB(B0, 0, 0); PG8_LDB(B1, 0, 1); PG8_SCHED; PG8_LDA(At, 0, 0); PG8_STAGE(PG8_SA(1, 1), a1 + hstep, voffA);
            PG8_WAIT_V(8); PG8_WAIT_L(0); PG8_BAR; PG8_MMA(0, 0, At, B0); PG8_MMA(0, 1, At, B1); PG8_BAR; PG8_SCHED;
            PG8_LDA(At, 0, 1); PG8_STAGE(PG8_SB(0, 0), b2, voffB); PG8_STAGE(PG8_SB(0, 1), b2 + hstep, voffB); PG8_STAGE(PG8_SA(0, 0), a2, voffA);
            PG8_WAIT_V(8); PG8_WAIT_L(0); PG8_BAR; PG8_MMA(1, 0, At, B0); PG8_MMA(1, 1, At, B1); PG8_BAR; PG8_SCHED;
            PG8_LDB(B0, 1, 0); PG8_LDB(B1, 1, 1); PG8_SCHED; PG8_LDA(At, 1, 0); PG8_STAGE(PG8_SA(0, 1), a2 + hstep, voffA);
            PG8_WAIT_V(8); PG8_WAIT_L(0); PG8_BAR; PG8_MMA(0, 0, At, B0); PG8_MMA(0, 1, At, B1); PG8_BAR; PG8_SCHED;
            PG8_LDA(At, 1, 1); PG8_STAGE(PG8_SB(1, 0), b3, voffB); PG8_STAGE(PG8_SB(1, 1), b3 + hstep, voffB); PG8_STAGE(PG8_SA(1, 0), a3, voffA);
            PG8_WAIT_V(8); PG8_WAIT_L(0); PG8_BAR; PG8_MMA(1, 0, At, B0); PG8_MMA(1, 1, At, B1); PG8_BAR; PG8_SCHED;
            } else {
            PG8_LDB(B0, 0, 0); PG8_SCHED; PG8_LDA(At, 0, 0); PG8_STAGE(PG8_SA(1, 1), a1 + hstep, voffA);
            PG8_WAIT_L(8); PG8_BAR; PG8_WAIT_L(0); PG8_MMA(0, 0, At, B0); PG8_BAR; PG8_SCHED;
            PG8_LDB(B1, 0, 1); PG8_STAGE(PG8_SB(0, 0), b2, voffB);
            PG8_BAR; PG8_WAIT_L(0); PG8_MMA(0, 1, At, B1); PG8_BAR;
            PG8_LDA(At, 0, 1); PG8_STAGE(PG8_SA(0, 0), a2, voffA);
            PG8_BAR; PG8_WAIT_L(0); PG8_MMA(1, 0, At, B0); PG8_BAR; PG8_SCHED;
            PG8_STAGE(PG8_SB(0, 1), b2 + hstep, voffB);
            PG8_WAIT_V(6); PG8_BAR; PG8_MMA(1, 1, At, B1); PG8_BAR;
            PG8_LDB(B0, 1, 0); PG8_SCHED; PG8_LDA(At, 1, 0); PG8_STAGE(PG8_SA(0, 1), a2 + hstep, voffA);
            PG8_WAIT_L(8); PG8_BAR; PG8_WAIT_L(0); PG8_MMA(0, 0, At, B0); PG8_BAR; PG8_SCHED;
            PG8_LDB(B1, 1, 1); PG8_STAGE(PG8_SB(1, 0), b3, voffB);
            PG8_BAR; PG8_WAIT_L(0); PG8_MMA(0, 1, At, B1); PG8_BAR;
            PG8_LDA(At, 1, 1); PG8_STAGE(PG8_SA(1, 0), a3, voffA);
            PG8_BAR; PG8_WAIT_L(0); PG8_MMA(1, 0, At, B0); PG8_BAR; PG8_SCHED;
            PG8_STAGE(PG8_SB(1, 1), b3 + hstep, voffB);
            PG8_WAIT_V(6); PG8_BAR; PG8_MMA(1, 1, At, B1); PG8_BAR;
            }
        }
        if constexpr (ALIGN_EPI) { if (wr == 0) PG8_BAR; }
        if constexpr (!Epi::AFTER_DRAIN) { E(acc, cur, wr, wc, fr, fq); S.done(cur); }
        if (!has_next) break;
#pragma unroll
        for (int a = 0; a < 2; ++a)
#pragma unroll
            for (int b = 0; b < 2; ++b)
#pragma unroll
                for (int m = 0; m < 4; ++m)
#pragma unroll
                    for (int n = 0; n < 2; ++n) acc[a][b][m][n] = (f32x4){0.f, 0.f, 0.f, 0.f};
        cur = nxt; cA = nA; cB = nB; ++ui;
        if constexpr (ALIGN_EPI) { if (wr == 1) PG8_BAR; }
    }
    PG8_WAIT_V(0);
    if constexpr (!ALIGN_EPI) { if (wr == 0) PG8_BAR; }
    PG8_BAR;
    if constexpr (Epi::AFTER_DRAIN) { E.fused(acc, cur, wr, wc, fr, fq, lds, wid, lane); S.done(cur); }
#undef PG8_SA
#undef PG8_SB
#undef PG8_STAGE
#undef PG8_LDA
#undef PG8_LDB
#undef PG8_MMA
#undef PG8_WAIT_V
#undef PG8_WAIT_L
#undef PG8_BAR
#undef PG8_SCHED
}
}
#ifndef PG8_SP2
#define PG8_SP2 true
#endif
#ifndef PG8_ALIGN
#define PG8_ALIGN true
#endif
constexpr int RING_BYTES = 131072;
constexpr int LDSCTL_OFF = RING_BYTES, MISC_OFF = LDSCTL_OFF + 320;
constexpr int LDS_BYTES = 147456;
#define GAS __attribute__((address_space(1)))
#define LAS __attribute__((address_space(3)))
#define XB_TMO      128
#define XB_XCNT(j)  (256  + 64 * (j))
#define XB_XSUB(j)  (1280 + 64 * (j))
#define XB_XGEN(j)  (2304 + 64 * (j))
#define XB_TOP      3328
#define XB_TOPGEN   3392
#define XCD_BAR_WORDS 3456
#define XB_SPIN_CAP (1u << 18)

__device__ __forceinline__ unsigned xb_ld(unsigned* p)              { return __hip_atomic_load(p, __ATOMIC_RELAXED, __HIP_MEMORY_SCOPE_AGENT); }
__device__ __forceinline__ unsigned xb_add(unsigned* p, unsigned v) { return __hip_atomic_fetch_add(p, v, __ATOMIC_RELAXED, __HIP_MEMORY_SCOPE_AGENT); }
__device__ __forceinline__ unsigned xb_xcc_id() { return (unsigned)__builtin_amdgcn_s_getreg((3 << 11) | 20) & 0xFu; }
#define XB_SPIN(cond, bar) do { unsigned _sp = 0; while (cond) { __builtin_amdgcn_s_sleep(1); \
    if ((++_sp & 255u) == 0u) { if (xb_ld(&(bar)[XB_TMO])) break; if (_sp > XB_SPIN_CAP) { atomicAdd(&(bar)[XB_TMO], 1u); break; } } } } while (0)

struct XcdBarrier {
    unsigned* bar; unsigned x;
    volatile LAS unsigned* st;
};

__device__ __forceinline__ XcdBarrier xcd_barrier_post(unsigned* bar, volatile LAS unsigned* st) {
    XcdBarrier b; b.bar = bar; b.x = xb_xcc_id(); b.st = st;
    if (threadIdx.x == 0) (void)xb_add(&bar[XB_XCNT(b.x)], 1u);
    return b;
}
__device__ __forceinline__ void xcd_barrier_complete(unsigned* bar, unsigned x, unsigned& nloc, unsigned& nx) {
    const unsigned G = gridDim.x * gridDim.y * gridDim.z;
    unsigned sum, cnt, mine, sp = 0u;
    for (;;) {
        sum = 0u; cnt = 0u; mine = 0u;
#pragma unroll
        for (unsigned j = 0; j < 16; ++j) { const unsigned c = xb_ld(&bar[XB_XCNT(j)]); sum += c; cnt += (c > 0u) ? 1u : 0u; mine = (j == x) ? c : mine; }
        if (sum == G) break;
        __builtin_amdgcn_s_sleep(1);
        if ((++sp & 255u) == 0u) { if (xb_ld(&bar[XB_TMO])) break; if (sp > XB_SPIN_CAP) { atomicAdd(&bar[XB_TMO], 1u); break; } }
    }
    nloc = mine > 0u ? mine : 1u; nx = cnt > 0u ? cnt : 1u;
}

__device__ __forceinline__ void xcd_barrier(const XcdBarrier& b) {
    asm volatile("s_waitcnt vmcnt(0)" ::: "memory");
    __syncthreads();
    if (threadIdx.x == 0) {
        unsigned* bar = b.bar;
        __builtin_amdgcn_s_waitcnt(0);
        unsigned nloc = b.st[0], nx = b.st[1];
        if (nloc == 0u) { xcd_barrier_complete(bar, b.x, nloc, nx); b.st[0] = nloc; b.st[1] = nx; }
        const unsigned old = xb_add(&bar[XB_XSUB(b.x)], 1u);
        const unsigned gen = old / nloc;
        if (old + 1u == (gen + 1u) * nloc) {
            __builtin_amdgcn_fence(__ATOMIC_RELEASE, "agent");
            asm volatile("s_waitcnt vmcnt(0)" ::: "memory");
            const unsigned og = xb_add(&bar[XB_TOP], 1u);
            const unsigned tg = og / nx;
            if (og + 1u == (tg + 1u) * nx) xb_add(&bar[XB_TOPGEN], 1u);
            else XB_SPIN(xb_ld(&bar[XB_TOPGEN]) == tg, bar);
            __builtin_amdgcn_fence(__ATOMIC_ACQUIRE, "agent");
            xb_add(&bar[XB_XGEN(b.x)], 1u);
            asm volatile("s_waitcnt vmcnt(0)" ::: "memory");
        } else {
            XB_SPIN(xb_ld(&bar[XB_XGEN(b.x)]) == gen, bar);
            __builtin_amdgcn_fence(__ATOMIC_ACQUIRE, "agent");
            asm volatile("s_waitcnt vmcnt(0)" ::: "memory");
        }
    }
    __syncthreads();
}
typedef unsigned short bf16;
typedef unsigned v4u __attribute__((ext_vector_type(4)));
typedef unsigned v2u __attribute__((ext_vector_type(2)));
typedef float f32x4 __attribute__((ext_vector_type(4)));
typedef short bf16x8 __attribute__((ext_vector_type(8)));
typedef LAS unsigned char* ldsp;
#define LDS_WAIT() asm volatile("s_waitcnt lgkmcnt(0)" ::: "memory")
__device__ __forceinline__ unsigned f2bf(float f) { unsigned u = __builtin_bit_cast(unsigned, f); return (u + 0x7fffu + ((u >> 16) & 1u)) >> 16; }
__device__ __forceinline__ unsigned pk2(float lo, float hi) { return f2bf(lo) | (f2bf(hi) << 16); }
__device__ __forceinline__ float blo(unsigned w) { return __uint_as_float(w << 16); }
__device__ __forceinline__ float bhi(unsigned w) { return __uint_as_float(w & 0xffff0000u); }
__device__ __forceinline__ float b2f(bf16 b) { return __uint_as_float(((unsigned)b) << 16); }
__device__ __forceinline__ float sigmoid_f(float x) { return 1.0f / (1.0f + __expf(-x)); }
__device__ __forceinline__ float wave_sum(float v) {
#pragma unroll
    for (int o = 1; o < 64; o <<= 1) v += __shfl_xor(v, o);
    return v;
}
#define MFMA16(a, b, c) __builtin_amdgcn_mfma_f32_16x16x32_bf16((a), (b), (c), 0, 0, 0)

struct Args {
    const float *xp, *xs, *memp, *c128, *c512, *c2048, *sth, *cmem, *npre, *npost, *win, *lbl, *hgn, *mnorm, *wmem, *wpa, *wpb, *wpc, *wout;
    float* out; unsigned char* ws;
};

__device__ __forceinline__ int win_vrow(int n) { if (n < 3072) { const int d = n & 63; return (n & ~63) + (((d & 31) << 1) | (d >> 5)); } return n; }
__device__ __forceinline__ void transpose_item(const float* W, int K, int N, bf16* WT, bool rope, LAS float* scr, int item, int lane) {
    const int nblk = N / 32, kb = item / nblk, nb = item % nblk, k0 = 64 * kb, n0 = 32 * nb;
#pragma unroll 8
    for (int i = 0; i < 32; ++i) { const int kk = 2 * i + (lane >> 5); scr[kk * 33 + (lane & 31)] = W[(size_t)(k0 + kk) * N + n0 + (lane & 31)]; }
    LDS_WAIT(); asm volatile("" ::: "memory");
    const int c = lane & 7;
#pragma unroll
    for (int j = 0; j < 4; ++j) { const int n = (lane >> 3) + 8 * j; const LAS float* s = scr + (8 * c) * 33 + n;
        v4u o; o.x = pk2(s[0 * 33], s[1 * 33]); o.y = pk2(s[2 * 33], s[3 * 33]); o.z = pk2(s[4 * 33], s[5 * 33]); o.w = pk2(s[6 * 33], s[7 * 33]);
        const int dr = rope ? win_vrow(n0 + n) : (n0 + n);
        *(v4u*)(WT + (size_t)dr * K + k0 + 8 * c) = o; }
    LDS_WAIT(); asm volatile("" ::: "memory");
}
__device__ __forceinline__ void rms_row_to_bf16(const float* xrow, const float* g, bf16* orow, int lane) {
    const f32x4* xr = (const f32x4*)xrow + lane; const f32x4* gr = (const f32x4*)g + lane;
    f32x4 v[4]; float s = 0.f;
#pragma unroll
    for (int j = 0; j < 4; ++j) { v[j] = xr[64 * j]; s += (v[j].x * v[j].x + v[j].y * v[j].y) + (v[j].z * v[j].z + v[j].w * v[j].w); }
    const float rstd = rsqrtf(wave_sum(s) * (1.f / 1024.f) + EPS);
    v2u* o8 = (v2u*)orow + lane;
#pragma unroll
    for (int j = 0; j < 4; ++j) { const f32x4 gv = gr[64 * j]; v2u w; w.x = pk2(v[j].x * rstd * gv.x, v[j].y * rstd * gv.y); w.y = pk2(v[j].z * rstd * gv.z, v[j].w * rstd * gv.w); o8[64 * j] = w; }
}
__device__ __forceinline__ void sincos_entry(int pos, int i, float& c, float& s) {
    const float invf[32] = {1.000000000e+00f, 7.498942018e-01f, 5.623413324e-01f, 4.216965139e-01f, 3.162277639e-01f, 2.371373773e-01f, 1.778279394e-01f, 1.333521456e-01f, 1.000000015e-01f, 7.498942316e-02f, 5.623413250e-02f, 4.216964915e-02f, 3.162277490e-02f, 2.371373773e-02f, 1.778279431e-02f, 1.333521400e-02f, 9.999999776e-03f, 7.498942316e-03f, 5.623413250e-03f, 4.216964822e-03f, 3.162277630e-03f, 2.371373819e-03f, 1.778279431e-03f, 1.333521446e-03f, 1.000000047e-03f, 7.498941850e-04f, 5.623413017e-04f, 4.216965172e-04f, 3.162277571e-04f, 2.371373703e-04f, 1.778279402e-04f, 1.333521504e-04f};
    const float ang = (float)pos * invf[i];
    const double x = (double)ang, kq = rint(x * 0.63661977236758134308);
    double r = fma(-kq, 1.57079632679489655800, x); r = fma(-kq, 6.12323399573676603587e-17, r);
    const float rf = (float)r, r2 = rf * rf; const int q = ((int)kq) & 3;
    const float sp = rf + rf * r2 * (-1.6666654611e-1f + r2 * (8.3321608736e-3f + r2 * (-1.9515295891e-4f)));
    const float cp = 1.0f - 0.5f * r2 + r2 * r2 * (4.166664568298827e-2f + r2 * (-1.388731625493765e-3f + r2 * 2.443315711809948e-5f));
    c = (q == 0) ? cp : (q == 1 ? -sp : (q == 2 ? -cp : sp));
    s = (q == 0) ? sp : (q == 1 ? cp : (q == 2 ? -sp : -cp));
}
__device__ __forceinline__ void p0_prologue(const Args& A, ldsp lds, int tid, int G) {
    const int lane = tid & 63, wave = tid >> 6;
    unsigned char* ws = A.ws;
    LAS float* scr = (LAS float*)(lds + wave * 16384);
    const int gw = blockIdx.x * 8 + wave, NGW = G * 8;
    constexpr int I_IN = 16 * 352, I_MEM = 16 * 32, I_BR = 8 * 32, I_OUT = 16 * 32, NITEMS = I_IN + I_MEM + 3 * I_BR + I_OUT;
    for (int it = gw; it < NITEMS; it += NGW) {
        int r = it;
        if (r < I_IN) { transpose_item(A.win, 1024, NIN, (bf16*)(ws + WS_WIN), true, scr, r, lane); continue; } r -= I_IN;
        if (r < I_MEM) { transpose_item(A.wmem, 1024, 1024, (bf16*)(ws + WS_WMEM), false, scr, r, lane); continue; } r -= I_MEM;
        if (r < I_BR) { transpose_item(A.wpa, 512, 1024, (bf16*)(ws + WS_WPA), false, scr, r, lane); continue; } r -= I_BR;
        if (r < I_BR) { transpose_item(A.wpb, 512, 1024, (bf16*)(ws + WS_WPB), false, scr, r, lane); continue; } r -= I_BR;
        if (r < I_BR) { transpose_item(A.wpc, 512, 1024, (bf16*)(ws + WS_WPC), false, scr, r, lane); continue; } r -= I_BR;
        transpose_item(A.wout, 1024, 1024, (bf16*)(ws + WS_WOUT), false, scr, r, lane);
    }
    bf16* XN = (bf16*)(ws + WS_XN); bf16* MN = (bf16*)(ws + WS_MN);
    for (int m = gw; m < T_SEQ + NSAMP + 256; m += NGW) {
        if (m < T_SEQ) rms_row_to_bf16(A.xp + (size_t)m * 1024, A.npre, XN + (size_t)m * 1024, lane);
        else if (m < T_SEQ + NSAMP) rms_row_to_bf16(A.xs + (size_t)(m - T_SEQ) * 1024, A.npre, XN + (size_t)m * 1024, lane);
        else rms_row_to_bf16(A.memp + (size_t)(m - T_SEQ - NSAMP) * 1024, A.mnorm, MN + (size_t)(m - T_SEQ - NSAMP) * 1024, lane);
    }
    float* cs = (float*)(ws + WS_CS);
    for (int e = blockIdx.x * 512 + tid; e < T_SEQ * 32; e += G * 512) { float c, s; sincos_entry(e >> 5, e & 31, c, s); *(float2*)(cs + (size_t)e * 2) = make_float2(c, s); }
}

constexpr int VT_STRIDE = 276;
__device__ __forceinline__ void attn_dil_unit(ldsp lds, const bf16* U, bf16* OG, float* LSE, int g, int dil, int r, int nb, int h, int tid) {
    const int lane = tid & 63, w = __builtin_amdgcn_readfirstlane(tid >> 6), l15 = lane & 15, q4 = lane >> 4;
    LAS bf16* VT = (LAS bf16*)lds;
    const int colq = C_AQ + g * 512 + h * 64, colk = C_AK + g * 512 + h * 64, colv = C_AV + g * 512 + h * 64;
    __syncthreads();
#pragma unroll
    for (int it = 0; it < 4; ++it) { const int key = (tid >> 3) + 64 * it, d8 = (tid & 7) * 8, kp = (nb - 1) * 128 + key;
        bf16x8 v = (bf16x8){0, 0, 0, 0, 0, 0, 0, 0};
        if (kp >= 0) v = *(const bf16x8*)(U + (size_t)(kp * dil + r) * NIN + colv + d8);
#pragma unroll
        for (int j = 0; j < 8; ++j) VT[(d8 + j) * VT_STRIDE + key] = (bf16)v[j]; }
    for (int e = tid; e < 64 * 20; e += 512) VT[(e / 20) * VT_STRIDE + 256 + (e % 20)] = 0;
    __syncthreads();
    const int tq = (nb * 128 + w * 16 + l15) * dil + r;
    bf16x8 qf[2];
#pragma unroll
    for (int kk = 0; kk < 2; ++kk) qf[kk] = *(const bf16x8*)(U + (size_t)tq * NIN + colq + 32 * kk + 8 * q4);
    f32x4 s[9];
#pragma unroll
    for (int kt = 0; kt < 9; ++kt) { int kp = (nb - 1) * 128 + 16 * w + 16 * kt + l15; kp = kp < 0 ? 0 : kp;
        const bf16* kr = U + (size_t)(kp * dil + r) * NIN + colk + 8 * q4;
        f32x4 a = (f32x4){0.f, 0.f, 0.f, 0.f};
#pragma unroll
        for (int kk = 0; kk < 2; ++kk) a = MFMA16(*(const bf16x8*)(kr + 32 * kk), qf[kk], a);
        s[kt] = a; }
    float m = -1e30f;
#pragma unroll
    for (int kt = 0; kt < 9; ++kt)
#pragma unroll
        for (int j = 0; j < 4; ++j) { const int klr = 16 * kt + 4 * q4 + j, dist = l15 + 128 - klr;
            const bool ok = dist >= 0 && dist <= 128 && (nb > 0 || (16 * w + klr) >= 128);
            s[kt][j] = ok ? s[kt][j] : -1e30f; m = fmaxf(m, s[kt][j]); }
    m = fmaxf(m, __shfl_xor(m, 16)); m = fmaxf(m, __shfl_xor(m, 32));
    float l = 0.f;
#pragma unroll
    for (int kt = 0; kt < 9; ++kt)
#pragma unroll
        for (int j = 0; j < 4; ++j) { const float p = __expf(s[kt][j] - m); s[kt][j] = p; l += p; }
    l += __shfl_xor(l, 16); l += __shfl_xor(l, 32);
    f32x4 o[4];
#pragma unroll
    for (int dt = 0; dt < 4; ++dt) o[dt] = (f32x4){0.f, 0.f, 0.f, 0.f};
#pragma unroll
    for (int ks = 0; ks < 5; ++ks) {
        v4u pw; pw.x = pk2(s[2 * ks][0], s[2 * ks][1]); pw.y = pk2(s[2 * ks][2], s[2 * ks][3]);
        if (ks < 4) { pw.z = pk2(s[2 * ks + 1][0], s[2 * ks + 1][1]); pw.w = pk2(s[2 * ks + 1][2], s[2 * ks + 1][3]); } else { pw.z = 0u; pw.w = 0u; }
        const bf16x8 pf = __builtin_bit_cast(bf16x8, pw);
#pragma unroll
        for (int dt = 0; dt < 4; ++dt) { const LAS bf16* vp = VT + (16 * dt + l15) * VT_STRIDE + 16 * w + 32 * ks + 4 * q4;
            const v2u lo = *(const LAS v2u*)vp, hi = *(const LAS v2u*)(vp + 16);
            v4u vw; vw.x = lo.x; vw.y = lo.y; vw.z = hi.x; vw.w = hi.y;
            o[dt] = MFMA16(__builtin_bit_cast(bf16x8, vw), pf, o[dt]); } }
    const float inv = 1.0f / l;
    bf16* op = OG + ((size_t)g * MROWS + tq) * 512 + h * 64 + 4 * q4;
#pragma unroll
    for (int dt = 0; dt < 4; ++dt) { v2u wv; wv.x = pk2(o[dt][0] * inv, o[dt][1] * inv); wv.y = pk2(o[dt][2] * inv, o[dt][3] * inv); *(v2u*)(op + 16 * dt) = wv; }
    if (q4 == 0) LSE[((size_t)g * MROWS + tq) * 8 + h] = m + __logf(l);
}
__device__ __forceinline__ void xattn_unit(ldsp lds, const bf16* U, const bf16* MKV, bf16* YC, int tile, int h, int tid) {
    const int lane = tid & 63, w = __builtin_amdgcn_readfirstlane(tid >> 6), l15 = lane & 15, q4 = lane >> 4;
    LAS bf16* VT = (LAS bf16*)lds;
    __syncthreads();
#pragma unroll
    for (int it = 0; it < 8; ++it) { const int key = (tid >> 4) + 32 * it, d8 = (tid & 15) * 8;
        const bf16x8 v = *(const bf16x8*)(MKV + (size_t)key * 1024 + 512 + h * 128 + d8);
#pragma unroll
        for (int j = 0; j < 8; ++j) VT[(d8 + j) * VT_STRIDE + key] = (bf16)v[j]; }
    __syncthreads();
    const int row = tile * 128 + w * 16 + l15;
    bf16x8 qf[4];
#pragma unroll
    for (int kk = 0; kk < 4; ++kk) qf[kk] = *(const bf16x8*)(U + (size_t)row * NIN + C_CQ + h * 128 + 32 * kk + 8 * q4);
    f32x4 s[16];
#pragma unroll
    for (int kt = 0; kt < 16; ++kt) { const bf16* kr = MKV + (size_t)(16 * kt + l15) * 1024 + h * 128 + 8 * q4;
        f32x4 a = (f32x4){0.f, 0.f, 0.f, 0.f};
#pragma unroll
        for (int kk = 0; kk < 4; ++kk) a = MFMA16(*(const bf16x8*)(kr + 32 * kk), qf[kk], a);
        s[kt] = a * 0.08838834764831845f; }
    float m = -1e30f;
#pragma unroll
    for (int kt = 0; kt < 16; ++kt)
#pragma unroll
        for (int j = 0; j < 4; ++j) m = fmaxf(m, s[kt][j]);
    m = fmaxf(m, __shfl_xor(m, 16)); m = fmaxf(m, __shfl_xor(m, 32));
    float l = 0.f;
#pragma unroll
    for (int kt = 0; kt < 16; ++kt)
#pragma unroll
        for (int j = 0; j < 4; ++j) { const float p = __expf(s[kt][j] - m); s[kt][j] = p; l += p; }
    l += __shfl_xor(l, 16); l += __shfl_xor(l, 32);
    f32x4 o[8];
#pragma unroll
    for (int dt = 0; dt < 8; ++dt) o[dt] = (f32x4){0.f, 0.f, 0.f, 0.f};
#pragma unroll
    for (int ks = 0; ks < 8; ++ks) {
        v4u pw; pw.x = pk2(s[2 * ks][0], s[2 * ks][1]); pw.y = pk2(s[2 * ks][2], s[2 * ks][3]); pw.z = pk2(s[2 * ks + 1][0], s[2 * ks + 1][1]); pw.w = pk2(s[2 * ks + 1][2], s[2 * ks + 1][3]);
        const bf16x8 pf = __builtin_bit_cast(bf16x8, pw);
#pragma unroll
        for (int dt = 0; dt < 8; ++dt) { const LAS bf16* vp = VT + (16 * dt + l15) * VT_STRIDE + 32 * ks + 4 * q4;
            const v2u lo = *(const LAS v2u*)vp, hi = *(const LAS v2u*)(vp + 16);
            v4u vw; vw.x = lo.x; vw.y = lo.y; vw.z = hi.x; vw.w = hi.y;
            o[dt] = MFMA16(__builtin_bit_cast(bf16x8, vw), pf, o[dt]); } }
    const float inv = 1.0f / l;
    const bf16* zp = U + (size_t)row * NIN + C_CZ + h * 128 + 4 * q4; bf16* op = YC + (size_t)row * 512 + h * 128 + 4 * q4;
#pragma unroll
    for (int dt = 0; dt < 8; ++dt) { const v2u z = *(const v2u*)(zp + 16 * dt); v2u wv;
        wv.x = pk2(o[dt][0] * inv * blo(z.x), o[dt][1] * inv * bhi(z.x)); wv.y = pk2(o[dt][2] * inv * blo(z.y), o[dt][3] * inv * bhi(z.y)); *(v2u*)(op + 16 * dt) = wv; }
}
__device__ __forceinline__ float lb_of(const float* lbl, int c) { return 1.0f / (1.0f + __expf(lbl[512 + c] - lbl[c])); }
__device__ __forceinline__ void hgrn_pass1_unit(ldsp lds, const bf16* U, const float* lbl, float* HU, float* HP, int h, int j, int tid) {
    LAS float* fb = (LAS float*)lds; LAS float* kb = fb + 32 * 128; LAS float* vb = kb + 32 * 128;
    const int v = tid & 127, kq = __builtin_amdgcn_readfirstlane(tid >> 7), tok = tid >> 4, c8 = (tid & 15) * 8;
    float s[32], lbr[8];
#pragma unroll
    for (int i = 0; i < 32; ++i) s[i] = 0.f;
#pragma unroll
    for (int e = 0; e < 8; ++e) lbr[e] = lb_of(lbl, h * 128 + c8 + e);
    float pacc = 1.f;
    for (int ch = 0; ch < 8; ++ch) {
        __syncthreads();
        { const size_t ro = (size_t)(j * 256 + ch * 32 + tok) * NIN + h * 128 + c8;
          const v4u fw = *(const v4u*)(U + ro + C_BF), vw = *(const v4u*)(U + ro + C_BI);
          const unsigned fa[4] = {fw.x, fw.y, fw.z, fw.w}, va[4] = {vw.x, vw.y, vw.z, vw.w};
#pragma unroll
          for (int e = 0; e < 4; ++e) { const float x0 = blo(fa[e]), x1 = bhi(fa[e]);
              const float f0 = lbr[2 * e] + (1.f - lbr[2 * e]) * sigmoid_f(x0), f1 = lbr[2 * e + 1] + (1.f - lbr[2 * e + 1]) * sigmoid_f(x1);
              const int o = tok * 128 + c8 + 2 * e;
              fb[o] = f0; fb[o + 1] = f1; kb[o] = 1.f - f0; kb[o + 1] = 1.f - f1; vb[o] = blo(va[e]); vb[o + 1] = bhi(va[e]); } }
        __syncthreads();
        for (int tt = 0; tt < 32; ++tt) { const float vv = vb[tt * 128 + v]; const LAS f32x4* f4 = (const LAS f32x4*)(fb + tt * 128 + kq * 32); const LAS f32x4* k4 = (const LAS f32x4*)(kb + tt * 128 + kq * 32);
#pragma unroll
            for (int i4 = 0; i4 < 8; ++i4) { const f32x4 f = f4[i4], k = k4[i4];
#pragma unroll
                for (int e = 0; e < 4; ++e) s[4 * i4 + e] = f[e] * s[4 * i4 + e] + k[e] * vv; } }
        if (tid < 128) { for (int tt = 0; tt < 32; ++tt) pacc *= fb[tt * 128 + tid]; }
    }
    float* up = HU + ((size_t)(j * 4 + h) * 128 + kq * 32) * 128 + v;
#pragma unroll
    for (int i = 0; i < 32; ++i) up[(size_t)i * 128] = s[i];
    if (tid < 128) HP[(size_t)(j * 4 + h) * 128 + tid] = pacc;
}
__device__ __forceinline__ void hgrn_scan_unit(const float* HU, const float* HP, float* HS, float* outS, int e, int tid) {
    const int idx = e * 512 + tid, h = idx >> 14, k = (idx >> 7) & 127, vk = idx & 16383;
    float S = 0.f;
    for (int j = 0; j < 64; ++j) { const size_t o = (size_t)(j * 4 + h) * 16384 + vk; HS[o] = S; S = HP[(size_t)(j * 4 + h) * 128 + k] * S + HU[o]; }
    outS[idx] = S;
}
__device__ __forceinline__ void hgrn_pass3_unit(ldsp lds, const bf16* U, const float* lbl, const float* hgn, const float* HS, bf16* YB, int h, int j, int tid) {
    LAS float* fb = (LAS float*)lds; LAS float* kb = fb + 32 * 128; LAS float* vb = kb + 32 * 128; LAS float* qb = vb + 32 * 128; LAS float* ob = qb + 32 * 128;
    const int lane = tid & 63, wv = tid >> 6, v = tid & 127, kq = __builtin_amdgcn_readfirstlane(tid >> 7), tok = tid >> 4, c8 = (tid & 15) * 8;
    float s[32], lbr[8];
    { const float* sp = HS + ((size_t)(j * 4 + h) * 128 + kq * 32) * 128 + v;
#pragma unroll
      for (int i = 0; i < 32; ++i) s[i] = sp[(size_t)i * 128]; }
#pragma unroll
    for (int e = 0; e < 8; ++e) lbr[e] = lb_of(lbl, h * 128 + c8 + e);
    const float g0 = hgn[h * 128 + lane], g1 = hgn[h * 128 + 64 + lane];
    for (int ch = 0; ch < 8; ++ch) {
        __syncthreads();
        { const size_t ro = (size_t)(j * 256 + ch * 32 + tok) * NIN + h * 128 + c8;
          const v4u fw = *(const v4u*)(U + ro + C_BF), vw = *(const v4u*)(U + ro + C_BI), qw = *(const v4u*)(U + ro + C_BQ);
          const unsigned fa[4] = {fw.x, fw.y, fw.z, fw.w}, va[4] = {vw.x, vw.y, vw.z, vw.w}, qa[4] = {qw.x, qw.y, qw.z, qw.w};
#pragma unroll
          for (int e = 0; e < 4; ++e) { const float x0 = blo(fa[e]), x1 = bhi(fa[e]);
              const float f0 = lbr[2 * e] + (1.f - lbr[2 * e]) * sigmoid_f(x0), f1 = lbr[2 * e + 1] + (1.f - lbr[2 * e + 1]) * sigmoid_f(x1);
              const int o = tok * 128 + c8 + 2 * e;
              fb[o] = f0; fb[o + 1] = f1; kb[o] = 1.f - f0; kb[o + 1] = 1.f - f1; vb[o] = blo(va[e]); vb[o + 1] = bhi(va[e]); qb[o] = blo(qa[e]); qb[o + 1] = bhi(qa[e]); } }
        __syncthreads();
        for (int tt = 0; tt < 32; ++tt) { const float vv = vb[tt * 128 + v]; const LAS f32x4* f4 = (const LAS f32x4*)(fb + tt * 128 + kq * 32); const LAS f32x4* k4 = (const LAS f32x4*)(kb + tt * 128 + kq * 32); const LAS f32x4* q4p = (const LAS f32x4*)(qb + tt * 128 + kq * 32);
            float acc = 0.f;
#pragma unroll
            for (int i4 = 0; i4 < 8; ++i4) { const f32x4 f = f4[i4], k = k4[i4], q = q4p[i4];
#pragma unroll
                for (int e = 0; e < 4; ++e) { s[4 * i4 + e] = f[e] * s[4 * i4 + e] + k[e] * vv; acc += s[4 * i4 + e] * q[e]; } }
            ob[(tt * 4 + kq) * 128 + v] = acc; }
        __syncthreads();
#pragma unroll
        for (int q = 0; q < 4; ++q) { const int tt = wv * 4 + q; const LAS float* op = ob + tt * 512;
            const float o0 = (op[lane] + op[128 + lane]) + (op[256 + lane] + op[384 + lane]), o1 = (op[64 + lane] + op[192 + lane]) + (op[320 + lane] + op[448 + lane]);
            const float rstd = rsqrtf(wave_sum(o0 * o0 + o1 * o1) * (1.f / 128.f) + EPS);
            const size_t t = (size_t)(j * 256 + ch * 32 + tt);
            const bf16* zp = U + t * NIN + C_BZ + h * 128; bf16* yp = YB + t * 512 + h * 128;
            yp[lane] = (bf16)f2bf(o0 * rstd * g0 * b2f(zp[lane])); yp[64 + lane] = (bf16)f2bf(o1 * rstd * g1 * b2f(zp[64 + lane])); }
    }
}
constexpr int HG_QT_STRIDE = 136, HG_KH_STRIDE = 40;
template <bool OUT>
__device__ __forceinline__ void hgrn_mfma_unit(ldsp lds, const bf16* U, const float* lbl, const float* hgn, const float* HS, float* HU, float* HP, bf16* YB, int h, int j, int tid) {
    const int lane = tid & 63, w = __builtin_amdgcn_readfirstlane(tid >> 6), l15 = lane & 15, q4 = lane >> 4;
    const int k = tid & 127, tq = tid >> 7, tok = tid >> 4, c8 = (tid & 15) * 8;
    LAS bf16* RAWQ = (LAS bf16*)lds; LAS bf16* RAWF = RAWQ + 4096; LAS bf16* RAWV = RAWF + 4096;
    LAS float* QS = (LAS float*)(lds + 24576); LAS float* DC = (LAS float*)(lds + 26624);
    LAS bf16* QT = (LAS bf16*)(lds + 27136); LAS bf16* KT = (LAS bf16*)(lds + 35840); LAS bf16* KH = (LAS bf16*)(lds + 44544); LAS bf16* VT = (LAS bf16*)(lds + 54784);
    LAS float* SSQ = (LAS float*)(lds + 65024);
    const float lb = lb_of(lbl, h * 128 + k), oml = 1.f - lb;
    f32x4 S[8];
    if (OUT) { const float* sp = HS + (size_t)(j * 4 + h) * 16384 + (size_t)(4 * q4) * 128 + 16 * w + l15;
#pragma unroll
        for (int kt = 0; kt < 8; ++kt)
#pragma unroll
            for (int r = 0; r < 4; ++r) S[kt][r] = sp[(size_t)(16 * kt + r) * 128]; }
    else {
#pragma unroll
        for (int kt = 0; kt < 8; ++kt) S[kt] = (f32x4){0.f, 0.f, 0.f, 0.f}; }
    float ptot = 0.f;
    v4u rq, rf, rv;
    { const size_t ro = (size_t)(j * 256 + tok) * NIN + h * 128 + c8; rf = *(const v4u*)(U + ro + C_BF); rv = *(const v4u*)(U + ro + C_BI); if (OUT) rq = *(const v4u*)(U + ro + C_BQ); else rq = rf; }
    for (int ch = 0; ch < 8; ++ch) {
        __syncthreads();
        *(LAS v4u*)(RAWF + tok * 128 + c8) = rf; *(LAS v4u*)(RAWV + tok * 128 + c8) = rv; if (OUT) *(LAS v4u*)(RAWQ + tok * 128 + c8) = rq;
        if (ch < 7) { const size_t ro = (size_t)(j * 256 + (ch + 1) * 32 + tok) * NIN + h * 128 + c8; rf = *(const v4u*)(U + ro + C_BF); rv = *(const v4u*)(U + ro + C_BI); if (OUT) rq = *(const v4u*)(U + ro + C_BQ); }
        __syncthreads();
        float kin[8], cum[8]; float c = 0.f;
#pragma unroll
        for (int i = 0; i < 8; ++i) { const float x = b2f(RAWF[(8 * tq + i) * 128 + k]); const float f = lb + oml * sigmoid_f(x); kin[i] = 1.f - f; c += __logf(f); cum[i] = c; }
        QS[tq * 128 + k] = c;
        __syncthreads();
        const float q0 = QS[k], q1 = QS[128 + k], q2 = QS[256 + k], q3 = QS[384 + k];
        const float pre = (tq > 0 ? q0 : 0.f) + (tq > 1 ? q1 : 0.f) + (tq > 2 ? q2 : 0.f), tot = (q0 + q1) + (q2 + q3);
        { unsigned khw[4], vtw[4];
#pragma unroll
          for (int i2 = 0; i2 < 4; ++i2) { float kh2[2]; unsigned short vv2[2];
#pragma unroll
              for (int e = 0; e < 2; ++e) { const int i = 2 * i2 + e, t = 8 * tq + i; const float b = pre + cum[i];
                  if (OUT) { const float eb = __expf(b); QT[t * HG_QT_STRIDE + k] = (bf16)f2bf(b2f(RAWQ[t * 128 + k]) * eb); KT[t * HG_QT_STRIDE + k] = (bf16)f2bf(kin[i] * __expf(fminf(-b, 80.f))); }
                  kh2[e] = kin[i] * __expf(tot - b); vv2[e] = RAWV[t * 128 + k]; }
              khw[i2] = pk2(kh2[0], kh2[1]); vtw[i2] = (unsigned)vv2[0] | ((unsigned)vv2[1] << 16); }
          v4u a; a.x = khw[0]; a.y = khw[1]; a.z = khw[2]; a.w = khw[3]; *(LAS v4u*)(KH + k * HG_KH_STRIDE + 8 * tq) = a;
          v4u b; b.x = vtw[0]; b.y = vtw[1]; b.z = vtw[2]; b.w = vtw[3]; *(LAS v4u*)(VT + k * HG_KH_STRIDE + 8 * tq) = b; }
        if (tq == 0) { DC[k] = __expf(tot); ptot += tot; }
        __syncthreads();
        const bf16x8 vnat = *(const LAS bf16x8*)(VT + (16 * w + l15) * HG_KH_STRIDE + 8 * q4);
        f32x4 o[2];
        if (OUT) {
            f32x4 a00 = (f32x4){0.f, 0.f, 0.f, 0.f}, a01 = a00, a11 = a00;
#pragma unroll
            for (int kk = 0; kk < 4; ++kk) { const bf16x8 k0 = *(const LAS bf16x8*)(KT + l15 * HG_QT_STRIDE + 32 * kk + 8 * q4), k1 = *(const LAS bf16x8*)(KT + (16 + l15) * HG_QT_STRIDE + 32 * kk + 8 * q4);
                const bf16x8 t0 = *(const LAS bf16x8*)(QT + l15 * HG_QT_STRIDE + 32 * kk + 8 * q4), t1 = *(const LAS bf16x8*)(QT + (16 + l15) * HG_QT_STRIDE + 32 * kk + 8 * q4);
                a00 = MFMA16(k0, t0, a00); a01 = MFMA16(k0, t1, a01); a11 = MFMA16(k1, t1, a11); }
#pragma unroll
            for (int r = 0; r < 4; ++r) { const bool ok = (4 * q4 + r) <= l15; a00[r] = ok ? a00[r] : 0.f; a11[r] = ok ? a11[r] : 0.f; }
            v4u p0, p1; p0.x = pk2(a00[0], a00[1]); p0.y = pk2(a00[2], a00[3]); p0.z = 0u; p0.w = 0u;
            p1.x = pk2(a01[0], a01[1]); p1.y = pk2(a01[2], a01[3]); p1.z = pk2(a11[0], a11[1]); p1.w = pk2(a11[2], a11[3]);
            const LAS bf16* vp = VT + (16 * w + l15) * HG_KH_STRIDE + 4 * q4; const v2u vlo = *(const LAS v2u*)vp, vhi = *(const LAS v2u*)(vp + 16);
            v4u vw; vw.x = vlo.x; vw.y = vlo.y; vw.z = vhi.x; vw.w = vhi.y; const bf16x8 vperm = __builtin_bit_cast(bf16x8, vw);
            o[0] = MFMA16(vperm, __builtin_bit_cast(bf16x8, p0), ((f32x4){0.f, 0.f, 0.f, 0.f}));
            o[1] = MFMA16(vperm, __builtin_bit_cast(bf16x8, p1), ((f32x4){0.f, 0.f, 0.f, 0.f}));
#pragma unroll
            for (int kk = 0; kk < 4; ++kk) { v4u sw; sw.x = pk2(S[2 * kk][0], S[2 * kk][1]); sw.y = pk2(S[2 * kk][2], S[2 * kk][3]); sw.z = pk2(S[2 * kk + 1][0], S[2 * kk + 1][1]); sw.w = pk2(S[2 * kk + 1][2], S[2 * kk + 1][3]);
                const bf16x8 sf = __builtin_bit_cast(bf16x8, sw);
#pragma unroll
                for (int tt = 0; tt < 2; ++tt) { const LAS bf16* qp = QT + (16 * tt + l15) * HG_QT_STRIDE + 32 * kk + 4 * q4; const v2u qlo = *(const LAS v2u*)qp, qhi = *(const LAS v2u*)(qp + 16);
                    v4u qw; qw.x = qlo.x; qw.y = qlo.y; qw.z = qhi.x; qw.w = qhi.y; o[tt] = MFMA16(sf, __builtin_bit_cast(bf16x8, qw), o[tt]); } }
        }
#pragma unroll
        for (int kt = 0; kt < 8; ++kt) { const f32x4 d = *(const LAS f32x4*)(DC + 16 * kt + 4 * q4); const bf16x8 kf = *(const LAS bf16x8*)(KH + (16 * kt + l15) * HG_KH_STRIDE + 8 * q4);
            S[kt] = MFMA16(kf, vnat, S[kt] * d); }
        if (OUT) {
#pragma unroll
            for (int tt = 0; tt < 2; ++tt) { float p = (o[tt][0] * o[tt][0] + o[tt][1] * o[tt][1]) + (o[tt][2] * o[tt][2] + o[tt][3] * o[tt][3]); p += __shfl_xor(p, 16); p += __shfl_xor(p, 32); if (q4 == 0) SSQ[w * 32 + 16 * tt + l15] = p; }
            __syncthreads();
            const f32x4 g4 = *(const f32x4*)(hgn + h * 128 + 16 * w + 4 * q4);
#pragma unroll
            for (int tt = 0; tt < 2; ++tt) { float ss = 0.f;
#pragma unroll
                for (int q = 0; q < 8; ++q) ss += SSQ[q * 32 + 16 * tt + l15];
                const float rstd = rsqrtf(ss * (1.f / 128.f) + EPS);
                const size_t t = (size_t)(j * 256 + ch * 32 + 16 * tt + l15);
                const v2u z = *(const v2u*)(U + t * NIN + C_BZ + h * 128 + 16 * w + 4 * q4); v2u y;
                y.x = pk2(o[tt][0] * rstd * g4[0] * blo(z.x), o[tt][1] * rstd * g4[1] * bhi(z.x)); y.y = pk2(o[tt][2] * rstd * g4[2] * blo(z.y), o[tt][3] * rstd * g4[3] * bhi(z.y));
                *(v2u*)(YB + t * 512 + h * 128 + 16 * w + 4 * q4) = y; }
        }
    }
    if (!OUT) { float* up = HU + (size_t)(j * 4 + h) * 16384 + (size_t)(4 * q4) * 128 + 16 * w + l15;
#pragma unroll
        for (int kt = 0; kt < 8; ++kt)
#pragma unroll
            for (int r = 0; r < 4; ++r) up[(size_t)(16 * kt + r) * 128] = S[kt][r];
        if (tq == 0) HP[(size_t)(j * 4 + h) * 128 + k] = __expf(ptot); }
}
__device__ __forceinline__ void attn_merge_row(const bf16* U, const bf16* OG, const float* LSE, bf16* YA, int t, int lane) {
    const int hd = lane >> 3, c8 = lane * 8;
    const float l0 = LSE[((size_t)0 * MROWS + t) * 8 + hd], l1 = LSE[((size_t)1 * MROWS + t) * 8 + hd], l2 = LSE[((size_t)2 * MROWS + t) * 8 + hd];
    const float mx = fmaxf(l0, fmaxf(l1, l2)); float w0 = __expf(l0 - mx), w1 = __expf(l1 - mx), w2 = __expf(l2 - mx); const float inv = 1.f / (w0 + w1 + w2); w0 *= inv; w1 *= inv; w2 *= inv;
    const v4u a = *(const v4u*)(OG + ((size_t)0 * MROWS + t) * 512 + c8), b = *(const v4u*)(OG + ((size_t)1 * MROWS + t) * 512 + c8), c = *(const v4u*)(OG + ((size_t)2 * MROWS + t) * 512 + c8);
    const v4u z = *(const v4u*)(U + (size_t)t * NIN + C_AZ + c8);
    const unsigned aa[4] = {a.x, a.y, a.z, a.w}, ba[4] = {b.x, b.y, b.z, b.w}, ca[4] = {c.x, c.y, c.z, c.w}, za[4] = {z.x, z.y, z.z, z.w}; unsigned oa[4];
#pragma unroll
    for (int e = 0; e < 4; ++e) oa[e] = pk2((w0 * blo(aa[e]) + w1 * blo(ba[e]) + w2 * blo(ca[e])) * blo(za[e]), (w0 * bhi(aa[e]) + w1 * bhi(ba[e]) + w2 * bhi(ca[e])) * bhi(za[e]));
    v4u o; o.x = oa[0]; o.y = oa[1]; o.z = oa[2]; o.w = oa[3]; *(v4u*)(YA + (size_t)t * 512 + c8) = o;
}
__device__ __forceinline__ void samp_attn_unit(const Args& A, const bf16* U, bf16* YA, int b, int tid) {
    const int lane = tid & 63, h = tid >> 6, ks = lane >> 4, dp = lane & 15; const size_t row = T_SEQ + b; const bf16* ur = U + row * NIN;
    float m = -1e30f, l = 0.f; f32x4 acc = (f32x4){0.f, 0.f, 0.f, 0.f};
#pragma unroll
    for (int g = 0; g < 3; ++g) { const int dil = (g == 0) ? 1 : (g == 1 ? 4 : 16), Wb = 128 * dil; const float* cache = ((g == 0) ? A.c128 : (g == 1 ? A.c512 : A.c2048)) + (size_t)b * Wb * 1024 + h * 64 + 4 * dp;
        const v2u qw = *(const v2u*)(ur + C_AQ + g * 512 + h * 64 + 4 * dp); const f32x4 q = (f32x4){blo(qw.x), bhi(qw.x), blo(qw.y), bhi(qw.y)};
        if (ks == 0) { const v2u kw = *(const v2u*)(ur + C_AK + g * 512 + h * 64 + 4 * dp), vw = *(const v2u*)(ur + C_AV + g * 512 + h * 64 + 4 * dp);
            float sc = q[0] * blo(kw.x) + q[1] * bhi(kw.x) + q[2] * blo(kw.y) + q[3] * bhi(kw.y);
            sc += __shfl_xor(sc, 1); sc += __shfl_xor(sc, 2); sc += __shfl_xor(sc, 4); sc += __shfl_xor(sc, 8);
            const float mn = fmaxf(m, sc), corr = __expf(m - mn), pe = __expf(sc - mn); l = l * corr + pe;
            acc = acc * corr + pe * (f32x4){blo(vw.x), bhi(vw.x), blo(vw.y), bhi(vw.y)}; m = mn; }
#pragma unroll 4
        for (int it = 0; it < 32; ++it) { const int jj = 1 + ks + 4 * it, idx = Wb - dil * jj; const float* kp = cache + (size_t)idx * 1024;
            const f32x4 k4 = *(const f32x4*)kp, v4 = *(const f32x4*)(kp + 512);
            float sc = (q[0] * k4[0] + q[1] * k4[1]) + (q[2] * k4[2] + q[3] * k4[3]);
            sc += __shfl_xor(sc, 1); sc += __shfl_xor(sc, 2); sc += __shfl_xor(sc, 4); sc += __shfl_xor(sc, 8);
            const float mn = fmaxf(m, sc), corr = __expf(m - mn), pe = __expf(sc - mn); l = l * corr + pe; acc = acc * corr + pe * v4; m = mn; } }
    float ma = fmaxf(m, __shfl_xor(m, 16)); ma = fmaxf(ma, __shfl_xor(ma, 32));
    const float sc = __expf(m - ma); l *= sc; acc = acc * sc;
    l += __shfl_xor(l, 16); l += __shfl_xor(l, 32);
#pragma unroll
    for (int e = 0; e < 4; ++e) { acc[e] += __shfl_xor(acc[e], 16); acc[e] += __shfl_xor(acc[e], 32); }
    if (ks == 0) { const float inv = 1.f / l; const v2u z = *(const v2u*)(ur + C_AZ + h * 64 + 4 * dp); v2u o;
        o.x = pk2(acc[0] * inv * blo(z.x), acc[1] * inv * bhi(z.x)); o.y = pk2(acc[2] * inv * blo(z.y), acc[3] * inv * bhi(z.y)); *(v2u*)(YA + row * 512 + h * 64 + 4 * dp) = o; }
}
__device__ __forceinline__ void samp_hgrn_unit(ldsp lds, const Args& A, const bf16* U, bf16* YB, int b, int h, int tid) {
    LAS float* fb = (LAS float*)lds; LAS float* kb = fb + 128; LAS float* qb = kb + 128; LAS float* red = qb + 128;
    const size_t row = T_SEQ + b; const bf16* ur = U + row * NIN;
    __syncthreads();
    if (tid < 128) { const float lb = lb_of(A.lbl, h * 128 + tid), f = lb + (1.f - lb) * sigmoid_f(b2f(ur[C_BF + h * 128 + tid])); fb[tid] = f; kb[tid] = 1.f - f; qb[tid] = b2f(ur[C_BQ + h * 128 + tid]); }
    __syncthreads();
    const int v4i = (tid & 31) * 4, kk = tid >> 5;
    const v2u vw = *(const v2u*)(ur + C_BI + h * 128 + v4i); const f32x4 vv = (f32x4){blo(vw.x), bhi(vw.x), blo(vw.y), bhi(vw.y)};
    const float* sp = A.sth + (size_t)(b * 4 + h) * 16384; float* dp = A.out + O_HGS + (size_t)(b * 4 + h) * 16384;
    f32x4 oacc = (f32x4){0.f, 0.f, 0.f, 0.f};
#pragma unroll
    for (int p = 0; p < 8; ++p) { const int k = kk + 16 * p; const f32x4 S = *(const f32x4*)(sp + k * 128 + v4i); const f32x4 Sn = fb[k] * S + kb[k] * vv; *(f32x4*)(dp + k * 128 + v4i) = Sn; oacc += Sn * qb[k]; }
    *(LAS f32x4*)(red + kk * 128 + v4i) = oacc;
    __syncthreads();
    if (tid < 64) { float o0 = 0.f, o1 = 0.f;
#pragma unroll
        for (int q = 0; q < 16; ++q) { o0 += red[q * 128 + tid]; o1 += red[q * 128 + 64 + tid]; }
        const float rstd = rsqrtf(wave_sum(o0 * o0 + o1 * o1) * (1.f / 128.f) + EPS);
        bf16* yp = YB + row * 512 + h * 128;
        yp[tid] = (bf16)f2bf(o0 * rstd * A.hgn[h * 128 + tid] * b2f(ur[C_BZ + h * 128 + tid])); yp[64 + tid] = (bf16)f2bf(o1 * rstd * A.hgn[h * 128 + 64 + tid] * b2f(ur[C_BZ + h * 128 + 64 + tid])); }
}
__device__ __forceinline__ void samp_xattn_unit(ldsp lds, const Args& A, const bf16* U, bf16* YC, int b, int h, int tid) {
    LAS float* part = (LAS float*)lds;
    const int lane = tid & 63, w = tid >> 6, sub = lane >> 5, dp = lane & 31; const size_t row = T_SEQ + b; const bf16* ur = U + row * NIN;
    const v2u qw = *(const v2u*)(ur + C_CQ + h * 128 + 4 * dp); const f32x4 q = (f32x4){blo(qw.x), bhi(qw.x), blo(qw.y), bhi(qw.y)} * 0.08838834764831845f;
    const float* mem = A.cmem + (size_t)b * 256 * 1024 + h * 128 + 4 * dp;
    float m = -1e30f, l = 0.f; f32x4 acc = (f32x4){0.f, 0.f, 0.f, 0.f};
#pragma unroll 4
    for (int it = 0; it < 16; ++it) { const float* kp = mem + (size_t)(32 * w + 2 * it + sub) * 1024; const f32x4 k4 = *(const f32x4*)kp, v4 = *(const f32x4*)(kp + 512);
        float sc = (q[0] * k4[0] + q[1] * k4[1]) + (q[2] * k4[2] + q[3] * k4[3]);
        sc += __shfl_xor(sc, 1); sc += __shfl_xor(sc, 2); sc += __shfl_xor(sc, 4); sc += __shfl_xor(sc, 8); sc += __shfl_xor(sc, 16);
        const float mn = fmaxf(m, sc), corr = __expf(m - mn), pe = __expf(sc - mn); l = l * corr + pe; acc = acc * corr + pe * v4; m = mn; }
    const float ma = fmaxf(m, __shfl_xor(m, 32)); const float sc = __expf(m - ma); l *= sc; acc = acc * sc; l += __shfl_xor(l, 32);
#pragma unroll
    for (int e = 0; e < 4; ++e) acc[e] += __shfl_xor(acc[e], 32);
    __syncthreads();
    if (sub == 0) { *(LAS f32x4*)(part + w * 132 + 4 * dp) = acc; if (dp == 0) { part[w * 132 + 128] = ma; part[w * 132 + 129] = l; } }
    __syncthreads();
    if (tid < 128) { float M = -1e30f;
#pragma unroll
        for (int q8 = 0; q8 < 8; ++q8) M = fmaxf(M, part[q8 * 132 + 128]);
        float L = 0.f, O = 0.f;
#pragma unroll
        for (int q8 = 0; q8 < 8; ++q8) { const float e = __expf(part[q8 * 132 + 128] - M); L += part[q8 * 132 + 129] * e; O += part[q8 * 132 + tid] * e; }
        YC[row * 512 + h * 128 + tid] = (bf16)f2bf(O / L * b2f(ur[C_CZ + h * 128 + tid])); }
}
__device__ __forceinline__ void final_row(const float* z, const float* hrow, const float* g, float* yrow, int lane) {
    const f32x4* zr = (const f32x4*)z + lane; const f32x4* hr = (const f32x4*)hrow + lane; const f32x4* gr = (const f32x4*)g + lane; f32x4* yr = (f32x4*)yrow + lane;
    f32x4 v[4]; float s = 0.f;
#pragma unroll
    for (int j = 0; j < 4; ++j) { v[j] = zr[64 * j]; s += (v[j].x * v[j].x + v[j].y * v[j].y) + (v[j].z * v[j].z + v[j].w * v[j].w); }
    const float rstd = rsqrtf(wave_sum(s) * (1.f / 1024.f) + EPS);
#pragma unroll
    for (int j = 0; j < 4; ++j) yr[64 * j] = hr[64 * j] + v[j] * rstd * gr[64 * j];
}
__global__ void __launch_bounds__(512, 2) fwd_kernel(Args A) {
    extern __shared__ __attribute__((aligned(16))) unsigned char lds_raw[];
    ldsp lds = (ldsp)lds_raw;
    volatile LAS unsigned* MISC = (volatile LAS unsigned*)(lds + MISC_OFF);
    const int tid = threadIdx.x, lane = tid & 63, wave = tid >> 6, G = gridDim.x, bid = blockIdx.x;
    for (int u = tid; u < (LDS_BYTES - LDSCTL_OFF) / 4; u += 512) ((LAS unsigned*)(lds + LDSCTL_OFF))[u] = 0u;
    __syncthreads();
    unsigned char* ws = A.ws;
    unsigned* ctl = (unsigned*)(ws + WS_CTL);
    XcdBarrier bar = xcd_barrier_post(ctl + CW_BAR, MISC + 8);
    bf16* U = (bf16*)(ws + WS_U); bf16* MKV = (bf16*)(ws + WS_MEMKV);
    bf16* YA = (bf16*)(ws + WS_YA); bf16* YB = (bf16*)(ws + WS_YB); bf16* YC = (bf16*)(ws + WS_YC);
    bf16* OG = (bf16*)(ws + WS_OG); float* LSE = (float*)(ws + WS_LSE);
    float* HU = (float*)(ws + WS_HU); float* HP = (float*)(ws + WS_HP); float* HS = (float*)(ws + WS_HS);

    p0_prologue(A, lds, tid, G);
    xcd_barrier(bar);

    { pg8::Gemm g{(const pg8::bf16_t*)(ws + WS_MN), (const pg8::bf16_t*)(ws + WS_WMEM), 256, 1024, 1024}; pg8::StaticOrder S; S.init(256, 1024, G, (bid + 4) % G);
      pg8::EpiMem E{A.out + O_MEMKV, (pg8::bf16_t*)MKV};
      pg8::gemm_phase<pg8::EpiMem, pg8::StaticOrder, false, PG8_SP2>(lds, g, S, E); }
    __syncthreads();
    { pg8::Gemm g{(const pg8::bf16_t*)(ws + WS_XN), (const pg8::bf16_t*)(ws + WS_WIN), MROWS, NIN, 1024}; pg8::StaticOrder S; S.init(MROWS, NIN, G, bid);
      pg8::EpiU E{(pg8::bf16_t*)U, (const float*)(ws + WS_CS), A.out};
      pg8::gemm_phase<pg8::EpiU, pg8::StaticOrder, PG8_ALIGN, PG8_SP2>(lds, g, S, E); }
    xcd_barrier(bar);

    for (int u = bid; u < 128; u += G) samp_attn_unit(A, U, YA, u, tid);
    for (int u = bid; u < 512; u += G) samp_xattn_unit(lds, A, U, YC, u >> 2, u & 3, tid);
    for (int u = bid; u < 512; u += G) samp_hgrn_unit(lds, A, U, YB, u >> 2, u & 3, tid);
    for (int u = bid; u < 256; u += G) hgrn_mfma_unit<false>(lds, U, A.lbl, A.hgn, HS, HU, HP, YB, u & 3, u >> 2, tid);
    for (int u = bid; u < 3072; u += G) { const int g = u >> 10, rem = u & 1023, h = rem & 7, rb = rem >> 3, dil = (g == 0) ? 1 : (g == 1 ? 4 : 16), nblk = 128 / dil;
        attn_dil_unit(lds, U, OG, LSE, g, dil, rb / nblk, rb % nblk, h, tid); }
    for (int u = bid; u < 512; u += G) xattn_unit(lds, U, MKV, YC, u >> 2, u & 3, tid);
    xcd_barrier(bar);

    for (int u = bid; u < 128; u += G) hgrn_scan_unit(HU, HP, HS, A.out + O_HGP, u, tid);
    for (int t = bid * 8 + wave; t < T_SEQ; t += G * 8) attn_merge_row(U, OG, LSE, YA, t, lane);
    xcd_barrier(bar);

    for (int u = bid; u < 256; u += G) hgrn_mfma_unit<true>(lds, U, A.lbl, A.hgn, HS, HU, HP, YB, u & 3, u >> 2, tid);
    xcd_barrier(bar);

    { pg8::StaticOrder S; S.init(MROWS, 1024, G, bid);
      { pg8::Gemm g{(const pg8::bf16_t*)YA, (const pg8::bf16_t*)(ws + WS_WPA), MROWS, 1024, 512}; pg8::EpiBranch<0> E{(const pg8::bf16_t*)U, (float*)(ws + WS_M32), (pg8::bf16_t*)(ws + WS_MG)};
        pg8::gemm_phase<pg8::EpiBranch<0>, pg8::StaticOrder, PG8_ALIGN, PG8_SP2>(lds, g, S, E); }
      __syncthreads();
      { pg8::Gemm g{(const pg8::bf16_t*)YB, (const pg8::bf16_t*)(ws + WS_WPB), MROWS, 1024, 512}; pg8::EpiBranch<1> E{(const pg8::bf16_t*)U, (float*)(ws + WS_M32), (pg8::bf16_t*)(ws + WS_MG)};
        pg8::gemm_phase<pg8::EpiBranch<1>, pg8::StaticOrder, PG8_ALIGN, PG8_SP2>(lds, g, S, E); }
      __syncthreads();
      { pg8::Gemm g{(const pg8::bf16_t*)YC, (const pg8::bf16_t*)(ws + WS_WPC), MROWS, 1024, 512}; pg8::EpiBranch<2> E{(const pg8::bf16_t*)U, (float*)(ws + WS_M32), (pg8::bf16_t*)(ws + WS_MG)};
        pg8::gemm_phase<pg8::EpiBranch<2>, pg8::StaticOrder, PG8_ALIGN, PG8_SP2>(lds, g, S, E); } }
    xcd_barrier(bar);

    { pg8::Gemm g{(const pg8::bf16_t*)(ws + WS_MG), (const pg8::bf16_t*)(ws + WS_WOUT), MROWS, 1024, 1024}; pg8::StaticOrder S; S.init(MROWS, 1024, G, bid);
      pg8::EpiZ E{(float*)(ws + WS_Z)};
      pg8::gemm_phase<pg8::EpiZ, pg8::StaticOrder, PG8_ALIGN, PG8_SP2>(lds, g, S, E); }
    xcd_barrier(bar);

    { const float* Z = (const float*)(ws + WS_Z);
      for (int m = bid * 8 + wave; m < T_SEQ + NSAMP; m += G * 8) {
          if (m < T_SEQ) final_row(Z + (size_t)m * 1024, A.xp + (size_t)m * 1024, A.npost, A.out + O_YP + (size_t)m * 1024, lane);
          else final_row(Z + (size_t)m * 1024, A.xs + (size_t)(m - T_SEQ) * 1024, A.npost, A.out + O_YS + (size_t)(m - T_SEQ) * 1024, lane); } }
}

extern "C" void kernel_launch(void* const* d_in, const int* in_sizes, int n_in, void* d_out, int out_size, void* d_ws, size_t ws_size, hipStream_t stream) {
    static int grid = 0;
    if (grid == 0) {
        if (n_in != 19 || out_size != (int)O_END || ws_size < WS_END) { fprintf(stderr, "kernel_launch: unexpected shapes (n_in %d, out %d, ws %zu); nothing launched\n", n_in, out_size, ws_size); grid = -1; return; }
        int dev = 0, cus = 0, per_cu = 0;
        if (hipGetDevice(&dev) != hipSuccess || hipDeviceGetAttribute(&cus, hipDeviceAttributeMultiprocessorCount, dev) != hipSuccess) { grid = -1; return; }
        if (hipFuncSetAttribute((const void*)fwd_kernel, hipFuncAttributeMaxDynamicSharedMemorySize, LDS_BYTES) != hipSuccess) { fprintf(stderr, "kernel_launch: hipFuncSetAttribute failed\n"); grid = -1; return; }
        if (hipOccupancyMaxActiveBlocksPerMultiprocessor(&per_cu, (const void*)fwd_kernel, 512, LDS_BYTES) != hipSuccess || per_cu < 1) { fprintf(stderr, "kernel_launch: occupancy query says %d blocks per CU\n", per_cu); per_cu = 1; }
        (void)hipGetLastError();
        grid = cus;
    }
    if (grid < 0) return;
    if (hipMemsetAsync((char*)d_ws + WS_CTL, 0, CTL_ZERO_BYTES, stream) != hipSuccess) return;
    Args a{};
    a.xp = (const float*)d_in[0]; a.xs = (const float*)d_in[1]; a.memp = (const float*)d_in[2]; a.c128 = (const float*)d_in[3]; a.c512 = (const float*)d_in[4]; a.c2048 = (const float*)d_in[5];
    a.sth = (const float*)d_in[6]; a.cmem = (const float*)d_in[7]; a.npre = (const float*)d_in[8]; a.npost = (const float*)d_in[9]; a.win = (const float*)d_in[10]; a.lbl = (const float*)d_in[11];
    a.hgn = (const float*)d_in[12]; a.mnorm = (const float*)d_in[13]; a.wmem = (const float*)d_in[14]; a.wpa = (const float*)d_in[15]; a.wpb = (const float*)d_in[16]; a.wpc = (const float*)d_in[17]; a.wout = (const float*)d_in[18];
    a.out = (float*)d_out; a.ws = (unsigned char*)d_ws;
    hipLaunchKernelGGL(fwd_kernel, dim3(grid), dim3(512), LDS_BYTES, stream, a);
    const hipError_t le = hipPeekAtLastError();
    if (le != hipSuccess) fprintf(stderr, "kernel_launch: launch failed: %s\n", hipGetErrorName(le));
}
```

```cpp
#include <hip/hip_runtime.h>
#include <cstdio>
#include <cstdint>
constexpr int T_SEQ = 16384, DMODEL = 1024, NSAMP = 128, MROWS = 16640  , NIN = 11264;
constexpr int C_AQ = 0, C_AK = 1536, C_AV = 3072, C_AZ = 4608, C_BQ = 5120, C_BF = 5632, C_BI = 6144, C_BZ = 6656, C_CQ = 7168, C_CZ = 7680, C_GA = 8192;
constexpr float EPS = 1e-6f;
constexpr int YPITCH = 1536;
constexpr size_t O_YP = 0, O_YS = 16777216, O_W128P = 16908288, O_W512P = 17039360, O_W2048P = 17563648, O_HGP = 19660800, O_MEMKV = 19726336,
                 O_W128S = 19988480, O_W512S = 20119552, O_W2048S = 20250624, O_HGS = 20381696, O_END = 28770304;
constexpr size_t MiB = 1u << 20;
constexpr size_t WS_CTL = 0, CTL_ZERO_BYTES = 1 * MiB;
constexpr size_t WS_WIN = 2 * MiB, WS_WMEM = 24 * MiB, WS_WPA = 26 * MiB, WS_WPB = 27 * MiB, WS_WPC = 28 * MiB, WS_WOUT = 29 * MiB, WS_MN = 31 * MiB, WS_MEMKV = 31 * MiB + 512 * 1024;
constexpr size_t WS_CS = 32 * MiB, WS_XN = 36 * MiB, WS_U = 70 * MiB, WS_OG = 428 * MiB, WS_LSE = 477 * MiB, WS_HU = 479 * MiB, WS_HP = 495 * MiB, WS_HS = 496 * MiB;
constexpr size_t WS_YA = 512 * MiB, WS_YB = 529 * MiB, WS_YC = 546 * MiB, WS_M32 = 563 * MiB, WS_MG = 628 * MiB, WS_Z = 661 * MiB, WS_GT = 726 * MiB, WS_END = 824 * MiB;
constexpr int CW_BAR = 4096;
namespace pg8 {
#define PG8_LAS __attribute__((address_space(3)))
typedef unsigned short bf16_t;
typedef short bf16x8 __attribute__((ext_vector_type(8)));
typedef float f32x4 __attribute__((ext_vector_type(4)));
typedef unsigned u32x4 __attribute__((ext_vector_type(4)));
constexpr int BM = 256, BK = 64, HALF = 128, HTB = HALF * BK * 2  , STAGE_BYTES = 8 * HTB, NXCD = 8, WGM = 8;

__host__ __device__ __forceinline__ int lds_byte(int r, int c) { const int st = (r >> 4) * 2 + (c >> 5), rr = r & 15, cc = c & 31, ob = rr * 64 + cc * 2; return st * 1024 + (ob ^ (((ob >> 9) & 1) << 5)); }
__host__ __device__ __forceinline__ void stage_rc(int b, int& R, int& C) { const int st = b / 1024, sb = b % 1024, swz = sb ^ (((sb >> 9) & 1) << 5); R = (st >> 1) * 16 + swz / 64; C = (st & 1) * 32 + (swz % 64) / 2; }
__host__ __device__ __forceinline__ int perm32(int rho) { const int n = rho >> 4, i = rho & 15; return 8 * (i >> 2) + 4 * n + (i & 3); }

struct Unit { int pm, pn; };
struct Gemm { const bf16_t* A; const bf16_t* Bt; int M, N, K; };

struct StaticOrder {
    int nM, nN, nwg, G, c;
    __host__ __device__ void init(int M, int N, int G_, int c_) { nM = M / BM; nN = N / BM; nwg = nM * nN; G = G_; c = c_; }
    __host__ __device__ bool next(int i, Unit& u) const {
        const long L = (long)i * G + c; if (L >= nwg) return false;
        int wgid = (int)L; { const int q = nwg / NXCD, r = nwg % NXCD, xcd = wgid % NXCD, off = wgid / NXCD; wgid = (xcd < r ? xcd * (q + 1) : r * (q + 1) + (xcd - r) * q) + off; }
        const int nig = WGM * nN, gid = wgid / nig, fm = gid * WGM, gsz = (nM - fm) < WGM ? (nM - fm) : WGM;
        u.pm = fm + ((wgid % nig) % gsz); u.pn = (wgid % nig) / gsz; return true;
    }
    __device__ __forceinline__ void a_ready(const Unit&) const {}
    __device__ __forceinline__ void done(const Unit&) const {}
};

struct PanelOrder {
    int pm, n, c;
    __device__ __forceinline__ bool next(int i, Unit& u) const { if (i > 0 || c < 0 || c >= n) return false; u.pm = pm; u.pn = c; return true; }
    __device__ __forceinline__ void a_ready(const Unit&) const {}
    __device__ __forceinline__ void done(const Unit&) const {}
};
__device__ __forceinline__ unsigned cvt_pk_bf16(float lo, float hi) { unsigned r; asm volatile("v_cvt_pk_bf16_f32 %0, %1, %2" : "=v"(r) : "v"(lo), "v"(hi)); return r; }
typedef unsigned u32x2 __attribute__((ext_vector_type(2)));
typedef float f32x2 __attribute__((ext_vector_type(2)));
__device__ __forceinline__ float sigm(float x) { return __builtin_amdgcn_rcpf(1.0f + __builtin_amdgcn_exp2f(x * -1.4426950408889634f)); }
__device__ __forceinline__ float bflo(unsigned w) { return __uint_as_float(w << 16); }
__device__ __forceinline__ float bfhi(unsigned w) { return __uint_as_float(w & 0xffff0000u); }

struct EpiU {
    static constexpr bool PERM = true, AFTER_DRAIN = false, MID = false;
    bf16_t* U; const float* cs; float* out; bf16_t* GT;
    __device__ __forceinline__ void operator()(const f32x4 (&acc)[2][2][4][2], const Unit& u, int wr, int wc, int fr, int fq) const {
        const int pn = u.pn, rbase = u.pm * 256 + wr * 64 + fr, cbase = pn * 256 + wc * 32 + 8 * fq;
        if (pn < 12) {
            const bool isk = pn >= 6; const int g = isk ? ((pn - 6) >> 1) : 0;
            const int t0 = (g == 0) ? 16256 : (g == 1 ? 15872 : 14336);
            const size_t offp = (g == 0) ? O_W128P : (g == 1 ? O_W512P : O_W2048P), offs = (g == 0) ? O_W128S : (g == 1 ? O_W512S : O_W2048S);
            const float qs = isk ? 1.0f : 0.125f;
            const int i0 = 16 * (wc & 1) + 4 * fq, hb0 = pn * 256 + (wc >> 1) * 64;
#pragma unroll
            for (int ai = 0; ai < 2; ++ai)
#pragma unroll
                for (int m = 0; m < 4; ++m) { const int row = rbase + ai * 128 + m * 16, pos = row < T_SEQ ? row : 8192;
                    float* dstr = nullptr;
                    if (isk) { if (row < T_SEQ) { if (row >= t0) dstr = out + offp + (size_t)(row - t0) * 1024; } else if (row < T_SEQ + NSAMP) dstr = out + offs + (size_t)(row - T_SEQ) * 1024; }
                    const float* cp = cs + ((size_t)pos * 32 + i0) * 2; const f32x4 ca = *(const f32x4*)cp * qs, cb = *(const f32x4*)(cp + 4) * qs;
                    const f32x4 cc = (f32x4){ca[0], ca[2], cb[0], cb[2]}, ss = (f32x4){ca[1], ca[3], cb[1], cb[3]};
#pragma unroll
                    for (int bj = 0; bj < 2; ++bj) { const f32x4 xl = acc[ai][bj][m][0], xh = acc[ai][bj][m][1];
                        const f32x4 lo = xl * cc - xh * ss, hi = xh * cc + xl * ss;
                        bf16_t* up = U + (size_t)row * NIN + hb0 + bj * 128 + i0;
                        u32x2 wl; wl.x = cvt_pk_bf16(lo[0], lo[1]); wl.y = cvt_pk_bf16(lo[2], lo[3]); *(u32x2*)up = wl;
                        u32x2 wh; wh.x = cvt_pk_bf16(hi[0], hi[1]); wh.y = cvt_pk_bf16(hi[2], hi[3]); *(u32x2*)(up + 32) = wh;
                        if (dstr) { float* d = dstr + (((hb0 + bj * 128 - C_AK) >> 6) & 7) * 64 + i0; *(f32x4*)d = lo; *(f32x4*)(d + 32) = hi; } } }
        } else if (pn < 18) {
            const int g = (pn - 12) >> 1; const int t0 = (g == 0) ? 16256 : (g == 1 ? 15872 : 14336);
            const size_t offp = (g == 0) ? O_W128P : (g == 1 ? O_W512P : O_W2048P), offs = (g == 0) ? O_W128S : (g == 1 ? O_W512S : O_W2048S);
#pragma unroll
            for (int ai = 0; ai < 2; ++ai)
#pragma unroll
                for (int m = 0; m < 4; ++m) { const int row = rbase + ai * 128 + m * 16;
                    float* dstr = nullptr;
                    if (row < T_SEQ) { if (row >= t0) dstr = out + offp + (size_t)(row - t0) * 1024 + 512; } else if (row < T_SEQ + NSAMP) dstr = out + offs + (size_t)(row - T_SEQ) * 1024 + 512;
#pragma unroll
                    for (int bj = 0; bj < 2; ++bj) { const int vc = cbase + bj * 128; const f32x4 x0 = acc[ai][bj][m][0], x1 = acc[ai][bj][m][1];
                        u32x4 w; w.x = cvt_pk_bf16(x0[0], x0[1]); w.y = cvt_pk_bf16(x0[2], x0[3]); w.z = cvt_pk_bf16(x1[0], x1[1]); w.w = cvt_pk_bf16(x1[2], x1[3]); *(u32x4*)(U + (size_t)row * NIN + vc) = w;
                        if (dstr) { float* d = dstr + ((vc - C_AV) & 511); *(f32x4*)d = x0; *(f32x4*)(d + 4) = x1; } } }
        } else if (pn < 32) {
            const bool act = (pn < 20 || pn == 26 || pn == 27 || pn == 30 || pn == 31);
#pragma unroll
            for (int ai = 0; ai < 2; ++ai)
#pragma unroll
                for (int m = 0; m < 4; ++m) { const int row = rbase + ai * 128 + m * 16;
#pragma unroll
                    for (int bj = 0; bj < 2; ++bj) { const int vc = cbase + bj * 128; f32x4 x0 = acc[ai][bj][m][0], x1 = acc[ai][bj][m][1];
                        if (act) {
#pragma unroll
                            for (int j = 0; j < 4; ++j) { x0[j] *= sigm(x0[j]); x1[j] *= sigm(x1[j]); } }
                        u32x4 w; w.x = cvt_pk_bf16(x0[0], x0[1]); w.y = cvt_pk_bf16(x0[2], x0[3]); w.z = cvt_pk_bf16(x1[0], x1[1]); w.w = cvt_pk_bf16(x1[2], x1[3]); *(u32x4*)(U + (size_t)row * NIN + vc) = w; } }
        } else {
            const int br = (pn - 32) >> 2, pt = (pn - 32) & 3, wid = wr * 4 + wc, lane = fq * 16 + fr;
            bf16_t* gp = GT + ((((size_t)(br * 65 + u.pm) * 4 + pt) * 8 + wid) * 16) * 512 + lane * 8;
#pragma unroll
            for (int ai = 0; ai < 2; ++ai)
#pragma unroll
                for (int bj = 0; bj < 2; ++bj)
#pragma unroll
                    for (int m = 0; m < 4; ++m) { f32x4 x0 = acc[ai][bj][m][0], x1 = acc[ai][bj][m][1];
#pragma unroll
                        for (int j = 0; j < 4; ++j) { x0[j] = fmaxf(sigm(x0[j]), 1e-30f); x1[j] = fmaxf(sigm(x1[j]), 1e-30f); }
                        u32x4 w; w.x = cvt_pk_bf16(x0[0], x0[1]); w.y = cvt_pk_bf16(x0[2], x0[3]); w.z = cvt_pk_bf16(x1[0], x1[1]); w.w = cvt_pk_bf16(x1[2], x1[3]);
                        *(u32x4*)(gp + ((ai * 2 + bj) * 4 + m) * 512) = w; }
        }
    }
};
struct EpiMem {
    static constexpr bool PERM = false, AFTER_DRAIN = false, MID = false;
    float* O; bf16_t* B;
    __device__ __forceinline__ void operator()(const f32x4 (&acc)[2][2][4][2], const Unit& u, int wr, int wc, int fr, int fq) const {
        const int rbase = u.pm * 256 + wr * 64 + fr, cbase = u.pn * 256 + wc * 32 + 4 * fq;
#pragma unroll
        for (int ai = 0; ai < 2; ++ai)
#pragma unroll
            for (int m = 0; m < 4; ++m) { const int row = rbase + ai * 128 + m * 16;
#pragma unroll
                for (int bj = 0; bj < 2; ++bj)
#pragma unroll
                    for (int n = 0; n < 2; ++n) { const int c = cbase + bj * 128 + n * 16; const f32x4 x = acc[ai][bj][m][n];
                        *(f32x4*)(O + (size_t)row * 1024 + c) = x; u32x2 w; w.x = cvt_pk_bf16(x[0], x[1]); w.y = cvt_pk_bf16(x[2], x[3]); *(u32x2*)(B + (size_t)row * 1024 + c) = w; } }
    }
};
struct EpiMerged {
    static constexpr bool PERM = true, AFTER_DRAIN = false, MID = true;
    const bf16_t* GT; bf16_t* MG;
    __device__ __forceinline__ const bf16_t* gtp(int br, const Unit& u, int wr, int wc, int fr, int fq) const {
        return GT + ((((size_t)(br * 65 + u.pm) * 4 + u.pn) * 8 + wr * 4 + wc) * 16) * 512 + (fq * 16 + fr) * 8; }
    __device__ __forceinline__ void mid(f32x4 (&acc)[2][2][4][2], const Unit& u, int t, int wr, int wc, int fr, int fq) const {
        int lo = (fq * 16 + fr) * 8; asm volatile("" : "+v"(lo));
        const int br = (t == 8) ? 0 : 1;
        const bf16_t* pa = GT + ((((size_t)(br * 65 + u.pm) * 4 + u.pn) * 8 + wr * 4 + wc) * 16) * 512 + lo; const bf16_t* pb = pa + (size_t)65 * 4 * 8 * 16 * 512;
#pragma unroll
        for (int ai = 0; ai < 2; ++ai)
#pragma unroll
            for (int bj = 0; bj < 2; ++bj) {
#pragma unroll
                for (int m = 0; m < 4; ++m) { const int i2 = (ai * 2 + bj) * 4 + m; const u32x4 a = *(const u32x4*)(pa + i2 * 512), b = *(const u32x4*)(pb + i2 * 512);
                    f32x4 r0, r1; r0[0] = bflo(a.x) * __builtin_amdgcn_rcpf(bflo(b.x)); r0[1] = bfhi(a.x) * __builtin_amdgcn_rcpf(bfhi(b.x)); r0[2] = bflo(a.y) * __builtin_amdgcn_rcpf(bflo(b.y)); r0[3] = bfhi(a.y) * __builtin_amdgcn_rcpf(bfhi(b.y));
                    r1[0] = bflo(a.z) * __builtin_amdgcn_rcpf(bflo(b.z)); r1[1] = bfhi(a.z) * __builtin_amdgcn_rcpf(bfhi(b.z)); r1[2] = bflo(a.w) * __builtin_amdgcn_rcpf(bflo(b.w)); r1[3] = bfhi(a.w) * __builtin_amdgcn_rcpf(bfhi(b.w));
                    acc[ai][bj][m][0] = acc[ai][bj][m][0] * r0; acc[ai][bj][m][1] = acc[ai][bj][m][1] * r1; }
                asm volatile("" ::: "memory"); }
    }
    __device__ __forceinline__ void operator()(const f32x4 (&acc)[2][2][4][2], const Unit& u, int wr, int wc, int fr, int fq) const {
        const int rbase = u.pm * 256 + wr * 64 + fr, cbase = u.pn * 256 + wc * 32 + 8 * fq;
        const bf16_t* pc = gtp(2, u, wr, wc, fr, fq);
#pragma unroll
        for (int ai = 0; ai < 2; ++ai)
#pragma unroll
            for (int m = 0; m < 4; ++m) { const int row = rbase + ai * 128 + m * 16;
#pragma unroll
                for (int bj = 0; bj < 2; ++bj) { const int c = cbase + bj * 128; const f32x4 x0 = acc[ai][bj][m][0], x1 = acc[ai][bj][m][1];
                    const u32x4 gw = *(const u32x4*)(pc + ((ai * 2 + bj) * 4 + m) * 512);
                    u32x4 w; w.x = cvt_pk_bf16(x0[0] * bflo(gw.x), x0[1] * bfhi(gw.x)); w.y = cvt_pk_bf16(x0[2] * bflo(gw.y), x0[3] * bfhi(gw.y));
                    w.z = cvt_pk_bf16(x1[0] * bflo(gw.z), x1[1] * bfhi(gw.z)); w.w = cvt_pk_bf16(x1[2] * bflo(gw.w), x1[3] * bfhi(gw.w)); *(u32x4*)(MG + (size_t)row * 1024 + c) = w; } }
    }
};
struct EpiZ {
    static constexpr bool PERM = false, AFTER_DRAIN = false, MID = false;
    float* Z;
    __device__ __forceinline__ void operator()(const f32x4 (&acc)[2][2][4][2], const Unit& u, int wr, int wc, int fr, int fq) const {
        const int rbase = u.pm * 256 + wr * 64 + fr, cbase = u.pn * 256 + wc * 32 + 4 * fq;
#pragma unroll
        for (int ai = 0; ai < 2; ++ai)
#pragma unroll
            for (int m = 0; m < 4; ++m) { const int row = rbase + ai * 128 + m * 16;
#pragma unroll
                for (int bj = 0; bj < 2; ++bj)
#pragma unroll
                    for (int n = 0; n < 2; ++n) *(f32x4*)(Z + (size_t)row * 1024 + cbase + bj * 128 + n * 16) = acc[ai][bj][m][n]; }
    }
};
template <class Epi, class Sched, bool ALIGN_EPI = false, bool SP2 = false>
__device__ __forceinline__ void gemm_phase(PG8_LAS unsigned char* lds, const Gemm g, const Sched& S, const Epi& E) {
    int tid = threadIdx.x; asm volatile("" : "+v"(tid));
    const int wid = __builtin_amdgcn_readfirstlane(tid >> 6), lane = tid & 63, wr = wid >> 2, wc = wid & 3, fr = lane & 15, fq = lane >> 4;
    const int K = g.K, nt = K / BK;
    unsigned voffA[2], voffB[2];
#pragma unroll
    for (int i = 0; i < 2; ++i) { int R, C; stage_rc(tid * 16 + i * 8192, R, C); const int Rb = Epi::PERM ? ((R & ~31) + perm32(R & 31)) : R;
        voffA[i] = (unsigned)(R * K + C) * 2u; voffB[i] = (unsigned)(Rb * K + C) * 2u; }
    const size_t kstep = (size_t)(BK * 2);
    const size_t hstep = (size_t)HALF * K * 2;
    const size_t tstep = 2 * hstep;
    const unsigned ldsw = (unsigned)wid * 1024u;
    const int aoff = lds_byte(wr * 64 + fr, fq * 8), boff = lds_byte(wc * 32 + fr, fq * 8);
#define PG8_SA(b, h) (((b) * 2 + (h)) * HTB)
#define PG8_SB(b, h) ((4 + (b) * 2 + (h)) * HTB)
#define PG8_STAGE(bufoff, gbase, voff) do { _Pragma("unroll") for (int _i = 0; _i < 2; ++_i) \
        __builtin_amdgcn_global_load_lds((const unsigned*)((const char*)(gbase) + (voff)[_i]), (PG8_LAS unsigned*)(lds + (bufoff) + ldsw + _i * 8192), 16, 0, 0); } while (0)
#define PG8_LDA(dst, b, h) do { _Pragma("unroll") for (int m = 0; m < 4; ++m) _Pragma("unroll") for (int k = 0; k < 2; ++k) dst[m][k] = *(const PG8_LAS bf16x8*)(lds + PG8_SA(b, h) + aoff + m * 2048 + k * 1024); } while (0)
#define PG8_LDB(dst, b, h) do { _Pragma("unroll") for (int n = 0; n < 2; ++n) _Pragma("unroll") for (int k = 0; k < 2; ++k) dst[n][k] = *(const PG8_LAS bf16x8*)(lds + PG8_SB(b, h) + boff + n * 2048 + k * 1024); } while (0)
#define PG8_MMA(ai, bj, At, Bt) do { __builtin_amdgcn_s_setprio(1); _Pragma("unroll") for (int m = 0; m < 4; ++m) _Pragma("unroll") for (int n = 0; n < 2; ++n) _Pragma("unroll") for (int k = 0; k < 2; ++k) \
        acc[ai][bj][m][n] = __builtin_amdgcn_mfma_f32_16x16x32_bf16(Bt[n][k], At[m][k], acc[ai][bj][m][n], 0, 0, 0); __builtin_amdgcn_s_setprio(0); } while (0)
#define PG8_WAIT_V(n) asm volatile("s_waitcnt vmcnt(" #n ")" ::: "memory")
#define PG8_WAIT_L(n) asm volatile("s_waitcnt lgkmcnt(" #n ")" ::: "memory")
#define PG8_BAR __builtin_amdgcn_s_barrier()
#define PG8_SCHED __builtin_amdgcn_sched_barrier(0)
    Unit cur, nxt; int ui = 0;
    if (!S.next(0, cur)) return;
    f32x4 acc[2][2][4][2];
#pragma unroll
    for (int a = 0; a < 2; ++a)
#pragma unroll
        for (int b = 0; b < 2; ++b)
#pragma unroll
            for (int m = 0; m < 4; ++m)
#pragma unroll
                for (int n = 0; n < 2; ++n) acc[a][b][m][n] = (f32x4){0.f, 0.f, 0.f, 0.f};
    bf16x8 At[4][2], B0[2][2], B1[2][2];
    const char* cA = (const char*)g.A + (size_t)cur.pm * tstep; const char* cB = (const char*)g.Bt + (size_t)cur.pn * tstep;
    S.a_ready(cur);
    if constexpr (SP2) {
        PG8_STAGE(PG8_SB(0, 0), cB, voffB); PG8_STAGE(PG8_SB(0, 1), cB + hstep, voffB); PG8_STAGE(PG8_SA(0, 0), cA, voffA); PG8_STAGE(PG8_SA(0, 1), cA + hstep, voffA);
        if (wr == 1) PG8_BAR;
        PG8_WAIT_V(2); PG8_BAR;
        PG8_STAGE(PG8_SB(1, 0), cB + kstep, voffB); PG8_STAGE(PG8_SA(1, 0), cA + kstep, voffA); PG8_STAGE(PG8_SB(1, 1), cB + hstep + kstep, voffB);
        PG8_WAIT_V(6); PG8_BAR;
    } else {
        PG8_STAGE(PG8_SB(0, 0), cB, voffB); PG8_STAGE(PG8_SA(0, 0), cA, voffA); PG8_STAGE(PG8_SB(0, 1), cB + hstep, voffB); PG8_STAGE(PG8_SA(0, 1), cA + hstep, voffA);
        if (wr == 1) PG8_BAR;
        PG8_WAIT_V(4); PG8_BAR;
        PG8_STAGE(PG8_SB(1, 0), cB + kstep, voffB); PG8_STAGE(PG8_SA(1, 0), cA + kstep, voffA); PG8_STAGE(PG8_SB(1, 1), cB + hstep + kstep, voffB);
        PG8_WAIT_V(6); PG8_BAR;
    }
    for (;;) {
        const bool has_next = S.next(ui + 1, nxt);
        const char* nA = has_next ? (const char*)g.A + (size_t)nxt.pm * tstep : cA; const char* nB = has_next ? (const char*)g.Bt + (size_t)nxt.pn * tstep : cB;
        for (int t = 0; t < nt; t += 2) {
            const bool last = (t == nt - 2);
            const char* a1 = cA + (size_t)(t + 1) * kstep;
            const char* a2 = last ? nA : cA + (size_t)(t + 2) * kstep; const char* b2 = last ? nB : cB + (size_t)(t + 2) * kstep;
            const char* a3 = a2 + kstep; const char* b3 = b2 + kstep;
            if (last && has_next) S.a_ready(nxt);
            if constexpr (Epi::MID) { if (t == 8 || t == 16) E.mid(acc, cur, t, wr, wc, fr, fq); }
            if constexpr (SP2) {
            PG8_LDB(B0, 0, 0); PG8_LDB(B1, 0, 1); PG8_SCHED; PG8_LDA(At, 0, 0); PG8_STAGE(PG8_SA(1, 1), a1 + hstep, voffA);
            PG8_WAIT_V(8); PG8_WAIT_L(0); PG8_BAR; PG8_MMA(0, 0, At, B0); PG8_MMA(0, 1, At, B1); PG8_BAR; PG8_SCHED;
            PG8_LDA(At, 0, 1); PG8_STAGE(PG8_SB(0, 0), b2, voffB); PG8_STAGE(PG8_SB(0, 1), b2 + hstep, voffB); PG8_STAGE(PG8_SA(0, 0), a2, voffA);
            PG8_WAIT_V(8); PG8_WAIT_L(0); PG8_BAR; PG8_MMA(1, 0, At, B0); PG8_MMA(1, 1, At, B1); PG8_BAR; PG8_SCHED;
            PG8_LDB(B0, 1, 0); PG8_LDB(B1, 1, 1); PG8_SCHED; PG8_LDA(At, 1, 0); PG8_STAGE(PG8_SA(0, 1), a2 + hstep, voffA);
            PG8_WAIT_V(8); PG8_WAIT_L(0); PG8_BAR; PG8_MMA(0, 0, At, B0); PG8_MMA(0, 1, At, B1); PG8_BAR; PG8_SCHED;
            PG8_LDA(At, 1, 1); PG8_STAGE(PG8_SB(1, 0), b3, voffB); PG8_STAGE(PG8_SB(1, 1), b3 + hstep, voffB); PG8_STAGE(PG8_SA(1, 0), a3, voffA);
            PG8_WAIT_V(8); PG8_WAIT_L(0); PG8_BAR; PG8_MMA(1, 0, At, B0); PG8_MMA(1, 1, At, B1); PG8_BAR; PG8_SCHED;
            } else {
            PG8_LDB(B0, 0, 0); PG8_SCHED; PG8_LDA(At, 0, 0); PG8_STAGE(PG8_SA(1, 1), a1 + hstep, voffA);
            PG8_WAIT_L(8); PG8_BAR; PG8_WAIT_L(0); PG8_MMA(0, 0, At, B0); PG8_BAR; PG8_SCHED;
            PG8_LDB(B1, 0, 1); PG8_STAGE(PG8_SB(0, 0), b2, voffB);
            PG8_BAR; PG8_WAIT_L(0); PG8_MMA(0, 1, At, B1); PG8_BAR;
            PG8_LDA(At, 0, 1); PG8_STAGE(PG8_SA(0, 0), a2, voffA);
            PG8_BAR; PG8_WAIT_L(0); PG8_MMA(1, 0, At, B0); PG8_BAR; PG8_SCHED;
            PG8_STAGE(PG8_SB(0, 1), b2 + hstep, voffB);
            PG8_WAIT_V(6); PG8_BAR; PG8_MMA(1, 1, At, B1); PG8_BAR;
            PG8_LDB(B0, 1, 0); PG8_SCHED; PG8_LDA(At, 1, 0); PG8_STAGE(PG8_SA(0, 1), a2 + hstep, voffA);
            PG8_WAIT_L(8); PG8_BAR; PG8_WAIT_L(0); PG8_MMA(0, 0, At, B0); PG8_BAR; PG8_SCHED;
            PG8_LDB(B1, 1, 1); PG8_STAGE(PG8_SB(1, 0), b3, voffB);
            PG8_BAR; PG8_WAIT_L(0); PG8_MMA(0, 1, At, B1); PG8_BAR;
            PG8_LDA(At, 1, 1); PG8_STAGE(PG8_SA(1, 0), a3, voffA);
            PG8_BAR; PG8_WAIT_L(0); PG8_MMA(1, 0, At, B0); PG8_BAR; PG8_SCHED;
            PG8_STAGE(PG8_SB(1, 1), b3 + hstep, voffB);
            PG8_WAIT_V(6); PG8_BAR; PG8_MMA(1, 1, At, B1); PG8_BAR;
            }
        }
        if constexpr (ALIGN_EPI) { if (wr == 0) PG8_BAR; }
        if constexpr (!Epi::AFTER_DRAIN) { E(acc, cur, wr, wc, fr, fq); S.done(cur); }
        if (!has_next) break;
#pragma unroll
        for (int a = 0; a < 2; ++a)
#pragma unroll
            for (int b = 0; b < 2; ++b)
#pragma unroll
                for (int m = 0; m < 4; ++m)
#pragma unroll
                    for (int n = 0; n < 2; ++n) acc[a][b][m][n] = (f32x4){0.f, 0.f, 0.f, 0.f};
        cur = nxt; cA = nA; cB = nB; ++ui;
        if constexpr (ALIGN_EPI) { if (wr == 1) PG8_BAR; }
    }
    PG8_WAIT_V(0);
    if constexpr (!ALIGN_EPI) { if (wr == 0) PG8_BAR; }
    PG8_BAR;
    if constexpr (Epi::AFTER_DRAIN) { E.fused(acc, cur, wr, wc, fr, fq, lds, wid, lane); S.done(cur); }
#undef PG8_SA
#undef PG8_SB
#undef PG8_STAGE
#undef PG8_LDA
#undef PG8_LDB
#undef PG8_MMA
#undef PG8_WAIT_V
#undef PG8_WAIT_L
#undef PG8_BAR
#undef PG8_SCHED
}
}
#ifndef PG8_SP2
#define PG8_SP2 true
#endif
#ifndef PG8_ALIGN
#define PG8_ALIGN true
#endif
constexpr int RING_BYTES = 131072;
constexpr int LDSCTL_OFF = RING_BYTES, MISC_OFF = LDSCTL_OFF + 320;
constexpr int LDS_BYTES = 147456;
#define GAS __attribute__((address_space(1)))
#define LAS __attribute__((address_space(3)))
#define XB_TMO      128
#define XB_XCNT(j)  (256  + 64 * (j))
#define XB_XSUB(j)  (1280 + 64 * (j))
#define XB_XGEN(j)  (2304 + 64 * (j))
#define XB_TOP      3328
#define XB_TOPGEN   3392
#define XCD_BAR_WORDS 3456
#define XB_SPIN_CAP (1u << 18)

__device__ __forceinline__ unsigned xb_ld(unsigned* p)              { return __hip_atomic_load(p, __ATOMIC_RELAXED, __HIP_MEMORY_SCOPE_AGENT); }
__device__ __forceinline__ unsigned xb_add(unsigned* p, unsigned v) { return __hip_atomic_fetch_add(p, v, __ATOMIC_RELAXED, __HIP_MEMORY_SCOPE_AGENT); }
__device__ __forceinline__ unsigned xb_xcc_id() { return (unsigned)__builtin_amdgcn_s_getreg((3 << 11) | 20) & 0xFu; }
#define XB_SPIN(cond, bar) do { unsigned _sp = 0; while (cond) { __builtin_amdgcn_s_sleep(1); \
    if ((++_sp & 255u) == 0u) { if (xb_ld(&(bar)[XB_TMO])) break; if (_sp > XB_SPIN_CAP) { atomicAdd(&(bar)[XB_TMO], 1u); break; } } } } while (0)

struct XcdBarrier {
    unsigned* bar; unsigned x;
    volatile LAS unsigned* st;
};

__device__ __forceinline__ XcdBarrier xcd_barrier_post(unsigned* bar, volatile LAS unsigned* st) {
    XcdBarrier b; b.bar = bar; b.x = xb_xcc_id(); b.st = st;
    if (threadIdx.x == 0) (void)xb_add(&bar[XB_XCNT(b.x)], 1u);
    return b;
}
__device__ __forceinline__ void xcd_barrier_complete(unsigned* bar, unsigned x, unsigned& nloc, unsigned& nx) {
    const unsigned G = gridDim.x * gridDim.y * gridDim.z;
    unsigned sum, cnt, mine, sp = 0u;
    for (;;) {
        sum = 0u; cnt = 0u; mine = 0u;
#pragma unroll
        for (unsigned j = 0; j < 16; ++j) { const unsigned c = xb_ld(&bar[XB_XCNT(j)]); sum += c; cnt += (c > 0u) ? 1u : 0u; mine = (j == x) ? c : mine; }
        if (sum == G) break;
        __builtin_amdgcn_s_sleep(1);
        if ((++sp & 255u) == 0u) { if (xb_ld(&bar[XB_TMO])) break; if (sp > XB_SPIN_CAP) { atomicAdd(&bar[XB_TMO], 1u); break; } }
    }
    nloc = mine > 0u ? mine : 1u; nx = cnt > 0u ? cnt : 1u;
}

__device__ __forceinline__ void xcd_barrier(const XcdBarrier& b) {
    asm volatile("s_waitcnt vmcnt(0)" ::: "memory");
    __syncthreads();
    if (threadIdx.x == 0) {
        unsigned* bar = b.bar;
        __builtin_amdgcn_s_waitcnt(0);
        unsigned nloc = b.st[0], nx = b.st[1];
        if (nloc == 0u) { xcd_barrier_complete(bar, b.x, nloc, nx); b.st[0] = nloc; b.st[1] = nx; }
        const unsigned old = xb_add(&bar[XB_XSUB(b.x)], 1u);
        const unsigned gen = old / nloc;
        if (old + 1u == (gen + 1u) * nloc) {
            __builtin_amdgcn_fence(__ATOMIC_RELEASE, "agent");
            asm volatile("s_waitcnt vmcnt(0)" ::: "memory");
            const unsigned og = xb_add(&bar[XB_TOP], 1u);
            const unsigned tg = og / nx;
            if (og + 1u == (tg + 1u) * nx) xb_add(&bar[XB_TOPGEN], 1u);
            else XB_SPIN(xb_ld(&bar[XB_TOPGEN]) == tg, bar);
            __builtin_amdgcn_fence(__ATOMIC_ACQUIRE, "agent");
            xb_add(&bar[XB_XGEN(b.x)], 1u);
            asm volatile("s_waitcnt vmcnt(0)" ::: "memory");
        } else {
            XB_SPIN(xb_ld(&bar[XB_XGEN(b.x)]) == gen, bar);
            __builtin_amdgcn_fence(__ATOMIC_ACQUIRE, "agent");
            asm volatile("s_waitcnt vmcnt(0)" ::: "memory");
        }
    }
    __syncthreads();
}
typedef unsigned short bf16;
typedef unsigned v4u __attribute__((ext_vector_type(4)));
typedef unsigned v2u __attribute__((ext_vector_type(2)));
typedef float f32x4 __attribute__((ext_vector_type(4)));
typedef short bf16x8 __attribute__((ext_vector_type(8)));
typedef LAS unsigned char* ldsp;
#define LDS_WAIT() asm volatile("s_waitcnt lgkmcnt(0)" ::: "memory")
__device__ __forceinline__ unsigned f2bf(float f) { unsigned u = __builtin_bit_cast(unsigned, f); return (u + 0x7fffu + ((u >> 16) & 1u)) >> 16; }
__device__ __forceinline__ unsigned pk2(float lo, float hi) { return f2bf(lo) | (f2bf(hi) << 16); }
__device__ __forceinline__ float blo(unsigned w) { return __uint_as_float(w << 16); }
__device__ __forceinline__ float bhi(unsigned w) { return __uint_as_float(w & 0xffff0000u); }
__device__ __forceinline__ float b2f(bf16 b) { return __uint_as_float(((unsigned)b) << 16); }
__device__ __forceinline__ float sigmoid_f(float x) { return __builtin_amdgcn_rcpf(1.0f + __builtin_amdgcn_exp2f(x * -1.4426950408889634f)); }
__device__ __forceinline__ float wave_sum(float v) {
#pragma unroll
    for (int o = 1; o < 64; o <<= 1) v += __shfl_xor(v, o);
    return v;
}
#define MFMA16(a, b, c) __builtin_amdgcn_mfma_f32_16x16x32_bf16((a), (b), (c), 0, 0, 0)

struct Args {
    const float *xp, *xs, *memp, *c128, *c512, *c2048, *sth, *cmem, *npre, *npost, *win, *lbl, *hgn, *mnorm, *wmem, *wpa, *wpb, *wpc, *wout;
    float* out; unsigned char* ws;
};

__device__ __forceinline__ int win_vrow(int n) { if (n < 3072) { const int d = n & 63; return (n & ~63) + ((d & 3) | (((d >> 5) & 1) << 2) | (((d >> 2) & 3) << 3) | (((d >> 4) & 1) << 5)); } return n; }
__device__ __forceinline__ void transpose_item(const float* W, int K, int N, bf16* WT, bool rope, LAS float* scr, int item, int lane, int ldk = 0, int koff = 0) {
    if (ldk == 0) ldk = K;
    const int nblk = N / 32, kb = item / nblk, nb = item % nblk, k0 = 64 * kb, n0 = 32 * nb;
#pragma unroll 8
    for (int i = 0; i < 32; ++i) { const int kk = 2 * i + (lane >> 5); scr[kk * 33 + (lane & 31)] = W[(size_t)(k0 + kk) * N + n0 + (lane & 31)]; }
    LDS_WAIT(); asm volatile("" ::: "memory");
    const int c = lane & 7;
#pragma unroll
    for (int j = 0; j < 4; ++j) { const int n = (lane >> 3) + 8 * j; const LAS float* s = scr + (8 * c) * 33 + n;
        v4u o; o.x = pk2(s[0 * 33], s[1 * 33]); o.y = pk2(s[2 * 33], s[3 * 33]); o.z = pk2(s[4 * 33], s[5 * 33]); o.w = pk2(s[6 * 33], s[7 * 33]);
        const int dr = rope ? win_vrow(n0 + n) : (n0 + n);
        *(v4u*)(WT + (size_t)dr * ldk + koff + k0 + 8 * c) = o; }
    LDS_WAIT(); asm volatile("" ::: "memory");
}
__device__ __forceinline__ void rms_row_to_bf16(const float* xrow, const float* g, bf16* orow, int lane) {
    const f32x4* xr = (const f32x4*)xrow + lane; const f32x4* gr = (const f32x4*)g + lane;
    f32x4 v[4]; float s = 0.f;
#pragma unroll
    for (int j = 0; j < 4; ++j) { v[j] = xr[64 * j]; s += (v[j].x * v[j].x + v[j].y * v[j].y) + (v[j].z * v[j].z + v[j].w * v[j].w); }
    const float rstd = rsqrtf(wave_sum(s) * (1.f / 1024.f) + EPS);
    v2u* o8 = (v2u*)orow + lane;
#pragma unroll
    for (int j = 0; j < 4; ++j) { const f32x4 gv = gr[64 * j]; v2u w; w.x = pk2(v[j].x * rstd * gv.x, v[j].y * rstd * gv.y); w.y = pk2(v[j].z * rstd * gv.z, v[j].w * rstd * gv.w); o8[64 * j] = w; }
}
__device__ __forceinline__ void sincos_entry(int pos, int i, float& c, float& s) {
    const float invf[32] = {1.000000000e+00f, 7.498942018e-01f, 5.623413324e-01f, 4.216965139e-01f, 3.162277639e-01f, 2.371373773e-01f, 1.778279394e-01f, 1.333521456e-01f, 1.000000015e-01f, 7.498942316e-02f, 5.623413250e-02f, 4.216964915e-02f, 3.162277490e-02f, 2.371373773e-02f, 1.778279431e-02f, 1.333521400e-02f, 9.999999776e-03f, 7.498942316e-03f, 5.623413250e-03f, 4.216964822e-03f, 3.162277630e-03f, 2.371373819e-03f, 1.778279431e-03f, 1.333521446e-03f, 1.000000047e-03f, 7.498941850e-04f, 5.623413017e-04f, 4.216965172e-04f, 3.162277571e-04f, 2.371373703e-04f, 1.778279402e-04f, 1.333521504e-04f};
    const float ang = (float)pos * invf[i];
    const double x = (double)ang, kq = rint(x * 0.63661977236758134308);
    double r = fma(-kq, 1.57079632679489655800, x); r = fma(-kq, 6.12323399573676603587e-17, r);
    const float rf = (float)r, r2 = rf * rf; const int q = ((int)kq) & 3;
    const float sp = rf + rf * r2 * (-1.6666654611e-1f + r2 * (8.3321608736e-3f + r2 * (-1.9515295891e-4f)));
    const float cp = 1.0f - 0.5f * r2 + r2 * r2 * (4.166664568298827e-2f + r2 * (-1.388731625493765e-3f + r2 * 2.443315711809948e-5f));
    c = (q == 0) ? cp : (q == 1 ? -sp : (q == 2 ? -cp : sp));
    s = (q == 0) ? sp : (q == 1 ? cp : (q == 2 ? -sp : -cp));
}
__device__ __forceinline__ void p0_prologue(const Args& A, ldsp lds, int tid, int G) {
    const int lane = tid & 63, wave = tid >> 6;
    unsigned char* ws = A.ws;
    LAS float* scr = (LAS float*)(lds + wave * 16384);
    const int gw = blockIdx.x * 8 + wave, NGW = G * 8;
    constexpr int I_IN = 16 * 352, I_MEM = 16 * 32, I_BR = 8 * 32, I_OUT = 16 * 32, NITEMS = I_IN + I_MEM + 3 * I_BR + I_OUT;
    for (int it = gw; it < NITEMS; it += NGW) {
        int r = it;
        if (r < I_IN) { transpose_item(A.win, 1024, NIN, (bf16*)(ws + WS_WIN), true, scr, r, lane); continue; } r -= I_IN;
        if (r < I_MEM) { transpose_item(A.wmem, 1024, 1024, (bf16*)(ws + WS_WMEM), false, scr, r, lane); continue; } r -= I_MEM;
        if (r < I_BR) { transpose_item(A.wpa, 512, 1024, (bf16*)(ws + WS_WPA), false, scr, r, lane, 1536, 0); continue; } r -= I_BR;
        if (r < I_BR) { transpose_item(A.wpb, 512, 1024, (bf16*)(ws + WS_WPA), false, scr, r, lane, 1536, 512); continue; } r -= I_BR;
        if (r < I_BR) { transpose_item(A.wpc, 512, 1024, (bf16*)(ws + WS_WPA), false, scr, r, lane, 1536, 1024); continue; } r -= I_BR;
        transpose_item(A.wout, 1024, 1024, (bf16*)(ws + WS_WOUT), false, scr, r, lane);
    }
    bf16* XN = (bf16*)(ws + WS_XN); bf16* MN = (bf16*)(ws + WS_MN);
    for (int m = gw; m < T_SEQ + NSAMP + 256; m += NGW) {
        if (m < T_SEQ) rms_row_to_bf16(A.xp + (size_t)m * 1024, A.npre, XN + (size_t)m * 1024, lane);
        else if (m < T_SEQ + NSAMP) rms_row_to_bf16(A.xs + (size_t)(m - T_SEQ) * 1024, A.npre, XN + (size_t)m * 1024, lane);
        else rms_row_to_bf16(A.memp + (size_t)(m - T_SEQ - NSAMP) * 1024, A.mnorm, MN + (size_t)(m - T_SEQ - NSAMP) * 1024, lane);
    }
    float* cs = (float*)(ws + WS_CS);
    for (int e = blockIdx.x * 512 + tid; e < T_SEQ * 32; e += G * 512) { float c, s; sincos_entry(e >> 5, e & 31, c, s); *(float2*)(cs + (size_t)e * 2) = make_float2(c, s); }
}

constexpr int VT_STRIDE = 276;
__device__ __forceinline__ void attn_dil_unit(ldsp lds, const bf16* U, bf16* OG, float* LSE, int g, int dil, int r, int nb, int h, int tid) {
    const int lane = tid & 63, w = __builtin_amdgcn_readfirstlane(tid >> 6), l15 = lane & 15, q4 = lane >> 4;
    LAS bf16* VT = (LAS bf16*)lds;
    const int colq = C_AQ + g * 512 + h * 64, colk = C_AK + g * 512 + h * 64, colv = C_AV + g * 512 + h * 64;
    __syncthreads();
#pragma unroll
    for (int it = 0; it < 4; ++it) { const int key = (tid >> 3) + 64 * it, d8 = (tid & 7) * 8, kp = (nb - 1) * 128 + key;
        bf16x8 v = (bf16x8){0, 0, 0, 0, 0, 0, 0, 0};
        if (kp >= 0) v = *(const bf16x8*)(U + (size_t)(kp * dil + r) * NIN + colv + d8);
#pragma unroll
        for (int j = 0; j < 8; ++j) VT[(d8 + j) * VT_STRIDE + key] = (bf16)v[j]; }
    for (int e = tid; e < 64 * 20; e += 512) VT[(e / 20) * VT_STRIDE + 256 + (e % 20)] = 0;
    __syncthreads();
    const int tq = (nb * 128 + w * 16 + l15) * dil + r;
    bf16x8 qf[2];
#pragma unroll
    for (int kk = 0; kk < 2; ++kk) qf[kk] = *(const bf16x8*)(U + (size_t)tq * NIN + colq + 32 * kk + 8 * q4);
    f32x4 s[9];
#pragma unroll
    for (int kt = 0; kt < 9; ++kt) { int kp = (nb - 1) * 128 + 16 * w + 16 * kt + l15; kp = kp < 0 ? 0 : kp;
        const bf16* kr = U + (size_t)(kp * dil + r) * NIN + colk + 8 * q4;
        f32x4 a = (f32x4){0.f, 0.f, 0.f, 0.f};
#pragma unroll
        for (int kk = 0; kk < 2; ++kk) a = MFMA16(*(const bf16x8*)(kr + 32 * kk), qf[kk], a);
        s[kt] = a; }
    float m = -1e30f;
#pragma unroll
    for (int kt = 0; kt < 9; ++kt)
#pragma unroll
        for (int j = 0; j < 4; ++j) { const int klr = 16 * kt + 4 * q4 + j, dist = l15 + 128 - klr;
            const bool ok = dist >= 0 && dist <= 128 && (nb > 0 || (16 * w + klr) >= 128);
            s[kt][j] = ok ? s[kt][j] : -1e30f; m = fmaxf(m, s[kt][j]); }
    m = fmaxf(m, __shfl_xor(m, 16)); m = fmaxf(m, __shfl_xor(m, 32));
    float l = 0.f;
#pragma unroll
    for (int kt = 0; kt < 9; ++kt)
#pragma unroll
        for (int j = 0; j < 4; ++j) { const float p = __expf(s[kt][j] - m); s[kt][j] = p; l += p; }
    l += __shfl_xor(l, 16); l += __shfl_xor(l, 32);
    f32x4 o[4];
#pragma unroll
    for (int dt = 0; dt < 4; ++dt) o[dt] = (f32x4){0.f, 0.f, 0.f, 0.f};
#pragma unroll
    for (int ks = 0; ks < 5; ++ks) {
        v4u pw; pw.x = pk2(s[2 * ks][0], s[2 * ks][1]); pw.y = pk2(s[2 * ks][2], s[2 * ks][3]);
        if (ks < 4) { pw.z = pk2(s[2 * ks + 1][0], s[2 * ks + 1][1]); pw.w = pk2(s[2 * ks + 1][2], s[2 * ks + 1][3]); } else { pw.z = 0u; pw.w = 0u; }
        const bf16x8 pf = __builtin_bit_cast(bf16x8, pw);
#pragma unroll
        for (int dt = 0; dt < 4; ++dt) { const LAS bf16* vp = VT + (16 * dt + l15) * VT_STRIDE + 16 * w + 32 * ks + 4 * q4;
            const v2u lo = *(const LAS v2u*)vp, hi = *(const LAS v2u*)(vp + 16);
            v4u vw; vw.x = lo.x; vw.y = lo.y; vw.z = hi.x; vw.w = hi.y;
            o[dt] = MFMA16(__builtin_bit_cast(bf16x8, vw), pf, o[dt]); } }
    const float inv = 1.0f / l;
    bf16* op = OG + ((size_t)g * MROWS + tq) * 512 + h * 64 + 4 * q4;
#pragma unroll
    for (int dt = 0; dt < 4; ++dt) { v2u wv; wv.x = pk2(o[dt][0] * inv, o[dt][1] * inv); wv.y = pk2(o[dt][2] * inv, o[dt][3] * inv); *(v2u*)(op + 16 * dt) = wv; }
    if (q4 == 0) LSE[((size_t)g * MROWS + tq) * 8 + h] = m + __logf(l);
}
__device__ __forceinline__ void xattn_unit(ldsp lds, const bf16* U, const bf16* MKV, bf16* YC, int tile, int h, int tid) {
    const int lane = tid & 63, w = __builtin_amdgcn_readfirstlane(tid >> 6), l15 = lane & 15, q4 = lane >> 4;
    LAS bf16* VT = (LAS bf16*)lds;
    __syncthreads();
#pragma unroll
    for (int it = 0; it < 8; ++it) { const int key = (tid >> 4) + 32 * it, d8 = (tid & 15) * 8;
        const bf16x8 v = *(const bf16x8*)(MKV + (size_t)key * 1024 + 512 + h * 128 + d8);
#pragma unroll
        for (int j = 0; j < 8; ++j) VT[(d8 + j) * VT_STRIDE + key] = (bf16)v[j]; }
    __syncthreads();
    const int row = tile * 128 + w * 16 + l15;
    bf16x8 qf[4];
#pragma unroll
    for (int kk = 0; kk < 4; ++kk) qf[kk] = *(const bf16x8*)(U + (size_t)row * NIN + C_CQ + h * 128 + 32 * kk + 8 * q4);
    f32x4 s[16];
#pragma unroll
    for (int kt = 0; kt < 16; ++kt) { const bf16* kr = MKV + (size_t)(16 * kt + l15) * 1024 + h * 128 + 8 * q4;
        f32x4 a = (f32x4){0.f, 0.f, 0.f, 0.f};
#pragma unroll
        for (int kk = 0; kk < 4; ++kk) a = MFMA16(*(const bf16x8*)(kr + 32 * kk), qf[kk], a);
        s[kt] = a * 0.08838834764831845f; }
    float m = -1e30f;
#pragma unroll
    for (int kt = 0; kt < 16; ++kt)
#pragma unroll
        for (int j = 0; j < 4; ++j) m = fmaxf(m, s[kt][j]);
    m = fmaxf(m, __shfl_xor(m, 16)); m = fmaxf(m, __shfl_xor(m, 32));
    float l = 0.f;
#pragma unroll
    for (int kt = 0; kt < 16; ++kt)
#pragma unroll
        for (int j = 0; j < 4; ++j) { const float p = __expf(s[kt][j] - m); s[kt][j] = p; l += p; }
    l += __shfl_xor(l, 16); l += __shfl_xor(l, 32);
    f32x4 o[8];
#pragma unroll
    for (int dt = 0; dt < 8; ++dt) o[dt] = (f32x4){0.f, 0.f, 0.f, 0.f};
#pragma unroll
    for (int ks = 0; ks < 8; ++ks) {
        v4u pw; pw.x = pk2(s[2 * ks][0], s[2 * ks][1]); pw.y = pk2(s[2 * ks][2], s[2 * ks][3]); pw.z = pk2(s[2 * ks + 1][0], s[2 * ks + 1][1]); pw.w = pk2(s[2 * ks + 1][2], s[2 * ks + 1][3]);
        const bf16x8 pf = __builtin_bit_cast(bf16x8, pw);
#pragma unroll
        for (int dt = 0; dt < 8; ++dt) { const LAS bf16* vp = VT + (16 * dt + l15) * VT_STRIDE + 32 * ks + 4 * q4;
            const v2u lo = *(const LAS v2u*)vp, hi = *(const LAS v2u*)(vp + 16);
            v4u vw; vw.x = lo.x; vw.y = lo.y; vw.z = hi.x; vw.w = hi.y;
            o[dt] = MFMA16(__builtin_bit_cast(bf16x8, vw), pf, o[dt]); } }
    const float inv = 1.0f / l;
    const bf16* zp = U + (size_t)row * NIN + C_CZ + h * 128 + 4 * q4; bf16* op = YC + (size_t)row * YPITCH + h * 128 + 4 * q4;
#pragma unroll
    for (int dt = 0; dt < 8; ++dt) { const v2u z = *(const v2u*)(zp + 16 * dt); v2u wv;
        wv.x = pk2(o[dt][0] * inv * blo(z.x), o[dt][1] * inv * bhi(z.x)); wv.y = pk2(o[dt][2] * inv * blo(z.y), o[dt][3] * inv * bhi(z.y)); *(v2u*)(op + 16 * dt) = wv; }
}
__device__ __forceinline__ float lb_of(const float* lbl, int c) { return 1.0f / (1.0f + __expf(lbl[512 + c] - lbl[c])); }
__device__ __forceinline__ void hgrn_pass1_unit(ldsp lds, const bf16* U, const float* lbl, float* HU, float* HP, int h, int j, int tid) {
    LAS float* fb = (LAS float*)lds; LAS float* kb = fb + 32 * 128; LAS float* vb = kb + 32 * 128;
    const int v = tid & 127, kq = __builtin_amdgcn_readfirstlane(tid >> 7), tok = tid >> 4, c8 = (tid & 15) * 8;
    float s[32], lbr[8];
#pragma unroll
    for (int i = 0; i < 32; ++i) s[i] = 0.f;
#pragma unroll
    for (int e = 0; e < 8; ++e) lbr[e] = lb_of(lbl, h * 128 + c8 + e);
    float pacc = 1.f;
    for (int ch = 0; ch < 8; ++ch) {
        __syncthreads();
        { const size_t ro = (size_t)(j * 256 + ch * 32 + tok) * NIN + h * 128 + c8;
          const v4u fw = *(const v4u*)(U + ro + C_BF), vw = *(const v4u*)(U + ro + C_BI);
          const unsigned fa[4] = {fw.x, fw.y, fw.z, fw.w}, va[4] = {vw.x, vw.y, vw.z, vw.w};
#pragma unroll
          for (int e = 0; e < 4; ++e) { const float x0 = blo(fa[e]), x1 = bhi(fa[e]);
              const float f0 = lbr[2 * e] + (1.f - lbr[2 * e]) * sigmoid_f(x0), f1 = lbr[2 * e + 1] + (1.f - lbr[2 * e + 1]) * sigmoid_f(x1);
              const int o = tok * 128 + c8 + 2 * e;
              fb[o] = f0; fb[o + 1] = f1; kb[o] = 1.f - f0; kb[o + 1] = 1.f - f1; vb[o] = blo(va[e]); vb[o + 1] = bhi(va[e]); } }
        __syncthreads();
        for (int tt = 0; tt < 32; ++tt) { const float vv = vb[tt * 128 + v]; const LAS f32x4* f4 = (const LAS f32x4*)(fb + tt * 128 + kq * 32); const LAS f32x4* k4 = (const LAS f32x4*)(kb + tt * 128 + kq * 32);
#pragma unroll
            for (int i4 = 0; i4 < 8; ++i4) { const f32x4 f = f4[i4], k = k4[i4];
#pragma unroll
                for (int e = 0; e < 4; ++e) s[4 * i4 + e] = f[e] * s[4 * i4 + e] + k[e] * vv; } }
        if (tid < 128) { for (int tt = 0; tt < 32; ++tt) pacc *= fb[tt * 128 + tid]; }
    }
    float* up = HU + ((size_t)(j * 4 + h) * 128 + kq * 32) * 128 + v;
#pragma unroll
    for (int i = 0; i < 32; ++i) up[(size_t)i * 128] = s[i];
    if (tid < 128) HP[(size_t)(j * 4 + h) * 128 + tid] = pacc;
}
__device__ __forceinline__ void hgrn_scan_unit(const float* __restrict__ HU, const float* __restrict__ HP, float* __restrict__ HS, float* __restrict__ outS, int e, int tid) {
    if (tid >= 256) return;
    const int idx = e * 256 + tid, h = idx >> 14, k = (idx >> 7) & 127, vk = idx & 16383;
    float S = 0.f;
#pragma unroll 1
    for (int j0 = 0; j0 < 64; j0 += 16) { float hu[16], hp[16];
#pragma unroll
        for (int q = 0; q < 16; ++q) { hu[q] = HU[(size_t)((j0 + q) * 4 + h) * 16384 + vk]; hp[q] = HP[(size_t)((j0 + q) * 4 + h) * 128 + k]; }
#pragma unroll
        for (int q = 0; q < 16; ++q) { HS[(size_t)((j0 + q) * 4 + h) * 16384 + vk] = S; S = hp[q] * S + hu[q]; } }
    outS[idx] = S;
}
__device__ __forceinline__ void hgrn_pass3_unit(ldsp lds, const bf16* U, const float* lbl, const float* hgn, const float* HS, bf16* YB, int h, int j, int tid) {
    LAS float* fb = (LAS float*)lds; LAS float* kb = fb + 32 * 128; LAS float* vb = kb + 32 * 128; LAS float* qb = vb + 32 * 128; LAS float* ob = qb + 32 * 128;
    const int lane = tid & 63, wv = tid >> 6, v = tid & 127, kq = __builtin_amdgcn_readfirstlane(tid >> 7), tok = tid >> 4, c8 = (tid & 15) * 8;
    float s[32], lbr[8];
    { const float* sp = HS + ((size_t)(j * 4 + h) * 128 + kq * 32) * 128 + v;
#pragma unroll
      for (int i = 0; i < 32; ++i) s[i] = sp[(size_t)i * 128]; }
#pragma unroll
    for (int e = 0; e < 8; ++e) lbr[e] = lb_of(lbl, h * 128 + c8 + e);
    const float g0 = hgn[h * 128 + lane], g1 = hgn[h * 128 + 64 + lane];
    for (int ch = 0; ch < 8; ++ch) {
        __syncthreads();
        { const size_t ro = (size_t)(j * 256 + ch * 32 + tok) * NIN + h * 128 + c8;
          const v4u fw = *(const v4u*)(U + ro + C_BF), vw = *(const v4u*)(U + ro + C_BI), qw = *(const v4u*)(U + ro + C_BQ);
          const unsigned fa[4] = {fw.x, fw.y, fw.z, fw.w}, va[4] = {vw.x, vw.y, vw.z, vw.w}, qa[4] = {qw.x, qw.y, qw.z, qw.w};
#pragma unroll
          for (int e = 0; e < 4; ++e) { const float x0 = blo(fa[e]), x1 = bhi(fa[e]);
              const float f0 = lbr[2 * e] + (1.f - lbr[2 * e]) * sigmoid_f(x0), f1 = lbr[2 * e + 1] + (1.f - lbr[2 * e + 1]) * sigmoid_f(x1);
              const int o = tok * 128 + c8 + 2 * e;
              fb[o] = f0; fb[o + 1] = f1; kb[o] = 1.f - f0; kb[o + 1] = 1.f - f1; vb[o] = blo(va[e]); vb[o + 1] = bhi(va[e]); qb[o] = blo(qa[e]); qb[o + 1] = bhi(qa[e]); } }
        __syncthreads();
        for (int tt = 0; tt < 32; ++tt) { const float vv = vb[tt * 128 + v]; const LAS f32x4* f4 = (const LAS f32x4*)(fb + tt * 128 + kq * 32); const LAS f32x4* k4 = (const LAS f32x4*)(kb + tt * 128 + kq * 32); const LAS f32x4* q4p = (const LAS f32x4*)(qb + tt * 128 + kq * 32);
            float acc = 0.f;
#pragma unroll
            for (int i4 = 0; i4 < 8; ++i4) { const f32x4 f = f4[i4], k = k4[i4], q = q4p[i4];
#pragma unroll
                for (int e = 0; e < 4; ++e) { s[4 * i4 + e] = f[e] * s[4 * i4 + e] + k[e] * vv; acc += s[4 * i4 + e] * q[e]; } }
            ob[(tt * 4 + kq) * 128 + v] = acc; }
        __syncthreads();
#pragma unroll
        for (int q = 0; q < 4; ++q) { const int tt = wv * 4 + q; const LAS float* op = ob + tt * 512;
            const float o0 = (op[lane] + op[128 + lane]) + (op[256 + lane] + op[384 + lane]), o1 = (op[64 + lane] + op[192 + lane]) + (op[320 + lane] + op[448 + lane]);
            const float rstd = rsqrtf(wave_sum(o0 * o0 + o1 * o1) * (1.f / 128.f) + EPS);
            const size_t t = (size_t)(j * 256 + ch * 32 + tt);
            const bf16* zp = U + t * NIN + C_BZ + h * 128; bf16* yp = YB + t * YPITCH + h * 128;
            yp[lane] = (bf16)f2bf(o0 * rstd * g0 * b2f(zp[lane])); yp[64 + lane] = (bf16)f2bf(o1 * rstd * g1 * b2f(zp[64 + lane])); }
    }
}
constexpr int HG_QT_STRIDE = 136, HG_KH_STRIDE = 40;
template <bool OUT>
__device__ __forceinline__ void hgrn_mfma_unit(ldsp lds, const bf16* U, const float* lbl, const float* hgn, const float* HS, float* HU, float* HP, bf16* YB, int h, int j, int tid) {
    const int lane = tid & 63, w = __builtin_amdgcn_readfirstlane(tid >> 6), l15 = lane & 15, q4 = lane >> 4;
    const int k = tid & 127, tq = tid >> 7, tok = tid >> 4, c8 = (tid & 15) * 8;
    LAS bf16* RAWQ = (LAS bf16*)lds; LAS bf16* RAWF = RAWQ + 4096; LAS bf16* RAWV = RAWF + 4096;
    LAS float* QS = (LAS float*)(lds + 24576); LAS float* DC = (LAS float*)(lds + 26624);
    LAS bf16* QT = (LAS bf16*)(lds + 27136); LAS bf16* KT = (LAS bf16*)(lds + 35840); LAS bf16* KH = (LAS bf16*)(lds + 44544); LAS bf16* VT = (LAS bf16*)(lds + 54784);
    LAS float* SSQ = (LAS float*)(lds + 65024);
    const float lb = lb_of(lbl, h * 128 + k), oml = 1.f - lb;
    f32x4 S[8];
    if (OUT) { const float* sp = HS + (size_t)(j * 4 + h) * 16384 + (size_t)(4 * q4) * 128 + 16 * w + l15;
#pragma unroll
        for (int kt = 0; kt < 8; ++kt)
#pragma unroll
            for (int r = 0; r < 4; ++r) S[kt][r] = sp[(size_t)(16 * kt + r) * 128]; }
    else {
#pragma unroll
        for (int kt = 0; kt < 8; ++kt) S[kt] = (f32x4){0.f, 0.f, 0.f, 0.f}; }
    float ptot = 0.f;
    v4u rq, rf, rv;
    { const size_t ro = (size_t)(j * 256 + tok) * NIN + h * 128 + c8; rf = *(const v4u*)(U + ro + C_BF); rv = *(const v4u*)(U + ro + C_BI); if (OUT) rq = *(const v4u*)(U + ro + C_BQ); else rq = rf; }
    for (int ch = 0; ch < 8; ++ch) {
        __syncthreads();
        *(LAS v4u*)(RAWF + tok * 128 + c8) = rf; *(LAS v4u*)(RAWV + tok * 128 + c8) = rv; if (OUT) *(LAS v4u*)(RAWQ + tok * 128 + c8) = rq;
        if (ch < 7) { const size_t ro = (size_t)(j * 256 + (ch + 1) * 32 + tok) * NIN + h * 128 + c8; rf = *(const v4u*)(U + ro + C_BF); rv = *(const v4u*)(U + ro + C_BI); if (OUT) rq = *(const v4u*)(U + ro + C_BQ); }
        __syncthreads();
        float kin[8], cum[8]; float c = 0.f;
#pragma unroll
        for (int i = 0; i < 8; ++i) { const float x = b2f(RAWF[(8 * tq + i) * 128 + k]); const float f = lb + oml * sigmoid_f(x); kin[i] = 1.f - f; c += __logf(f); cum[i] = c; }
        QS[tq * 128 + k] = c;
        __syncthreads();
        const float q0 = QS[k], q1 = QS[128 + k], q2 = QS[256 + k], q3 = QS[384 + k];
        const float pre = (tq > 0 ? q0 : 0.f) + (tq > 1 ? q1 : 0.f) + (tq > 2 ? q2 : 0.f), tot = (q0 + q1) + (q2 + q3);
        { unsigned khw[4], vtw[4];
#pragma unroll
          for (int i2 = 0; i2 < 4; ++i2) { float kh2[2]; unsigned short vv2[2];
#pragma unroll
              for (int e = 0; e < 2; ++e) { const int i = 2 * i2 + e, t = 8 * tq + i; const float b = pre + cum[i];
                  if (OUT) { const float eb = __expf(b); QT[t * HG_QT_STRIDE + k] = (bf16)f2bf(b2f(RAWQ[t * 128 + k]) * eb); KT[t * HG_QT_STRIDE + k] = (bf16)f2bf(kin[i] * __expf(fminf(-b, 80.f))); }
                  kh2[e] = kin[i] * __expf(tot - b); vv2[e] = RAWV[t * 128 + k]; }
              khw[i2] = pk2(kh2[0], kh2[1]); vtw[i2] = (unsigned)vv2[0] | ((unsigned)vv2[1] << 16); }
          v4u a; a.x = khw[0]; a.y = khw[1]; a.z = khw[2]; a.w = khw[3]; *(LAS v4u*)(KH + k * HG_KH_STRIDE + 8 * tq) = a;
          v4u b; b.x = vtw[0]; b.y = vtw[1]; b.z = vtw[2]; b.w = vtw[3]; *(LAS v4u*)(VT + k * HG_KH_STRIDE + 8 * tq) = b; }
        if (tq == 0) { DC[k] = __expf(tot); ptot += tot; }
        __syncthreads();
        const bf16x8 vnat = *(const LAS bf16x8*)(VT + (16 * w + l15) * HG_KH_STRIDE + 8 * q4);
        f32x4 o[2];
        if (OUT) {
            f32x4 a00 = (f32x4){0.f, 0.f, 0.f, 0.f}, a01 = a00, a11 = a00;
#pragma unroll
            for (int kk = 0; kk < 4; ++kk) { const bf16x8 k0 = *(const LAS bf16x8*)(KT + l15 * HG_QT_STRIDE + 32 * kk + 8 * q4), k1 = *(const LAS bf16x8*)(KT + (16 + l15) * HG_QT_STRIDE + 32 * kk + 8 * q4);
                const bf16x8 t0 = *(const LAS bf16x8*)(QT + l15 * HG_QT_STRIDE + 32 * kk + 8 * q4), t1 = *(const LAS bf16x8*)(QT + (16 + l15) * HG_QT_STRIDE + 32 * kk + 8 * q4);
                a00 = MFMA16(k0, t0, a00); a01 = MFMA16(k0, t1, a01); a11 = MFMA16(k1, t1, a11); }
#pragma unroll
            for (int r = 0; r < 4; ++r) { const bool ok = (4 * q4 + r) <= l15; a00[r] = ok ? a00[r] : 0.f; a11[r] = ok ? a11[r] : 0.f; }
            v4u p0, p1; p0.x = pk2(a00[0], a00[1]); p0.y = pk2(a00[2], a00[3]); p0.z = 0u; p0.w = 0u;
            p1.x = pk2(a01[0], a01[1]); p1.y = pk2(a01[2], a01[3]); p1.z = pk2(a11[0], a11[1]); p1.w = pk2(a11[2], a11[3]);
            const LAS bf16* vp = VT + (16 * w + l15) * HG_KH_STRIDE + 4 * q4; const v2u vlo = *(const LAS v2u*)vp, vhi = *(const LAS v2u*)(vp + 16);
            v4u vw; vw.x = vlo.x; vw.y = vlo.y; vw.z = vhi.x; vw.w = vhi.y; const bf16x8 vperm = __builtin_bit_cast(bf16x8, vw);
            o[0] = MFMA16(vperm, __builtin_bit_cast(bf16x8, p0), ((f32x4){0.f, 0.f, 0.f, 0.f}));
            o[1] = MFMA16(vperm, __builtin_bit_cast(bf16x8, p1), ((f32x4){0.f, 0.f, 0.f, 0.f}));
#pragma unroll
            for (int kk = 0; kk < 4; ++kk) { v4u sw; sw.x = pk2(S[2 * kk][0], S[2 * kk][1]); sw.y = pk2(S[2 * kk][2], S[2 * kk][3]); sw.z = pk2(S[2 * kk + 1][0], S[2 * kk + 1][1]); sw.w = pk2(S[2 * kk + 1][2], S[2 * kk + 1][3]);
                const bf16x8 sf = __builtin_bit_cast(bf16x8, sw);
#pragma unroll
                for (int tt = 0; tt < 2; ++tt) { const LAS bf16* qp = QT + (16 * tt + l15) * HG_QT_STRIDE + 32 * kk + 4 * q4; const v2u qlo = *(const LAS v2u*)qp, qhi = *(const LAS v2u*)(qp + 16);
                    v4u qw; qw.x = qlo.x; qw.y = qlo.y; qw.z = qhi.x; qw.w = qhi.y; o[tt] = MFMA16(sf, __builtin_bit_cast(bf16x8, qw), o[tt]); } }
        }
#pragma unroll
        for (int kt = 0; kt < 8; ++kt) { const f32x4 d = *(const LAS f32x4*)(DC + 16 * kt + 4 * q4); const bf16x8 kf = *(const LAS bf16x8*)(KH + (16 * kt + l15) * HG_KH_STRIDE + 8 * q4);
            S[kt] = MFMA16(kf, vnat, S[kt] * d); }
        if (OUT) {
#pragma unroll
            for (int tt = 0; tt < 2; ++tt) { float p = (o[tt][0] * o[tt][0] + o[tt][1] * o[tt][1]) + (o[tt][2] * o[tt][2] + o[tt][3] * o[tt][3]); p += __shfl_xor(p, 16); p += __shfl_xor(p, 32); if (q4 == 0) SSQ[w * 32 + 16 * tt + l15] = p; }
            __syncthreads();
            const f32x4 g4 = *(const f32x4*)(hgn + h * 128 + 16 * w + 4 * q4);
#pragma unroll
            for (int tt = 0; tt < 2; ++tt) { float ss = 0.f;
#pragma unroll
                for (int q = 0; q < 8; ++q) ss += SSQ[q * 32 + 16 * tt + l15];
                const float rstd = rsqrtf(ss * (1.f / 128.f) + EPS);
                const size_t t = (size_t)(j * 256 + ch * 32 + 16 * tt + l15);
                const v2u z = *(const v2u*)(U + t * NIN + C_BZ + h * 128 + 16 * w + 4 * q4); v2u y;
                y.x = pk2(o[tt][0] * rstd * g4[0] * blo(z.x), o[tt][1] * rstd * g4[1] * bhi(z.x)); y.y = pk2(o[tt][2] * rstd * g4[2] * blo(z.y), o[tt][3] * rstd * g4[3] * bhi(z.y));
                *(v2u*)(YB + t * YPITCH + h * 128 + 16 * w + 4 * q4) = y; }
        }
    }
    if (!OUT) { float* up = HU + (size_t)(j * 4 + h) * 16384 + (size_t)(4 * q4) * 128 + 16 * w + l15;
#pragma unroll
        for (int kt = 0; kt < 8; ++kt)
#pragma unroll
            for (int r = 0; r < 4; ++r) up[(size_t)(16 * kt + r) * 128] = S[kt][r];
        if (tq == 0) HP[(size_t)(j * 4 + h) * 128 + k] = __expf(ptot); }
}
__device__ __forceinline__ void attn_merge_row(const bf16* U, const bf16* OG, const float* LSE, bf16* YA, int t, int lane) {
    const int hd = lane >> 3, c8 = lane * 8;
    const float l0 = LSE[((size_t)0 * MROWS + t) * 8 + hd], l1 = LSE[((size_t)1 * MROWS + t) * 8 + hd], l2 = LSE[((size_t)2 * MROWS + t) * 8 + hd];
    const float mx = fmaxf(l0, fmaxf(l1, l2)); float w0 = __expf(l0 - mx), w1 = __expf(l1 - mx), w2 = __expf(l2 - mx); const float inv = 1.f / (w0 + w1 + w2); w0 *= inv; w1 *= inv; w2 *= inv;
    const v4u a = *(const v4u*)(OG + ((size_t)0 * MROWS + t) * 512 + c8), b = *(const v4u*)(OG + ((size_t)1 * MROWS + t) * 512 + c8), c = *(const v4u*)(OG + ((size_t)2 * MROWS + t) * 512 + c8);
    const v4u z = *(const v4u*)(U + (size_t)t * NIN + C_AZ + c8);
    const unsigned aa[4] = {a.x, a.y, a.z, a.w}, ba[4] = {b.x, b.y, b.z, b.w}, ca[4] = {c.x, c.y, c.z, c.w}, za[4] = {z.x, z.y, z.z, z.w}; unsigned oa[4];
#pragma unroll
    for (int e = 0; e < 4; ++e) oa[e] = pk2((w0 * blo(aa[e]) + w1 * blo(ba[e]) + w2 * blo(ca[e])) * blo(za[e]), (w0 * bhi(aa[e]) + w1 * bhi(ba[e]) + w2 * bhi(ca[e])) * bhi(za[e]));
    v4u o; o.x = oa[0]; o.y = oa[1]; o.z = oa[2]; o.w = oa[3]; *(v4u*)(YA + (size_t)t * YPITCH + c8) = o;
}
__device__ __forceinline__ void samp_attn_unit(const Args& A, const bf16* U, bf16* YA, int b, int tid) {
    const int lane = tid & 63, h = tid >> 6, ks = lane >> 4, dp = lane & 15; const size_t row = T_SEQ + b; const bf16* ur = U + row * NIN;
    float m = -1e30f, l = 0.f; f32x4 acc = (f32x4){0.f, 0.f, 0.f, 0.f};
#pragma unroll
    for (int g = 0; g < 3; ++g) { const int dil = (g == 0) ? 1 : (g == 1 ? 4 : 16), Wb = 128 * dil; const float* cache = ((g == 0) ? A.c128 : (g == 1 ? A.c512 : A.c2048)) + (size_t)b * Wb * 1024 + h * 64 + 4 * dp;
        const v2u qw = *(const v2u*)(ur + C_AQ + g * 512 + h * 64 + 4 * dp); const f32x4 q = (f32x4){blo(qw.x), bhi(qw.x), blo(qw.y), bhi(qw.y)};
        if (ks == 0) { const v2u kw = *(const v2u*)(ur + C_AK + g * 512 + h * 64 + 4 * dp), vw = *(const v2u*)(ur + C_AV + g * 512 + h * 64 + 4 * dp);
            float sc = q[0] * blo(kw.x) + q[1] * bhi(kw.x) + q[2] * blo(kw.y) + q[3] * bhi(kw.y);
            sc += __shfl_xor(sc, 1); sc += __shfl_xor(sc, 2); sc += __shfl_xor(sc, 4); sc += __shfl_xor(sc, 8);
            const float mn = fmaxf(m, sc), corr = __expf(m - mn), pe = __expf(sc - mn); l = l * corr + pe;
            acc = acc * corr + pe * (f32x4){blo(vw.x), bhi(vw.x), blo(vw.y), bhi(vw.y)}; m = mn; }
#pragma unroll 4
        for (int it = 0; it < 32; ++it) { const int jj = 1 + ks + 4 * it, idx = Wb - dil * jj; const float* kp = cache + (size_t)idx * 1024;
            const f32x4 k4 = *(const f32x4*)kp, v4 = *(const f32x4*)(kp + 512);
            float sc = (q[0] * k4[0] + q[1] * k4[1]) + (q[2] * k4[2] + q[3] * k4[3]);
            sc += __shfl_xor(sc, 1); sc += __shfl_xor(sc, 2); sc += __shfl_xor(sc, 4); sc += __shfl_xor(sc, 8);
            const float mn = fmaxf(m, sc), corr = __expf(m - mn), pe = __expf(sc - mn); l = l * corr + pe; acc = acc * corr + pe * v4; m = mn; } }
    float ma = fmaxf(m, __shfl_xor(m, 16)); ma = fmaxf(ma, __shfl_xor(ma, 32));
    const float sc = __expf(m - ma); l *= sc; acc = acc * sc;
    l += __shfl_xor(l, 16); l += __shfl_xor(l, 32);
#pragma unroll
    for (int e = 0; e < 4; ++e) { acc[e] += __shfl_xor(acc[e], 16); acc[e] += __shfl_xor(acc[e], 32); }
    if (ks == 0) { const float inv = 1.f / l; const v2u z = *(const v2u*)(ur + C_AZ + h * 64 + 4 * dp); v2u o;
        o.x = pk2(acc[0] * inv * blo(z.x), acc[1] * inv * bhi(z.x)); o.y = pk2(acc[2] * inv * blo(z.y), acc[3] * inv * bhi(z.y)); *(v2u*)(YA + row * YPITCH + h * 64 + 4 * dp) = o; }
}
__device__ __forceinline__ void samp_hgrn_unit(ldsp lds, const Args& A, const bf16* U, bf16* YB, int b, int h, int tid) {
    LAS float* fb = (LAS float*)lds; LAS float* kb = fb + 128; LAS float* qb = kb + 128; LAS float* red = qb + 128;
    const size_t row = T_SEQ + b; const bf16* ur = U + row * NIN;
    __syncthreads();
    if (tid < 128) { const float lb = lb_of(A.lbl, h * 128 + tid), f = lb + (1.f - lb) * sigmoid_f(b2f(ur[C_BF + h * 128 + tid])); fb[tid] = f; kb[tid] = 1.f - f; qb[tid] = b2f(ur[C_BQ + h * 128 + tid]); }
    __syncthreads();
    const int v4i = (tid & 31) * 4, kk = tid >> 5;
    const v2u vw = *(const v2u*)(ur + C_BI + h * 128 + v4i); const f32x4 vv = (f32x4){blo(vw.x), bhi(vw.x), blo(vw.y), bhi(vw.y)};
    const float* sp = A.sth + (size_t)(b * 4 + h) * 16384; float* dp = A.out + O_HGS + (size_t)(b * 4 + h) * 16384;
    f32x4 oacc = (f32x4){0.f, 0.f, 0.f, 0.f};
#pragma unroll
    for (int p = 0; p < 8; ++p) { const int k = kk + 16 * p; const f32x4 S = *(const f32x4*)(sp + k * 128 + v4i); const f32x4 Sn = fb[k] * S + kb[k] * vv; *(f32x4*)(dp + k * 128 + v4i) = Sn; oacc += Sn * qb[k]; }
    *(LAS f32x4*)(red + kk * 128 + v4i) = oacc;
    __syncthreads();
    if (tid < 64) { float o0 = 0.f, o1 = 0.f;
#pragma unroll
        for (int q = 0; q < 16; ++q) { o0 += red[q * 128 + tid]; o1 += red[q * 128 + 64 + tid]; }
        const float rstd = rsqrtf(wave_sum(o0 * o0 + o1 * o1) * (1.f / 128.f) + EPS);
        bf16* yp = YB + row * YPITCH + h * 128;
        yp[tid] = (bf16)f2bf(o0 * rstd * A.hgn[h * 128 + tid] * b2f(ur[C_BZ + h * 128 + tid])); yp[64 + tid] = (bf16)f2bf(o1 * rstd * A.hgn[h * 128 + 64 + tid] * b2f(ur[C_BZ + h * 128 + 64 + tid])); }
}
__device__ __forceinline__ void samp_xattn_unit(ldsp lds, const Args& A, const bf16* U, bf16* YC, int b, int h, int tid) {
    LAS float* part = (LAS float*)lds;
    const int lane = tid & 63, w = tid >> 6, sub = lane >> 5, dp = lane & 31; const size_t row = T_SEQ + b; const bf16* ur = U + row * NIN;
    const v2u qw = *(const v2u*)(ur + C_CQ + h * 128 + 4 * dp); const f32x4 q = (f32x4){blo(qw.x), bhi(qw.x), blo(qw.y), bhi(qw.y)} * 0.08838834764831845f;
    const float* mem = A.cmem + (size_t)b * 256 * 1024 + h * 128 + 4 * dp;
    float m = -1e30f, l = 0.f; f32x4 acc = (f32x4){0.f, 0.f, 0.f, 0.f};
#pragma unroll 4
    for (int it = 0; it < 16; ++it) { const float* kp = mem + (size_t)(32 * w + 2 * it + sub) * 1024; const f32x4 k4 = *(const f32x4*)kp, v4 = *(const f32x4*)(kp + 512);
        float sc = (q[0] * k4[0] + q[1] * k4[1]) + (q[2] * k4[2] + q[3] * k4[3]);
        sc += __shfl_xor(sc, 1); sc += __shfl_xor(sc, 2); sc += __shfl_xor(sc, 4); sc += __shfl_xor(sc, 8); sc += __shfl_xor(sc, 16);
        const float mn = fmaxf(m, sc), corr = __expf(m - mn), pe = __expf(sc - mn); l = l * corr + pe; acc = acc * corr + pe * v4; m = mn; }
    const float ma = fmaxf(m, __shfl_xor(m, 32)); const float sc = __expf(m - ma); l *= sc; acc = acc * sc; l += __shfl_xor(l, 32);
#pragma unroll
    for (int e = 0; e < 4; ++e) acc[e] += __shfl_xor(acc[e], 32);
    __syncthreads();
    if (sub == 0) { *(LAS f32x4*)(part + w * 132 + 4 * dp) = acc; if (dp == 0) { part[w * 132 + 128] = ma; part[w * 132 + 129] = l; } }
    __syncthreads();
    if (tid < 128) { float M = -1e30f;
#pragma unroll
        for (int q8 = 0; q8 < 8; ++q8) M = fmaxf(M, part[q8 * 132 + 128]);
        float L = 0.f, O = 0.f;
#pragma unroll
        for (int q8 = 0; q8 < 8; ++q8) { const float e = __expf(part[q8 * 132 + 128] - M); L += part[q8 * 132 + 129] * e; O += part[q8 * 132 + tid] * e; }
        YC[row * YPITCH + h * 128 + tid] = (bf16)f2bf(O / L * b2f(ur[C_CZ + h * 128 + tid])); }
}
__device__ __forceinline__ void final_row(const float* z, const float* hrow, const float* g, float* yrow, int lane) {
    const f32x4* zr = (const f32x4*)z + lane; const f32x4* hr = (const f32x4*)hrow + lane; const f32x4* gr = (const f32x4*)g + lane; f32x4* yr = (f32x4*)yrow + lane;
    f32x4 v[4]; float s = 0.f;
#pragma unroll
    for (int j = 0; j < 4; ++j) { v[j] = zr[64 * j]; s += (v[j].x * v[j].x + v[j].y * v[j].y) + (v[j].z * v[j].z + v[j].w * v[j].w); }
    const float rstd = rsqrtf(wave_sum(s) * (1.f / 1024.f) + EPS);
#pragma unroll
    for (int j = 0; j < 4; ++j) yr[64 * j] = hr[64 * j] + v[j] * rstd * gr[64 * j];
}
__global__ void __launch_bounds__(512, 2) fwd_kernel(Args A) {
    extern __shared__ __attribute__((aligned(16))) unsigned char lds_raw[];
    ldsp lds = (ldsp)lds_raw;
    volatile LAS unsigned* MISC = (volatile LAS unsigned*)(lds + MISC_OFF);
    int tid = threadIdx.x; const int G = gridDim.x, bid = blockIdx.x;
#define NEWTID() do { tid = threadIdx.x; asm volatile("" : "+v"(tid)); } while (0)
    for (int u = tid; u < (LDS_BYTES - LDSCTL_OFF) / 4; u += 512) ((LAS unsigned*)(lds + LDSCTL_OFF))[u] = 0u;
    __syncthreads();
    unsigned char* ws = A.ws;
    unsigned* ctl = (unsigned*)(ws + WS_CTL);
    XcdBarrier bar = xcd_barrier_post(ctl + CW_BAR, MISC + 8);
    bf16* U = (bf16*)(ws + WS_U); bf16* MKV = (bf16*)(ws + WS_MEMKV);
    bf16* YA = (bf16*)(ws + WS_YA); bf16* YB = YA + 512; bf16* YC = YA + 1024;
    bf16* OG = (bf16*)(ws + WS_OG); float* LSE = (float*)(ws + WS_LSE);
    float* HU = (float*)(ws + WS_HU); float* HP = (float*)(ws + WS_HP); float* HS = (float*)(ws + WS_HS);

    NEWTID();
    p0_prologue(A, lds, tid, G);
    xcd_barrier(bar);

    { pg8::Gemm g{(const pg8::bf16_t*)(ws + WS_MN), (const pg8::bf16_t*)(ws + WS_WMEM), 256, 1024, 1024}; pg8::StaticOrder S; S.init(256, 1024, G, (bid + 4) % G);
      pg8::EpiMem E{A.out + O_MEMKV, (pg8::bf16_t*)MKV};
      pg8::gemm_phase<pg8::EpiMem, pg8::StaticOrder, false, PG8_SP2>(lds, g, S, E); }
    __syncthreads();
    { pg8::Gemm g{(const pg8::bf16_t*)(ws + WS_XN), (const pg8::bf16_t*)(ws + WS_WIN), MROWS, NIN, 1024}; pg8::StaticOrder S; S.init(MROWS, NIN, G, bid);
      pg8::EpiU E{(pg8::bf16_t*)U, (const float*)(ws + WS_CS), A.out, (pg8::bf16_t*)(ws + WS_GT)};
      pg8::gemm_phase<pg8::EpiU, pg8::StaticOrder, PG8_ALIGN, PG8_SP2>(lds, g, S, E); }
    xcd_barrier(bar);

    NEWTID();
    for (int u = bid; u < 128; u += G) samp_attn_unit(A, U, YA, u, tid);
    NEWTID();
    for (int u = bid; u < 512; u += G) samp_xattn_unit(lds, A, U, YC, u >> 2, u & 3, tid);
    NEWTID();
    for (int u = bid; u < 512; u += G) samp_hgrn_unit(lds, A, U, YB, u >> 2, u & 3, tid);
    NEWTID();
    for (int u = bid; u < 256; u += G) hgrn_mfma_unit<false>(lds, U, A.lbl, A.hgn, HS, HU, HP, YB, u & 3, u >> 2, tid);
    NEWTID();
    for (int u = bid; u < 3072; u += G) { const int g = u >> 10, rem = u & 1023, h = rem & 7, rb = rem >> 3, dil = (g == 0) ? 1 : (g == 1 ? 4 : 16), nblk = 128 / dil;
        attn_dil_unit(lds, U, OG, LSE, g, dil, rb / nblk, rb % nblk, h, tid); }
    NEWTID();
    for (int u = bid; u < 512; u += G) xattn_unit(lds, U, MKV, YC, u >> 2, u & 3, tid);
    xcd_barrier(bar);

    { pg8::Gemm g{(const pg8::bf16_t*)YA, (const pg8::bf16_t*)(ws + WS_WPA), MROWS, 1024, 1536}; pg8::PanelOrder S{64, 4, bid - (G - 4)};
      pg8::EpiMerged E{(const pg8::bf16_t*)(ws + WS_GT), (pg8::bf16_t*)(ws + WS_MG)};
      pg8::gemm_phase<pg8::EpiMerged, pg8::PanelOrder, false, PG8_SP2>(lds, g, S, E); }
    __syncthreads();
    NEWTID();
    for (int u = bid; u < 256; u += G) hgrn_scan_unit(HU, HP, HS, A.out + O_HGP, u, tid);
    NEWTID();
    for (int t = bid * 8 + (tid >> 6); t < T_SEQ; t += G * 8) attn_merge_row(U, OG, LSE, YA, t, tid & 63);
    xcd_barrier(bar);

    NEWTID();
    for (int u = bid; u < 256; u += G) hgrn_mfma_unit<true>(lds, U, A.lbl, A.hgn, HS, HU, HP, YB, u & 3, u >> 2, tid);
    __syncthreads();
    { pg8::Gemm g{(const pg8::bf16_t*)(ws + WS_MG), (const pg8::bf16_t*)(ws + WS_WOUT), MROWS, 1024, 1024}; pg8::PanelOrder S{64, 4, bid - (G - 4)};
      pg8::EpiZ E{(float*)(ws + WS_Z)};
      pg8::gemm_phase<pg8::EpiZ, pg8::PanelOrder, false, PG8_SP2>(lds, g, S, E); }
    xcd_barrier(bar);

    { pg8::Gemm g{(const pg8::bf16_t*)YA, (const pg8::bf16_t*)(ws + WS_WPA), T_SEQ, 1024, 1536}; pg8::StaticOrder S; S.init(T_SEQ, 1024, G, bid);
      pg8::EpiMerged E{(const pg8::bf16_t*)(ws + WS_GT), (pg8::bf16_t*)(ws + WS_MG)};
      pg8::gemm_phase<pg8::EpiMerged, pg8::StaticOrder, PG8_ALIGN, PG8_SP2>(lds, g, S, E); }
    xcd_barrier(bar);

    { pg8::Gemm g{(const pg8::bf16_t*)(ws + WS_MG), (const pg8::bf16_t*)(ws + WS_WOUT), T_SEQ, 1024, 1024}; pg8::StaticOrder S; S.init(T_SEQ, 1024, G, bid);
      pg8::EpiZ E{(float*)(ws + WS_Z)};
      pg8::gemm_phase<pg8::EpiZ, pg8::StaticOrder, PG8_ALIGN, PG8_SP2>(lds, g, S, E); }
    xcd_barrier(bar);

    NEWTID();
    { const float* Z = (const float*)(ws + WS_Z); const int lane = tid & 63;
      for (int m = bid * 8 + (tid >> 6); m < T_SEQ + NSAMP; m += G * 8) {
          if (m < T_SEQ) final_row(Z + (size_t)m * 1024, A.xp + (size_t)m * 1024, A.npost, A.out + O_YP + (size_t)m * 1024, lane);
          else final_row(Z + (size_t)m * 1024, A.xs + (size_t)(m - T_SEQ) * 1024, A.npost, A.out + O_YS + (size_t)(m - T_SEQ) * 1024, lane); } }
}

extern "C" void kernel_launch(void* const* d_in, const int* in_sizes, int n_in, void* d_out, int out_size, void* d_ws, size_t ws_size, hipStream_t stream) {
    static int grid = 0;
    if (grid == 0) {
        if (n_in != 19 || out_size != (int)O_END || ws_size < WS_END) { fprintf(stderr, "kernel_launch: unexpected shapes (n_in %d, out %d, ws %zu); nothing launched\n", n_in, out_size, ws_size); grid = -1; return; }
        int dev = 0, cus = 0, per_cu = 0;
        if (hipGetDevice(&dev) != hipSuccess || hipDeviceGetAttribute(&cus, hipDeviceAttributeMultiprocessorCount, dev) != hipSuccess) { grid = -1; return; }
        if (hipFuncSetAttribute((const void*)fwd_kernel, hipFuncAttributeMaxDynamicSharedMemorySize, LDS_BYTES) != hipSuccess) { fprintf(stderr, "kernel_launch: hipFuncSetAttribute failed\n"); grid = -1; return; }
        if (hipOccupancyMaxActiveBlocksPerMultiprocessor(&per_cu, (const void*)fwd_kernel, 512, LDS_BYTES) != hipSuccess || per_cu < 1) { fprintf(stderr, "kernel_launch: occupancy query says %d blocks per CU\n", per_cu); per_cu = 1; }
        (void)hipGetLastError();
        grid = cus;
    }
    if (grid < 0) return;
    if (hipMemsetAsync((char*)d_ws + WS_CTL, 0, CTL_ZERO_BYTES, stream) != hipSuccess) return;
    Args a{};
    a.xp = (const float*)d_in[0]; a.xs = (const float*)d_in[1]; a.memp = (const float*)d_in[2]; a.c128 = (const float*)d_in[3]; a.c512 = (const float*)d_in[4]; a.c2048 = (const float*)d_in[5];
    a.sth = (const float*)d_in[6]; a.cmem = (const float*)d_in[7]; a.npre = (const float*)d_in[8]; a.npost = (const float*)d_in[9]; a.win = (const float*)d_in[10]; a.lbl = (const float*)d_in[11];
    a.hgn = (const float*)d_in[12]; a.mnorm = (const float*)d_in[13]; a.wmem = (const float*)d_in[14]; a.wpa = (const float*)d_in[15]; a.wpb = (const float*)d_in[16]; a.wpc = (const float*)d_in[17]; a.wout = (const float*)d_in[18];
    a.out = (float*)d_out; a.ws = (unsigned char*)d_ws;
    hipLaunchKernelGGL(fwd_kernel, dim3(grid), dim3(512), LDS_BYTES, stream, a);
    const hipError_t le = hipPeekAtLastError();
    if (le != hipSuccess) fprintf(stderr, "kernel_launch: launch failed: %s\n", hipGetErrorName(le));
}
```

```cpp
#include <hip/hip_runtime.h>
#include <cstdio>
#include <cstdint>
constexpr int T_SEQ = 16384, DMODEL = 1024, NSAMP = 128, MROWS = 16640  , NIN = 11264;
constexpr int C_AQ = 0, C_AK = 1536, C_AV = 3072, C_AZ = 4608, C_BQ = 5120, C_BF = 5632, C_BI = 6144, C_BZ = 6656, C_CQ = 7168, C_CZ = 7680, C_GA = 8192;
constexpr float EPS = 1e-6f;
constexpr int YPITCH = 1536;
constexpr size_t O_YP = 0, O_YS = 16777216, O_W128P = 16908288, O_W512P = 17039360, O_W2048P = 17563648, O_HGP = 19660800, O_MEMKV = 19726336,
                 O_W128S = 19988480, O_W512S = 20119552, O_W2048S = 20250624, O_HGS = 20381696, O_END = 28770304;
constexpr size_t MiB = 1u << 20;
constexpr size_t WS_CTL = 0, CTL_ZERO_BYTES = 1 * MiB;
constexpr size_t WS_WIN = 2 * MiB, WS_WMEM = 24 * MiB, WS_WPA = 26 * MiB, WS_WPB = 27 * MiB, WS_WPC = 28 * MiB, WS_WOUT = 29 * MiB, WS_MN = 31 * MiB, WS_MEMKV = 31 * MiB + 512 * 1024;
constexpr size_t WS_CS = 32 * MiB, WS_XN = 36 * MiB, WS_U = 70 * MiB, WS_OG = 428 * MiB, WS_LSE = 477 * MiB, WS_HU = 479 * MiB, WS_HP = 495 * MiB, WS_HS = 496 * MiB;
constexpr size_t WS_YA = 512 * MiB, WS_YB = 529 * MiB, WS_YC = 546 * MiB, WS_M32 = 563 * MiB, WS_MG = 628 * MiB, WS_Z = 661 * MiB, WS_GT = 726 * MiB, WS_END = 824 * MiB;
constexpr int CW_BAR = 4096;
namespace pg8 {
#define PG8_LAS __attribute__((address_space(3)))
typedef unsigned short bf16_t;
typedef short bf16x8 __attribute__((ext_vector_type(8)));
typedef float f32x4 __attribute__((ext_vector_type(4)));
typedef unsigned u32x4 __attribute__((ext_vector_type(4)));
constexpr int BM = 256, BK = 64, HALF = 128, HTB = HALF * BK * 2  , STAGE_BYTES = 8 * HTB, NXCD = 8, WGM = 8;

__host__ __device__ __forceinline__ int lds_byte(int r, int c) { const int st = (r >> 4) * 2 + (c >> 5), rr = r & 15, cc = c & 31, ob = rr * 64 + cc * 2; return st * 1024 + (ob ^ (((ob >> 9) & 1) << 5)); }
__host__ __device__ __forceinline__ void stage_rc(int b, int& R, int& C) { const int st = b / 1024, sb = b % 1024, swz = sb ^ (((sb >> 9) & 1) << 5); R = (st >> 1) * 16 + swz / 64; C = (st & 1) * 32 + (swz % 64) / 2; }
__host__ __device__ __forceinline__ int perm32(int rho) { const int n = rho >> 4, i = rho & 15; return 8 * (i >> 2) + 4 * n + (i & 3); }

struct Unit { int pm, pn; };
struct Gemm { const bf16_t* A; const bf16_t* Bt; int M, N, K; };

struct StaticOrder {
    int nM, nN, nwg, G, c;
    __host__ __device__ void init(int M, int N, int G_, int c_) { nM = M / BM; nN = N / BM; nwg = nM * nN; G = G_; c = c_; }
    __host__ __device__ bool next(int i, Unit& u) const {
        const long L = (long)i * G + c; if (L >= nwg) return false;
        int wgid = (int)L; { const int q = nwg / NXCD, r = nwg % NXCD, xcd = wgid % NXCD, off = wgid / NXCD; wgid = (xcd < r ? xcd * (q + 1) : r * (q + 1) + (xcd - r) * q) + off; }
        const int nig = WGM * nN, gid = wgid / nig, fm = gid * WGM, gsz = (nM - fm) < WGM ? (nM - fm) : WGM;
        u.pm = fm + ((wgid % nig) % gsz); u.pn = (wgid % nig) / gsz; return true;
    }
    __device__ __forceinline__ void a_ready(const Unit&) const {}
    __device__ __forceinline__ void done(const Unit&) const {}
};

struct PanelOrder {
    int pm, n, c;
    __device__ __forceinline__ bool next(int i, Unit& u) const { if (i > 0 || c < 0 || c >= n) return false; u.pm = pm; u.pn = c; return true; }
    __device__ __forceinline__ void a_ready(const Unit&) const {}
    __device__ __forceinline__ void done(const Unit&) const {}
};
__device__ __forceinline__ unsigned cvt_pk_bf16(float lo, float hi) { unsigned r; asm volatile("v_cvt_pk_bf16_f32 %0, %1, %2" : "=v"(r) : "v"(lo), "v"(hi)); return r; }
typedef unsigned u32x2 __attribute__((ext_vector_type(2)));
typedef float f32x2 __attribute__((ext_vector_type(2)));
__device__ __forceinline__ float sigm(float x) { return __builtin_amdgcn_rcpf(1.0f + __builtin_amdgcn_exp2f(x * -1.4426950408889634f)); }
__device__ __forceinline__ float bflo(unsigned w) { return __uint_as_float(w << 16); }
__device__ __forceinline__ float bfhi(unsigned w) { return __uint_as_float(w & 0xffff0000u); }

struct EpiU {
    static constexpr bool PERM = true, AFTER_DRAIN = false, MID = false;
    bf16_t* U; const float* cs; float* out; bf16_t* GT;
    __device__ __forceinline__ void operator()(const f32x4 (&acc)[2][2][4][2], const Unit& u, int wr, int wc, int fr, int fq) const {
        const int pn = u.pn, rbase = u.pm * 256 + wr * 64 + fr, cbase = pn * 256 + wc * 32 + 8 * fq;
        if (pn < 12) {
            const bool isk = pn >= 6; const int g = isk ? ((pn - 6) >> 1) : 0;
            const int t0 = (g == 0) ? 16256 : (g == 1 ? 15872 : 14336);
            const size_t offp = (g == 0) ? O_W128P : (g == 1 ? O_W512P : O_W2048P), offs = (g == 0) ? O_W128S : (g == 1 ? O_W512S : O_W2048S);
            const float qs = isk ? 1.0f : 0.125f;
            const int i0 = 16 * (wc & 1) + 4 * fq, hb0 = pn * 256 + (wc >> 1) * 64;
#pragma unroll
            for (int ai = 0; ai < 2; ++ai)
#pragma unroll
                for (int m = 0; m < 4; ++m) { const int row = rbase + ai * 128 + m * 16, pos = row < T_SEQ ? row : 8192;
                    float* dstr = nullptr;
                    if (isk) { if (row < T_SEQ) { if (row >= t0) dstr = out + offp + (size_t)(row - t0) * 1024; } else if (row < T_SEQ + NSAMP) dstr = out + offs + (size_t)(row - T_SEQ) * 1024; }
                    const float* cp = cs + ((size_t)pos * 32 + i0) * 2; const f32x4 ca = *(const f32x4*)cp * qs, cb = *(const f32x4*)(cp + 4) * qs;
                    const f32x4 cc = (f32x4){ca[0], ca[2], cb[0], cb[2]}, ss = (f32x4){ca[1], ca[3], cb[1], cb[3]};
#pragma unroll
                    for (int bj = 0; bj < 2; ++bj) { const f32x4 xl = acc[ai][bj][m][0], xh = acc[ai][bj][m][1];
                        const f32x4 lo = xl * cc - xh * ss, hi = xh * cc + xl * ss;
                        bf16_t* up = U + (size_t)row * NIN + hb0 + bj * 128 + i0;
                        u32x2 wl; wl.x = cvt_pk_bf16(lo[0], lo[1]); wl.y = cvt_pk_bf16(lo[2], lo[3]); *(u32x2*)up = wl;
                        u32x2 wh; wh.x = cvt_pk_bf16(hi[0], hi[1]); wh.y = cvt_pk_bf16(hi[2], hi[3]); *(u32x2*)(up + 32) = wh;
                        if (dstr) { float* d = dstr + (((hb0 + bj * 128 - C_AK) >> 6) & 7) * 64 + i0; *(f32x4*)d = lo; *(f32x4*)(d + 32) = hi; } } }
        } else if (pn < 18) {
            const int g = (pn - 12) >> 1; const int t0 = (g == 0) ? 16256 : (g == 1 ? 15872 : 14336);
            const size_t offp = (g == 0) ? O_W128P : (g == 1 ? O_W512P : O_W2048P), offs = (g == 0) ? O_W128S : (g == 1 ? O_W512S : O_W2048S);
#pragma unroll
            for (int ai = 0; ai < 2; ++ai)
#pragma unroll
                for (int m = 0; m < 4; ++m) { const int row = rbase + ai * 128 + m * 16;
                    float* dstr = nullptr;
                    if (row < T_SEQ) { if (row >= t0) dstr = out + offp + (size_t)(row - t0) * 1024 + 512; } else if (row < T_SEQ + NSAMP) dstr = out + offs + (size_t)(row - T_SEQ) * 1024 + 512;
#pragma unroll
                    for (int bj = 0; bj < 2; ++bj) { const int vc = cbase + bj * 128; const f32x4 x0 = acc[ai][bj][m][0], x1 = acc[ai][bj][m][1];
                        u32x4 w; w.x = cvt_pk_bf16(x0[0], x0[1]); w.y = cvt_pk_bf16(x0[2], x0[3]); w.z = cvt_pk_bf16(x1[0], x1[1]); w.w = cvt_pk_bf16(x1[2], x1[3]); *(u32x4*)(U + (size_t)row * NIN + vc) = w;
                        if (dstr) { float* d = dstr + ((vc - C_AV) & 511); *(f32x4*)d = x0; *(f32x4*)(d + 4) = x1; } } }
        } else if (pn < 32) {
            const bool act = (pn < 20 || pn == 26 || pn == 27 || pn == 30 || pn == 31);
#pragma unroll
            for (int ai = 0; ai < 2; ++ai)
#pragma unroll
                for (int m = 0; m < 4; ++m) { const int row = rbase + ai * 128 + m * 16;
#pragma unroll
                    for (int bj = 0; bj < 2; ++bj) { const int vc = cbase + bj * 128; f32x4 x0 = acc[ai][bj][m][0], x1 = acc[ai][bj][m][1];
                        if (act) {
#pragma unroll
                            for (int j = 0; j < 4; ++j) { x0[j] *= sigm(x0[j]); x1[j] *= sigm(x1[j]); } }
                        u32x4 w; w.x = cvt_pk_bf16(x0[0], x0[1]); w.y = cvt_pk_bf16(x0[2], x0[3]); w.z = cvt_pk_bf16(x1[0], x1[1]); w.w = cvt_pk_bf16(x1[2], x1[3]); *(u32x4*)(U + (size_t)row * NIN + vc) = w; } }
        } else {
            const int br = (pn - 32) >> 2, pt = (pn - 32) & 3, wid = wr * 4 + wc, lane = fq * 16 + fr;
            bf16_t* gp = GT + ((((size_t)(br * 65 + u.pm) * 4 + pt) * 8 + wid) * 16) * 512 + lane * 8;
#pragma unroll
            for (int ai = 0; ai < 2; ++ai)
#pragma unroll
                for (int bj = 0; bj < 2; ++bj)
#pragma unroll
                    for (int m = 0; m < 4; ++m) { f32x4 x0 = acc[ai][bj][m][0], x1 = acc[ai][bj][m][1];
#pragma unroll
                        for (int j = 0; j < 4; ++j) { x0[j] = fmaxf(sigm(x0[j]), 1e-30f); x1[j] = fmaxf(sigm(x1[j]), 1e-30f); }
                        u32x4 w; w.x = cvt_pk_bf16(x0[0], x0[1]); w.y = cvt_pk_bf16(x0[2], x0[3]); w.z = cvt_pk_bf16(x1[0], x1[1]); w.w = cvt_pk_bf16(x1[2], x1[3]);
                        *(u32x4*)(gp + ((ai * 2 + bj) * 4 + m) * 512) = w;
                        if (u.pm == 64) *(u32x4*)(U + (size_t)(rbase + ai * 128 + m * 16) * NIN + cbase + bj * 128) = w; }
        }
    }
};
struct EpiMem {
    static constexpr bool PERM = false, AFTER_DRAIN = false, MID = false;
    float* O; bf16_t* B;
    __device__ __forceinline__ void operator()(const f32x4 (&acc)[2][2][4][2], const Unit& u, int wr, int wc, int fr, int fq) const {
        const int rbase = u.pm * 256 + wr * 64 + fr, cbase = u.pn * 256 + wc * 32 + 4 * fq;
#pragma unroll
        for (int ai = 0; ai < 2; ++ai)
#pragma unroll
            for (int m = 0; m < 4; ++m) { const int row = rbase + ai * 128 + m * 16;
#pragma unroll
                for (int bj = 0; bj < 2; ++bj)
#pragma unroll
                    for (int n = 0; n < 2; ++n) { const int c = cbase + bj * 128 + n * 16; const f32x4 x = acc[ai][bj][m][n];
                        *(f32x4*)(O + (size_t)row * 1024 + c) = x; u32x2 w; w.x = cvt_pk_bf16(x[0], x[1]); w.y = cvt_pk_bf16(x[2], x[3]); *(u32x2*)(B + (size_t)row * 1024 + c) = w; } }
    }
};
struct EpiMerged {
    static constexpr bool PERM = true, AFTER_DRAIN = false, MID = true;
    const bf16_t* GT; bf16_t* MG;
    __device__ __forceinline__ const bf16_t* gtp(int br, const Unit& u, int wr, int wc, int fr, int fq) const {
        return GT + ((((size_t)(br * 65 + u.pm) * 4 + u.pn) * 8 + wr * 4 + wc) * 16) * 512 + (fq * 16 + fr) * 8; }
    __device__ __forceinline__ void mid(f32x4 (&acc)[2][2][4][2], const Unit& u, int t, int wr, int wc, int fr, int fq) const {
        int lo = (fq * 16 + fr) * 8; asm volatile("" : "+v"(lo));
        const int br = (t == 8) ? 0 : 1;
        const bf16_t* pa = GT + ((((size_t)(br * 65 + u.pm) * 4 + u.pn) * 8 + wr * 4 + wc) * 16) * 512 + lo; const bf16_t* pb = pa + (size_t)65 * 4 * 8 * 16 * 512;
#pragma unroll
        for (int ai = 0; ai < 2; ++ai)
#pragma unroll
            for (int bj = 0; bj < 2; ++bj) {
#pragma unroll
                for (int m = 0; m < 4; ++m) { const int i2 = (ai * 2 + bj) * 4 + m; const u32x4 a = *(const u32x4*)(pa + i2 * 512), b = *(const u32x4*)(pb + i2 * 512);
                    f32x4 r0, r1; r0[0] = bflo(a.x) * __builtin_amdgcn_rcpf(bflo(b.x)); r0[1] = bfhi(a.x) * __builtin_amdgcn_rcpf(bfhi(b.x)); r0[2] = bflo(a.y) * __builtin_amdgcn_rcpf(bflo(b.y)); r0[3] = bfhi(a.y) * __builtin_amdgcn_rcpf(bfhi(b.y));
                    r1[0] = bflo(a.z) * __builtin_amdgcn_rcpf(bflo(b.z)); r1[1] = bfhi(a.z) * __builtin_amdgcn_rcpf(bfhi(b.z)); r1[2] = bflo(a.w) * __builtin_amdgcn_rcpf(bflo(b.w)); r1[3] = bfhi(a.w) * __builtin_amdgcn_rcpf(bfhi(b.w));
                    acc[ai][bj][m][0] = acc[ai][bj][m][0] * r0; acc[ai][bj][m][1] = acc[ai][bj][m][1] * r1; }
                asm volatile("" ::: "memory"); }
    }
    __device__ __forceinline__ void operator()(const f32x4 (&acc)[2][2][4][2], const Unit& u, int wr, int wc, int fr, int fq) const {
        const int rbase = u.pm * 256 + wr * 64 + fr, cbase = u.pn * 256 + wc * 32 + 8 * fq;
        const bf16_t* pc = gtp(2, u, wr, wc, fr, fq);
#pragma unroll
        for (int ai = 0; ai < 2; ++ai)
#pragma unroll
            for (int m = 0; m < 4; ++m) { const int row = rbase + ai * 128 + m * 16;
#pragma unroll
                for (int bj = 0; bj < 2; ++bj) { const int c = cbase + bj * 128; const f32x4 x0 = acc[ai][bj][m][0], x1 = acc[ai][bj][m][1];
                    const u32x4 gw = *(const u32x4*)(pc + ((ai * 2 + bj) * 4 + m) * 512);
                    u32x4 w; w.x = cvt_pk_bf16(x0[0] * bflo(gw.x), x0[1] * bfhi(gw.x)); w.y = cvt_pk_bf16(x0[2] * bflo(gw.y), x0[3] * bfhi(gw.y));
                    w.z = cvt_pk_bf16(x1[0] * bflo(gw.z), x1[1] * bfhi(gw.z)); w.w = cvt_pk_bf16(x1[2] * bflo(gw.w), x1[3] * bfhi(gw.w)); *(u32x4*)(MG + (size_t)row * 1024 + c) = w; } }
    }
};
struct EpiZ {
    static constexpr bool PERM = false, AFTER_DRAIN = false, MID = false;
    float* Z;
    __device__ __forceinline__ void operator()(const f32x4 (&acc)[2][2][4][2], const Unit& u, int wr, int wc, int fr, int fq) const {
        const int rbase = u.pm * 256 + wr * 64 + fr, cbase = u.pn * 256 + wc * 32 + 4 * fq;
#pragma unroll
        for (int ai = 0; ai < 2; ++ai)
#pragma unroll
            for (int m = 0; m < 4; ++m) { const int row = rbase + ai * 128 + m * 16;
#pragma unroll
                for (int bj = 0; bj < 2; ++bj)
#pragma unroll
                    for (int n = 0; n < 2; ++n) *(f32x4*)(Z + (size_t)row * 1024 + cbase + bj * 128 + n * 16) = acc[ai][bj][m][n]; }
    }
};
template <class Epi, class Sched, bool ALIGN_EPI = false, bool SP2 = false>
__device__ __forceinline__ void gemm_phase(PG8_LAS unsigned char* lds, const Gemm g, const Sched& S, const Epi& E) {
    int tid = threadIdx.x; asm volatile("" : "+v"(tid));
    const int wid = __builtin_amdgcn_readfirstlane(tid >> 6), lane = tid & 63, wr = wid >> 2, wc = wid & 3, fr = lane & 15, fq = lane >> 4;
    const int K = g.K, nt = K / BK;
    unsigned voffA[2], voffB[2];
#pragma unroll
    for (int i = 0; i < 2; ++i) { int R, C; stage_rc(tid * 16 + i * 8192, R, C); const int Rb = Epi::PERM ? ((R & ~31) + perm32(R & 31)) : R;
        voffA[i] = (unsigned)(R * K + C) * 2u; voffB[i] = (unsigned)(Rb * K + C) * 2u; }
    const size_t kstep = (size_t)(BK * 2);
    const size_t hstep = (size_t)HALF * K * 2;
    const size_t tstep = 2 * hstep;
    const unsigned ldsw = (unsigned)wid * 1024u;
    const int aoff = lds_byte(wr * 64 + fr, fq * 8), boff = lds_byte(wc * 32 + fr, fq * 8);
#define PG8_SA(b, h) (((b) * 2 + (h)) * HTB)
#define PG8_SB(b, h) ((4 + (b) * 2 + (h)) * HTB)
#define PG8_STAGE(bufoff, gbase, voff) do { _Pragma("unroll") for (int _i = 0; _i < 2; ++_i) \
        __builtin_amdgcn_global_load_lds((const unsigned*)((const char*)(gbase) + (voff)[_i]), (PG8_LAS unsigned*)(lds + (bufoff) + ldsw + _i * 8192), 16, 0, 0); } while (0)
#define PG8_LDA(dst, b, h) do { _Pragma("unroll") for (int m = 0; m < 4; ++m) _Pragma("unroll") for (int k = 0; k < 2; ++k) dst[m][k] = *(const PG8_LAS bf16x8*)(lds + PG8_SA(b, h) + aoff + m * 2048 + k * 1024); } while (0)
#define PG8_LDB(dst, b, h) do { _Pragma("unroll") for (int n = 0; n < 2; ++n) _Pragma("unroll") for (int k = 0; k < 2; ++k) dst[n][k] = *(const PG8_LAS bf16x8*)(lds + PG8_SB(b, h) + boff + n * 2048 + k * 1024); } while (0)
#define PG8_MMA(ai, bj, At, Bt) do { __builtin_amdgcn_s_setprio(1); _Pragma("unroll") for (int m = 0; m < 4; ++m) _Pragma("unroll") for (int n = 0; n < 2; ++n) _Pragma("unroll") for (int k = 0; k < 2; ++k) \
        acc[ai][bj][m][n] = __builtin_amdgcn_mfma_f32_16x16x32_bf16(Bt[n][k], At[m][k], acc[ai][bj][m][n], 0, 0, 0); __builtin_amdgcn_s_setprio(0); } while (0)
#define PG8_WAIT_V(n) asm volatile("s_waitcnt vmcnt(" #n ")" ::: "memory")
#define PG8_WAIT_L(n) asm volatile("s_waitcnt lgkmcnt(" #n ")" ::: "memory")
#define PG8_BAR __builtin_amdgcn_s_barrier()
#define PG8_SCHED __builtin_amdgcn_sched_barrier(0)
    Unit cur, nxt; int ui = 0;
    if (!S.next(0, cur)) return;
    f32x4 acc[2][2][4][2];
#pragma unroll
    for (int a = 0; a < 2; ++a)
#pragma unroll
        for (int b = 0; b < 2; ++b)
#pragma unroll
            for (int m = 0; m < 4; ++m)
#pragma unroll
                for (int n = 0; n < 2; ++n) acc[a][b][m][n] = (f32x4){0.f, 0.f, 0.f, 0.f};
    bf16x8 At[4][2], B0[2][2], B1[2][2];
    const char* cA = (const char*)g.A + (size_t)cur.pm * tstep; const char* cB = (const char*)g.Bt + (size_t)cur.pn * tstep;
    S.a_ready(cur);
    if constexpr (SP2) {
        PG8_STAGE(PG8_SB(0, 0), cB, voffB); PG8_STAGE(PG8_SB(0, 1), cB + hstep, voffB); PG8_STAGE(PG8_SA(0, 0), cA, voffA); PG8_STAGE(PG8_SA(0, 1), cA + hstep, voffA);
        if (wr == 1) PG8_BAR;
        PG8_WAIT_V(2); PG8_BAR;
        PG8_STAGE(PG8_SB(1, 0), cB + kstep, voffB); PG8_STAGE(PG8_SA(1, 0), cA + kstep, voffA); PG8_STAGE(PG8_SB(1, 1), cB + hstep + kstep, voffB);
        PG8_WAIT_V(6); PG8_BAR;
    } else {
        PG8_STAGE(PG8_SB(0, 0), cB, voffB); PG8_STAGE(PG8_SA(0, 0), cA, voffA); PG8_STAGE(PG8_SB(0, 1), cB + hstep, voffB); PG8_STAGE(PG8_SA(0, 1), cA + hstep, voffA);
        if (wr == 1) PG8_BAR;
        PG8_WAIT_V(4); PG8_BAR;
        PG8_STAGE(PG8_SB(1, 0), cB + kstep, voffB); PG8_STAGE(PG8_SA(1, 0), cA + kstep, voffA); PG8_STAGE(PG8_SB(1, 1), cB + hstep + kstep, voffB);
        PG8_WAIT_V(6); PG8_BAR;
    }
    for (;;) {
        const bool has_next = S.next(ui + 1, nxt);
        const char* nA = has_next ? (const char*)g.A + (size_t)nxt.pm * tstep : cA; const char* nB = has_next ? (const char*)g.Bt + (size_t)nxt.pn * tstep : cB;
        for (int t = 0; t < nt; t += 2) {
            const bool last = (t == nt - 2);
            const char* a1 = cA + (size_t)(t + 1) * kstep;
            const char* a2 = last ? nA : cA + (size_t)(t + 2) * kstep; const char* b2 = last ? nB : cB + (size_t)(t + 2) * kstep;
            const char* a3 = a2 + kstep; const char* b3 = b2 + kstep;
            if (last && has_next) S.a_ready(nxt);
            if constexpr (Epi::MID) { if (t == 8 || t == 16) E.mid(acc, cur, t, wr, wc, fr, fq); }
            if constexpr (SP2) {
            PG8_LDB(B0, 0, 0); PG8_LDB(B1, 0, 1); PG8_SCHED; PG8_LDA(At, 0, 0); PG8_STAGE(PG8_SA(1, 1), a1 + hstep, voffA);
            PG8_WAIT_V(8); PG8_WAIT_L(0); PG8_BAR; PG8_MMA(0, 0, At, B0); PG8_MMA(0, 1, At, B1); PG8_BAR; PG8_SCHED;
            PG8_LDA(At, 0, 1); PG8_STAGE(PG8_SB(0, 0), b2, voffB); PG8_STAGE(PG8_SB(0, 1), b2 + hstep, voffB); PG8_STAGE(PG8_SA(0, 0), a2, voffA);
            PG8_WAIT_V(8); PG8_WAIT_L(0); PG8_BAR; PG8_MMA(1, 0, At, B0); PG8_MMA(1, 1, At, B1); PG8_BAR; PG8_SCHED;
            PG8_LDB(B0, 1, 0); PG8_LDB(B1, 1, 1); PG8_SCHED; PG8_LDA(At, 1, 0); PG8_STAGE(PG8_SA(0, 1), a2 + hstep, voffA);
            PG8_WAIT_V(8); PG8_WAIT_L(0); PG8_BAR; PG8_MMA(0, 0, At, B0); PG8_MMA(0, 1, At, B1); PG8_BAR; PG8_SCHED;
            PG8_LDA(At, 1, 1); PG8_STAGE(PG8_SB(1, 0), b3, voffB); PG8_STAGE(PG8_SB(1, 1), b3 + hstep, voffB); PG8_STAGE(PG8_SA(1, 0), a3, voffA);
            PG8_WAIT_V(8); PG8_WAIT_L(0); PG8_BAR; PG8_MMA(1, 0, At, B0); PG8_MMA(1, 1, At, B1); PG8_BAR; PG8_SCHED;
            } else {
            PG8_LDB(B0, 0, 0); PG8_SCHED; PG8_LDA(At, 0, 0); PG8_STAGE(PG8_SA(1, 1), a1 + hstep, voffA);
            PG8_WAIT_L(8); PG8_BAR; PG8_WAIT_L(0); PG8_MMA(0, 0, At, B0); PG8_BAR; PG8_SCHED;
            PG8_LDB(B1, 0, 1); PG8_STAGE(PG8_SB(0, 0), b2, voffB);
            PG8_BAR; PG8_WAIT_L(0); PG8_MMA(0, 1, At, B1); PG8_BAR;
            PG8_LDA(At, 0, 1); PG8_STAGE(PG8_SA(0, 0), a2, voffA);
            PG8_BAR; PG8_WAIT_L(0); PG8_MMA(1, 0, At, B0); PG8_BAR; PG8_SCHED;
            PG8_STAGE(PG8_SB(0, 1), b2 + hstep, voffB);
            PG8_WAIT_V(6); PG8_BAR; PG8_MMA(1, 1, At, B1); PG8_BAR;
            PG8_LDB(B0, 1, 0); PG8_SCHED; PG8_LDA(At, 1, 0); PG8_STAGE(PG8_SA(0, 1), a2 + hstep, voffA);
            PG8_WAIT_L(8); PG8_BAR; PG8_WAIT_L(0); PG8_MMA(0, 0, At, B0); PG8_BAR; PG8_SCHED;
            PG8_LDB(B1, 1, 1); PG8_STAGE(PG8_SB(1, 0), b3, voffB);
            PG8_BAR; PG8_WAIT_L(0); PG8_MMA(0, 1, At, B1); PG8_BAR;
            PG8_LDA(At, 1, 1); PG8_STAGE(PG8_SA(1, 0), a3, voffA);
            PG8_BAR; PG8_WAIT_L(0); PG8_MMA(1, 0, At, B0); PG8_BAR; PG8_SCHED;
            PG8_STAGE(PG8_SB(1, 1), b3 + hstep, voffB);
            PG8_WAIT_V(6); PG8_BAR; PG8_MMA(1, 1, At, B1); PG8_BAR;
            }
        }
        if constexpr (ALIGN_EPI) { if (wr == 0) PG8_BAR; }
        if constexpr (!Epi::AFTER_DRAIN) { E(acc, cur, wr, wc, fr, fq); S.done(cur); }
        if (!has_next) break;
#pragma unroll
        for (int a = 0; a < 2; ++a)
#pragma unroll
            for (int b = 0; b < 2; ++b)
#pragma unroll
                for (int m = 0; m < 4; ++m)
#pragma unroll
                    for (int n = 0; n < 2; ++n) acc[a][b][m][n] = (f32x4){0.f, 0.f, 0.f, 0.f};
        cur = nxt; cA = nA; cB = nB; ++ui;
        if constexpr (ALIGN_EPI) { if (wr == 1) PG8_BAR; }
    }
    PG8_WAIT_V(0);
    if constexpr (!ALIGN_EPI) { if (wr == 0) PG8_BAR; }
    PG8_BAR;
    if constexpr (Epi::AFTER_DRAIN) { E.fused(acc, cur, wr, wc, fr, fq, lds, wid, lane); S.done(cur); }
#undef PG8_SA
#undef PG8_SB
#undef PG8_STAGE
#undef PG8_LDA
#undef PG8_LDB
#undef PG8_MMA
#undef PG8_WAIT_V
#undef PG8_WAIT_L
#undef PG8_BAR
#undef PG8_SCHED
}
}
#ifndef PG8_SP2
#define PG8_SP2 true
#endif
#ifndef PG8_ALIGN
#define PG8_ALIGN true
#endif
constexpr int RING_BYTES = 131072;
constexpr int LDSCTL_OFF = RING_BYTES, MISC_OFF = LDSCTL_OFF + 320;
constexpr int LDS_BYTES = 147456;
#define GAS __attribute__((address_space(1)))
#define LAS __attribute__((address_space(3)))
#define XB_TMO      128
#define XB_XCNT(j)  (256  + 64 * (j))
#define XB_XSUB(j)  (1280 + 64 * (j))
#define XB_XGEN(j)  (2304 + 64 * (j))
#define XB_TOP      3328
#define XB_TOPGEN   3392
#define XCD_BAR_WORDS 3456
#define XB_SPIN_CAP (1u << 18)

__device__ __forceinline__ unsigned xb_ld(unsigned* p)              { return __hip_atomic_load(p, __ATOMIC_RELAXED, __HIP_MEMORY_SCOPE_AGENT); }
__device__ __forceinline__ unsigned xb_add(unsigned* p, unsigned v) { return __hip_atomic_fetch_add(p, v, __ATOMIC_RELAXED, __HIP_MEMORY_SCOPE_AGENT); }
__device__ __forceinline__ unsigned xb_xcc_id() { return (unsigned)__builtin_amdgcn_s_getreg((3 << 11) | 20) & 0xFu; }
#define XB_SPIN(cond, bar) do { unsigned _sp = 0; while (cond) { __builtin_amdgcn_s_sleep(1); \
    if ((++_sp & 255u) == 0u) { if (xb_ld(&(bar)[XB_TMO])) break; if (_sp > XB_SPIN_CAP) { atomicAdd(&(bar)[XB_TMO], 1u); break; } } } } while (0)

struct XcdBarrier {
    unsigned* bar; unsigned x;
    volatile LAS unsigned* st;
};

__device__ __forceinline__ XcdBarrier xcd_barrier_post(unsigned* bar, volatile LAS unsigned* st) {
    XcdBarrier b; b.bar = bar; b.x = xb_xcc_id(); b.st = st;
    if (threadIdx.x == 0) (void)xb_add(&bar[XB_XCNT(b.x)], 1u);
    return b;
}
__device__ __forceinline__ void xcd_barrier_complete(unsigned* bar, unsigned x, unsigned& nloc, unsigned& nx) {
    const unsigned G = gridDim.x * gridDim.y * gridDim.z;
    unsigned sum, cnt, mine, sp = 0u;
    for (;;) {
        sum = 0u; cnt = 0u; mine = 0u;
#pragma unroll
        for (unsigned j = 0; j < 16; ++j) { const unsigned c = xb_ld(&bar[XB_XCNT(j)]); sum += c; cnt += (c > 0u) ? 1u : 0u; mine = (j == x) ? c : mine; }
        if (sum == G) break;
        __builtin_amdgcn_s_sleep(1);
        if ((++sp & 255u) == 0u) { if (xb_ld(&bar[XB_TMO])) break; if (sp > XB_SPIN_CAP) { atomicAdd(&bar[XB_TMO], 1u); break; } }
    }
    nloc = mine > 0u ? mine : 1u; nx = cnt > 0u ? cnt : 1u;
}

__device__ __forceinline__ void xcd_barrier(const XcdBarrier& b) {
    asm volatile("s_waitcnt vmcnt(0)" ::: "memory");
    __syncthreads();
    if (threadIdx.x == 0) {
        unsigned* bar = b.bar;
        __builtin_amdgcn_s_waitcnt(0);
        unsigned nloc = b.st[0], nx = b.st[1];
        if (nloc == 0u) { xcd_barrier_complete(bar, b.x, nloc, nx); b.st[0] = nloc; b.st[1] = nx; }
        const unsigned old = xb_add(&bar[XB_XSUB(b.x)], 1u);
        const unsigned gen = old / nloc;
        if (old + 1u == (gen + 1u) * nloc) {
            __builtin_amdgcn_fence(__ATOMIC_RELEASE, "agent");
            asm volatile("s_waitcnt vmcnt(0)" ::: "memory");
            const unsigned og = xb_add(&bar[XB_TOP], 1u);
            const unsigned tg = og / nx;
            if (og + 1u == (tg + 1u) * nx) xb_add(&bar[XB_TOPGEN], 1u);
            else XB_SPIN(xb_ld(&bar[XB_TOPGEN]) == tg, bar);
            __builtin_amdgcn_fence(__ATOMIC_ACQUIRE, "agent");
            xb_add(&bar[XB_XGEN(b.x)], 1u);
            asm volatile("s_waitcnt vmcnt(0)" ::: "memory");
        } else {
            XB_SPIN(xb_ld(&bar[XB_XGEN(b.x)]) == gen, bar);
            __builtin_amdgcn_fence(__ATOMIC_ACQUIRE, "agent");
            asm volatile("s_waitcnt vmcnt(0)" ::: "memory");
        }
    }
    __syncthreads();
}
typedef unsigned short bf16;
typedef unsigned v4u __attribute__((ext_vector_type(4)));
typedef unsigned v2u __attribute__((ext_vector_type(2)));
typedef float f32x4 __attribute__((ext_vector_type(4)));
typedef short bf16x8 __attribute__((ext_vector_type(8)));
typedef LAS unsigned char* ldsp;
#define LDS_WAIT() asm volatile("s_waitcnt lgkmcnt(0)" ::: "memory")
__device__ __forceinline__ unsigned f2bf(float f) { unsigned u = __builtin_bit_cast(unsigned, f); return (u + 0x7fffu + ((u >> 16) & 1u)) >> 16; }
__device__ __forceinline__ unsigned pk2(float lo, float hi) { return f2bf(lo) | (f2bf(hi) << 16); }
__device__ __forceinline__ float blo(unsigned w) { return __uint_as_float(w << 16); }
__device__ __forceinline__ float bhi(unsigned w) { return __uint_as_float(w & 0xffff0000u); }
__device__ __forceinline__ float b2f(bf16 b) { return __uint_as_float(((unsigned)b) << 16); }
__device__ __forceinline__ float sigmoid_f(float x) { return __builtin_amdgcn_rcpf(1.0f + __builtin_amdgcn_exp2f(x * -1.4426950408889634f)); }
__device__ __forceinline__ float wave_sum(float v) {
#pragma unroll
    for (int o = 1; o < 64; o <<= 1) v += __shfl_xor(v, o);
    return v;
}
#define MFMA16(a, b, c) __builtin_amdgcn_mfma_f32_16x16x32_bf16((a), (b), (c), 0, 0, 0)

struct Args {
    const float *xp, *xs, *memp, *c128, *c512, *c2048, *sth, *cmem, *npre, *npost, *win, *lbl, *hgn, *mnorm, *wmem, *wpa, *wpb, *wpc, *wout;
    float* out; unsigned char* ws;
};

__device__ __forceinline__ int win_vrow(int n) { if (n < 3072) { const int d = n & 63; return (n & ~63) + ((d & 3) | (((d >> 5) & 1) << 2) | (((d >> 2) & 3) << 3) | (((d >> 4) & 1) << 5)); } return n; }
__device__ __forceinline__ void transpose_item(const float* W, int K, int N, bf16* WT, bool rope, LAS float* scr, int item, int lane, int ldk = 0, int koff = 0) {
    if (ldk == 0) ldk = K;
    const int nblk = N / 32, kb = item / nblk, nb = item % nblk, k0 = 64 * kb, n0 = 32 * nb;
#pragma unroll 8
    for (int i = 0; i < 32; ++i) { const int kk = 2 * i + (lane >> 5); scr[kk * 33 + (lane & 31)] = W[(size_t)(k0 + kk) * N + n0 + (lane & 31)]; }
    LDS_WAIT(); asm volatile("" ::: "memory");
    const int c = lane & 7;
#pragma unroll
    for (int j = 0; j < 4; ++j) { const int n = (lane >> 3) + 8 * j; const LAS float* s = scr + (8 * c) * 33 + n;
        v4u o; o.x = pk2(s[0 * 33], s[1 * 33]); o.y = pk2(s[2 * 33], s[3 * 33]); o.z = pk2(s[4 * 33], s[5 * 33]); o.w = pk2(s[6 * 33], s[7 * 33]);
        const int dr = rope ? win_vrow(n0 + n) : (n0 + n);
        *(v4u*)(WT + (size_t)dr * ldk + koff + k0 + 8 * c) = o; }
    LDS_WAIT(); asm volatile("" ::: "memory");
}
__device__ __forceinline__ void rms_row_to_bf16(const float* xrow, const float* g, bf16* orow, int lane) {
    const f32x4* xr = (const f32x4*)xrow + lane; const f32x4* gr = (const f32x4*)g + lane;
    f32x4 v[4]; float s = 0.f;
#pragma unroll
    for (int j = 0; j < 4; ++j) { v[j] = xr[64 * j]; s += (v[j].x * v[j].x + v[j].y * v[j].y) + (v[j].z * v[j].z + v[j].w * v[j].w); }
    const float rstd = rsqrtf(wave_sum(s) * (1.f / 1024.f) + EPS);
    v2u* o8 = (v2u*)orow + lane;
#pragma unroll
    for (int j = 0; j < 4; ++j) { const f32x4 gv = gr[64 * j]; v2u w; w.x = pk2(v[j].x * rstd * gv.x, v[j].y * rstd * gv.y); w.y = pk2(v[j].z * rstd * gv.z, v[j].w * rstd * gv.w); o8[64 * j] = w; }
}
__device__ __forceinline__ void sincos_entry(int pos, int i, float& c, float& s) {
    const float invf[32] = {1.000000000e+00f, 7.498942018e-01f, 5.623413324e-01f, 4.216965139e-01f, 3.162277639e-01f, 2.371373773e-01f, 1.778279394e-01f, 1.333521456e-01f, 1.000000015e-01f, 7.498942316e-02f, 5.623413250e-02f, 4.216964915e-02f, 3.162277490e-02f, 2.371373773e-02f, 1.778279431e-02f, 1.333521400e-02f, 9.999999776e-03f, 7.498942316e-03f, 5.623413250e-03f, 4.216964822e-03f, 3.162277630e-03f, 2.371373819e-03f, 1.778279431e-03f, 1.333521446e-03f, 1.000000047e-03f, 7.498941850e-04f, 5.623413017e-04f, 4.216965172e-04f, 3.162277571e-04f, 2.371373703e-04f, 1.778279402e-04f, 1.333521504e-04f};
    const float ang = (float)pos * invf[i];
    const double x = (double)ang, kq = rint(x * 0.63661977236758134308);
    double r = fma(-kq, 1.57079632679489655800, x); r = fma(-kq, 6.12323399573676603587e-17, r);
    const float rf = (float)r, r2 = rf * rf; const int q = ((int)kq) & 3;
    const float sp = rf + rf * r2 * (-1.6666654611e-1f + r2 * (8.3321608736e-3f + r2 * (-1.9515295891e-4f)));
    const float cp = 1.0f - 0.5f * r2 + r2 * r2 * (4.166664568298827e-2f + r2 * (-1.388731625493765e-3f + r2 * 2.443315711809948e-5f));
    c = (q == 0) ? cp : (q == 1 ? -sp : (q == 2 ? -cp : sp));
    s = (q == 0) ? sp : (q == 1 ? cp : (q == 2 ? -sp : -cp));
}
__device__ __forceinline__ void p0_prologue(const Args& A, ldsp lds, int tid, int G) {
    const int lane = tid & 63, wave = tid >> 6;
    unsigned char* ws = A.ws;
    LAS float* scr = (LAS float*)(lds + wave * 16384);
    const int gw = blockIdx.x * 8 + wave, NGW = G * 8;
    constexpr int I_IN = 16 * 352, I_MEM = 16 * 32, I_BR = 8 * 32, I_OUT = 16 * 32, NITEMS = I_IN + I_MEM + 3 * I_BR + I_OUT;
    for (int it = gw; it < NITEMS; it += NGW) {
        int r = it;
        if (r < I_IN) { transpose_item(A.win, 1024, NIN, (bf16*)(ws + WS_WIN), true, scr, r, lane); continue; } r -= I_IN;
        if (r < I_MEM) { transpose_item(A.wmem, 1024, 1024, (bf16*)(ws + WS_WMEM), false, scr, r, lane); continue; } r -= I_MEM;
        if (r < I_BR) { transpose_item(A.wpa, 512, 1024, (bf16*)(ws + WS_WPA), false, scr, r, lane, 1536, 0); continue; } r -= I_BR;
        if (r < I_BR) { transpose_item(A.wpb, 512, 1024, (bf16*)(ws + WS_WPA), false, scr, r, lane, 1536, 512); continue; } r -= I_BR;
        if (r < I_BR) { transpose_item(A.wpc, 512, 1024, (bf16*)(ws + WS_WPA), false, scr, r, lane, 1536, 1024); continue; } r -= I_BR;
        transpose_item(A.wout, 1024, 1024, (bf16*)(ws + WS_WOUT), false, scr, r, lane);
    }
    bf16* XN = (bf16*)(ws + WS_XN); bf16* MN = (bf16*)(ws + WS_MN);
    for (int m = gw; m < T_SEQ + NSAMP + 256; m += NGW) {
        if (m < T_SEQ) rms_row_to_bf16(A.xp + (size_t)m * 1024, A.npre, XN + (size_t)m * 1024, lane);
        else if (m < T_SEQ + NSAMP) rms_row_to_bf16(A.xs + (size_t)(m - T_SEQ) * 1024, A.npre, XN + (size_t)m * 1024, lane);
        else rms_row_to_bf16(A.memp + (size_t)(m - T_SEQ - NSAMP) * 1024, A.mnorm, MN + (size_t)(m - T_SEQ - NSAMP) * 1024, lane);
    }
    float* cs = (float*)(ws + WS_CS);
    for (int e = blockIdx.x * 512 + tid; e < T_SEQ * 32; e += G * 512) { float c, s; sincos_entry(e >> 5, e & 31, c, s); *(float2*)(cs + (size_t)e * 2) = make_float2(c, s); }
}

constexpr int VT_STRIDE = 276;
__device__ __forceinline__ void attn_dil_unit(ldsp lds, const bf16* U, bf16* OG, float* LSE, int g, int dil, int r, int nb, int h, int tid) {
    const int lane = tid & 63, w = __builtin_amdgcn_readfirstlane(tid >> 6), l15 = lane & 15, q4 = lane >> 4;
    LAS bf16* VT = (LAS bf16*)lds;
    const int colq = C_AQ + g * 512 + h * 64, colk = C_AK + g * 512 + h * 64, colv = C_AV + g * 512 + h * 64;
    __syncthreads();
#pragma unroll
    for (int it = 0; it < 4; ++it) { const int key = (tid >> 3) + 64 * it, d8 = (tid & 7) * 8, kp = (nb - 1) * 128 + key;
        bf16x8 v = (bf16x8){0, 0, 0, 0, 0, 0, 0, 0};
        if (kp >= 0) v = *(const bf16x8*)(U + (size_t)(kp * dil + r) * NIN + colv + d8);
#pragma unroll
        for (int j = 0; j < 8; ++j) VT[(d8 + j) * VT_STRIDE + key] = (bf16)v[j]; }
    for (int e = tid; e < 64 * 20; e += 512) VT[(e / 20) * VT_STRIDE + 256 + (e % 20)] = 0;
    __syncthreads();
    const int tq = (nb * 128 + w * 16 + l15) * dil + r;
    bf16x8 qf[2];
#pragma unroll
    for (int kk = 0; kk < 2; ++kk) qf[kk] = *(const bf16x8*)(U + (size_t)tq * NIN + colq + 32 * kk + 8 * q4);
    f32x4 s[9];
#pragma unroll
    for (int kt = 0; kt < 9; ++kt) { int kp = (nb - 1) * 128 + 16 * w + 16 * kt + l15; kp = kp < 0 ? 0 : kp;
        const bf16* kr = U + (size_t)(kp * dil + r) * NIN + colk + 8 * q4;
        f32x4 a = (f32x4){0.f, 0.f, 0.f, 0.f};
#pragma unroll
        for (int kk = 0; kk < 2; ++kk) a = MFMA16(*(const bf16x8*)(kr + 32 * kk), qf[kk], a);
        s[kt] = a; }
    float m = -1e30f;
#pragma unroll
    for (int kt = 0; kt < 9; ++kt)
#pragma unroll
        for (int j = 0; j < 4; ++j) { const int klr = 16 * kt + 4 * q4 + j, dist = l15 + 128 - klr;
            const bool ok = dist >= 0 && dist <= 128 && (nb > 0 || (16 * w + klr) >= 128);
            s[kt][j] = ok ? s[kt][j] : -1e30f; m = fmaxf(m, s[kt][j]); }
    m = fmaxf(m, __shfl_xor(m, 16)); m = fmaxf(m, __shfl_xor(m, 32));
    float l = 0.f;
#pragma unroll
    for (int kt = 0; kt < 9; ++kt)
#pragma unroll
        for (int j = 0; j < 4; ++j) { const float p = __expf(s[kt][j] - m); s[kt][j] = p; l += p; }
    l += __shfl_xor(l, 16); l += __shfl_xor(l, 32);
    f32x4 o[4];
#pragma unroll
    for (int dt = 0; dt < 4; ++dt) o[dt] = (f32x4){0.f, 0.f, 0.f, 0.f};
#pragma unroll
    for (int ks = 0; ks < 5; ++ks) {
        v4u pw; pw.x = pk2(s[2 * ks][0], s[2 * ks][1]); pw.y = pk2(s[2 * ks][2], s[2 * ks][3]);
        if (ks < 4) { pw.z = pk2(s[2 * ks + 1][0], s[2 * ks + 1][1]); pw.w = pk2(s[2 * ks + 1][2], s[2 * ks + 1][3]); } else { pw.z = 0u; pw.w = 0u; }
        const bf16x8 pf = __builtin_bit_cast(bf16x8, pw);
#pragma unroll
        for (int dt = 0; dt < 4; ++dt) { const LAS bf16* vp = VT + (16 * dt + l15) * VT_STRIDE + 16 * w + 32 * ks + 4 * q4;
            const v2u lo = *(const LAS v2u*)vp, hi = *(const LAS v2u*)(vp + 16);
            v4u vw; vw.x = lo.x; vw.y = lo.y; vw.z = hi.x; vw.w = hi.y;
            o[dt] = MFMA16(__builtin_bit_cast(bf16x8, vw), pf, o[dt]); } }
    const float inv = 1.0f / l;
    bf16* op = OG + ((size_t)g * MROWS + tq) * 512 + h * 64 + 4 * q4;
#pragma unroll
    for (int dt = 0; dt < 4; ++dt) { v2u wv; wv.x = pk2(o[dt][0] * inv, o[dt][1] * inv); wv.y = pk2(o[dt][2] * inv, o[dt][3] * inv); *(v2u*)(op + 16 * dt) = wv; }
    if (q4 == 0) LSE[((size_t)g * MROWS + tq) * 8 + h] = m + __logf(l);
}
__device__ __forceinline__ void xattn_unit(ldsp lds, const bf16* U, const bf16* MKV, bf16* YC, int tile, int h, int tid) {
    const int lane = tid & 63, w = __builtin_amdgcn_readfirstlane(tid >> 6), l15 = lane & 15, q4 = lane >> 4;
    LAS bf16* VT = (LAS bf16*)lds;
    __syncthreads();
#pragma unroll
    for (int it = 0; it < 8; ++it) { const int key = (tid >> 4) + 32 * it, d8 = (tid & 15) * 8;
        const bf16x8 v = *(const bf16x8*)(MKV + (size_t)key * 1024 + 512 + h * 128 + d8);
#pragma unroll
        for (int j = 0; j < 8; ++j) VT[(d8 + j) * VT_STRIDE + key] = (bf16)v[j]; }
    __syncthreads();
    const int row = tile * 128 + w * 16 + l15;
    bf16x8 qf[4];
#pragma unroll
    for (int kk = 0; kk < 4; ++kk) qf[kk] = *(const bf16x8*)(U + (size_t)row * NIN + C_CQ + h * 128 + 32 * kk + 8 * q4);
    f32x4 s[16];
#pragma unroll
    for (int kt = 0; kt < 16; ++kt) { const bf16* kr = MKV + (size_t)(16 * kt + l15) * 1024 + h * 128 + 8 * q4;
        f32x4 a = (f32x4){0.f, 0.f, 0.f, 0.f};
#pragma unroll
        for (int kk = 0; kk < 4; ++kk) a = MFMA16(*(const bf16x8*)(kr + 32 * kk), qf[kk], a);
        s[kt] = a * 0.08838834764831845f; }
    float m = -1e30f;
#pragma unroll
    for (int kt = 0; kt < 16; ++kt)
#pragma unroll
        for (int j = 0; j < 4; ++j) m = fmaxf(m, s[kt][j]);
    m = fmaxf(m, __shfl_xor(m, 16)); m = fmaxf(m, __shfl_xor(m, 32));
    float l = 0.f;
#pragma unroll
    for (int kt = 0; kt < 16; ++kt)
#pragma unroll
        for (int j = 0; j < 4; ++j) { const float p = __expf(s[kt][j] - m); s[kt][j] = p; l += p; }
    l += __shfl_xor(l, 16); l += __shfl_xor(l, 32);
    f32x4 o[8];
#pragma unroll
    for (int dt = 0; dt < 8; ++dt) o[dt] = (f32x4){0.f, 0.f, 0.f, 0.f};
#pragma unroll
    for (int ks = 0; ks < 8; ++ks) {
        v4u pw; pw.x = pk2(s[2 * ks][0], s[2 * ks][1]); pw.y = pk2(s[2 * ks][2], s[2 * ks][3]); pw.z = pk2(s[2 * ks + 1][0], s[2 * ks + 1][1]); pw.w = pk2(s[2 * ks + 1][2], s[2 * ks + 1][3]);
        const bf16x8 pf = __builtin_bit_cast(bf16x8, pw);
#pragma unroll
        for (int dt = 0; dt < 8; ++dt) { const LAS bf16* vp = VT + (16 * dt + l15) * VT_STRIDE + 32 * ks + 4 * q4;
            const v2u lo = *(const LAS v2u*)vp, hi = *(const LAS v2u*)(vp + 16);
            v4u vw; vw.x = lo.x; vw.y = lo.y; vw.z = hi.x; vw.w = hi.y;
            o[dt] = MFMA16(__builtin_bit_cast(bf16x8, vw), pf, o[dt]); } }
    const float inv = 1.0f / l;
    const bf16* zp = U + (size_t)row * NIN + C_CZ + h * 128 + 4 * q4; bf16* op = YC + (size_t)row * YPITCH + h * 128 + 4 * q4;
#pragma unroll
    for (int dt = 0; dt < 8; ++dt) { const v2u z = *(const v2u*)(zp + 16 * dt); v2u wv;
        wv.x = pk2(o[dt][0] * inv * blo(z.x), o[dt][1] * inv * bhi(z.x)); wv.y = pk2(o[dt][2] * inv * blo(z.y), o[dt][3] * inv * bhi(z.y)); *(v2u*)(op + 16 * dt) = wv; }
}
__device__ __forceinline__ float lb_of(const float* lbl, int c) { return 1.0f / (1.0f + __expf(lbl[512 + c] - lbl[c])); }
__device__ __forceinline__ void hgrn_pass1_unit(ldsp lds, const bf16* U, const float* lbl, float* HU, float* HP, int h, int j, int tid) {
    LAS float* fb = (LAS float*)lds; LAS float* kb = fb + 32 * 128; LAS float* vb = kb + 32 * 128;
    const int v = tid & 127, kq = __builtin_amdgcn_readfirstlane(tid >> 7), tok = tid >> 4, c8 = (tid & 15) * 8;
    float s[32], lbr[8];
#pragma unroll
    for (int i = 0; i < 32; ++i) s[i] = 0.f;
#pragma unroll
    for (int e = 0; e < 8; ++e) lbr[e] = lb_of(lbl, h * 128 + c8 + e);
    float pacc = 1.f;
    for (int ch = 0; ch < 8; ++ch) {
        __syncthreads();
        { const size_t ro = (size_t)(j * 256 + ch * 32 + tok) * NIN + h * 128 + c8;
          const v4u fw = *(const v4u*)(U + ro + C_BF), vw = *(const v4u*)(U + ro + C_BI);
          const unsigned fa[4] = {fw.x, fw.y, fw.z, fw.w}, va[4] = {vw.x, vw.y, vw.z, vw.w};
#pragma unroll
          for (int e = 0; e < 4; ++e) { const float x0 = blo(fa[e]), x1 = bhi(fa[e]);
              const float f0 = lbr[2 * e] + (1.f - lbr[2 * e]) * sigmoid_f(x0), f1 = lbr[2 * e + 1] + (1.f - lbr[2 * e + 1]) * sigmoid_f(x1);
              const int o = tok * 128 + c8 + 2 * e;
              fb[o] = f0; fb[o + 1] = f1; kb[o] = 1.f - f0; kb[o + 1] = 1.f - f1; vb[o] = blo(va[e]); vb[o + 1] = bhi(va[e]); } }
        __syncthreads();
        for (int tt = 0; tt < 32; ++tt) { const float vv = vb[tt * 128 + v]; const LAS f32x4* f4 = (const LAS f32x4*)(fb + tt * 128 + kq * 32); const LAS f32x4* k4 = (const LAS f32x4*)(kb + tt * 128 + kq * 32);
#pragma unroll
            for (int i4 = 0; i4 < 8; ++i4) { const f32x4 f = f4[i4], k = k4[i4];
#pragma unroll
                for (int e = 0; e < 4; ++e) s[4 * i4 + e] = f[e] * s[4 * i4 + e] + k[e] * vv; } }
        if (tid < 128) { for (int tt = 0; tt < 32; ++tt) pacc *= fb[tt * 128 + tid]; }
    }
    float* up = HU + ((size_t)(j * 4 + h) * 128 + kq * 32) * 128 + v;
#pragma unroll
    for (int i = 0; i < 32; ++i) up[(size_t)i * 128] = s[i];
    if (tid < 128) HP[(size_t)(j * 4 + h) * 128 + tid] = pacc;
}
__device__ __forceinline__ void hgrn_scan_unit(const float* __restrict__ HU, const float* __restrict__ HP, float* __restrict__ HS, float* __restrict__ outS, int e, int tid) {
    if (tid >= 256) return;
    const int idx = e * 256 + tid, h = idx >> 14, k = (idx >> 7) & 127, vk = idx & 16383;
    float S = 0.f;
#pragma unroll 1
    for (int j0 = 0; j0 < 64; j0 += 16) { float hu[16], hp[16];
#pragma unroll
        for (int q = 0; q < 16; ++q) { hu[q] = HU[(size_t)((j0 + q) * 4 + h) * 16384 + vk]; hp[q] = HP[(size_t)((j0 + q) * 4 + h) * 128 + k]; }
#pragma unroll
        for (int q = 0; q < 16; ++q) { HS[(size_t)((j0 + q) * 4 + h) * 16384 + vk] = S; S = hp[q] * S + hu[q]; } }
    outS[idx] = S;
}
__device__ __forceinline__ void hgrn_pass3_unit(ldsp lds, const bf16* U, const float* lbl, const float* hgn, const float* HS, bf16* YB, int h, int j, int tid) {
    LAS float* fb = (LAS float*)lds; LAS float* kb = fb + 32 * 128; LAS float* vb = kb + 32 * 128; LAS float* qb = vb + 32 * 128; LAS float* ob = qb + 32 * 128;
    const int lane = tid & 63, wv = tid >> 6, v = tid & 127, kq = __builtin_amdgcn_readfirstlane(tid >> 7), tok = tid >> 4, c8 = (tid & 15) * 8;
    float s[32], lbr[8];
    { const float* sp = HS + ((size_t)(j * 4 + h) * 128 + kq * 32) * 128 + v;
#pragma unroll
      for (int i = 0; i < 32; ++i) s[i] = sp[(size_t)i * 128]; }
#pragma unroll
    for (int e = 0; e < 8; ++e) lbr[e] = lb_of(lbl, h * 128 + c8 + e);
    const float g0 = hgn[h * 128 + lane], g1 = hgn[h * 128 + 64 + lane];
    for (int ch = 0; ch < 8; ++ch) {
        __syncthreads();
        { const size_t ro = (size_t)(j * 256 + ch * 32 + tok) * NIN + h * 128 + c8;
          const v4u fw = *(const v4u*)(U + ro + C_BF), vw = *(const v4u*)(U + ro + C_BI), qw = *(const v4u*)(U + ro + C_BQ);
          const unsigned fa[4] = {fw.x, fw.y, fw.z, fw.w}, va[4] = {vw.x, vw.y, vw.z, vw.w}, qa[4] = {qw.x, qw.y, qw.z, qw.w};
#pragma unroll
          for (int e = 0; e < 4; ++e) { const float x0 = blo(fa[e]), x1 = bhi(fa[e]);
              const float f0 = lbr[2 * e] + (1.f - lbr[2 * e]) * sigmoid_f(x0), f1 = lbr[2 * e + 1] + (1.f - lbr[2 * e + 1]) * sigmoid_f(x1);
              const int o = tok * 128 + c8 + 2 * e;
              fb[o] = f0; fb[o + 1] = f1; kb[o] = 1.f - f0; kb[o + 1] = 1.f - f1; vb[o] = blo(va[e]); vb[o + 1] = bhi(va[e]); qb[o] = blo(qa[e]); qb[o + 1] = bhi(qa[e]); } }
        __syncthreads();
        for (int tt = 0; tt < 32; ++tt) { const float vv = vb[tt * 128 + v]; const LAS f32x4* f4 = (const LAS f32x4*)(fb + tt * 128 + kq * 32); const LAS f32x4* k4 = (const LAS f32x4*)(kb + tt * 128 + kq * 32); const LAS f32x4* q4p = (const LAS f32x4*)(qb + tt * 128 + kq * 32);
            float acc = 0.f;
#pragma unroll
            for (int i4 = 0; i4 < 8; ++i4) { const f32x4 f = f4[i4], k = k4[i4], q = q4p[i4];
#pragma unroll
                for (int e = 0; e < 4; ++e) { s[4 * i4 + e] = f[e] * s[4 * i4 + e] + k[e] * vv; acc += s[4 * i4 + e] * q[e]; } }
            ob[(tt * 4 + kq) * 128 + v] = acc; }
        __syncthreads();
#pragma unroll
        for (int q = 0; q < 4; ++q) { const int tt = wv * 4 + q; const LAS float* op = ob + tt * 512;
            const float o0 = (op[lane] + op[128 + lane]) + (op[256 + lane] + op[384 + lane]), o1 = (op[64 + lane] + op[192 + lane]) + (op[320 + lane] + op[448 + lane]);
            const float rstd = rsqrtf(wave_sum(o0 * o0 + o1 * o1) * (1.f / 128.f) + EPS);
            const size_t t = (size_t)(j * 256 + ch * 32 + tt);
            const bf16* zp = U + t * NIN + C_BZ + h * 128; bf16* yp = YB + t * YPITCH + h * 128;
            yp[lane] = (bf16)f2bf(o0 * rstd * g0 * b2f(zp[lane])); yp[64 + lane] = (bf16)f2bf(o1 * rstd * g1 * b2f(zp[64 + lane])); }
    }
}
constexpr int HG_QT_STRIDE = 136, HG_KH_STRIDE = 40;
template <bool OUT>
__device__ __forceinline__ void hgrn_mfma_unit(ldsp lds, const bf16* U, const float* lbl, const float* hgn, const float* HS, float* HU, float* HP, bf16* YB, int h, int j, int tid) {
    const int lane = tid & 63, w = __builtin_amdgcn_readfirstlane(tid >> 6), l15 = lane & 15, q4 = lane >> 4;
    const int k = tid & 127, tq = tid >> 7, tok = tid >> 4, c8 = (tid & 15) * 8;
    LAS bf16* RAWQ = (LAS bf16*)lds; LAS bf16* RAWF = RAWQ + 4096; LAS bf16* RAWV = RAWF + 4096;
    LAS float* QS = (LAS float*)(lds + 24576); LAS float* DC = (LAS float*)(lds + 26624);
    LAS bf16* QT = (LAS bf16*)(lds + 27136); LAS bf16* KT = (LAS bf16*)(lds + 35840); LAS bf16* KH = (LAS bf16*)(lds + 44544); LAS bf16* VT = (LAS bf16*)(lds + 54784);
    LAS float* SSQ = (LAS float*)(lds + 65024);
    const float lb = lb_of(lbl, h * 128 + k), oml = 1.f - lb;
    f32x4 S[8];
    if (OUT) { const float* sp = HS + (size_t)(j * 4 + h) * 16384 + (size_t)(4 * q4) * 128 + 16 * w + l15;
#pragma unroll
        for (int kt = 0; kt < 8; ++kt)
#pragma unroll
            for (int r = 0; r < 4; ++r) S[kt][r] = sp[(size_t)(16 * kt + r) * 128]; }
    else {
#pragma unroll
        for (int kt = 0; kt < 8; ++kt) S[kt] = (f32x4){0.f, 0.f, 0.f, 0.f}; }
    float ptot = 0.f;
    v4u rq, rf, rv;
    { const size_t ro = (size_t)(j * 256 + tok) * NIN + h * 128 + c8; rf = *(const v4u*)(U + ro + C_BF); rv = *(const v4u*)(U + ro + C_BI); if (OUT) rq = *(const v4u*)(U + ro + C_BQ); else rq = rf; }
    for (int ch = 0; ch < 8; ++ch) {
        __syncthreads();
        *(LAS v4u*)(RAWF + tok * 128 + c8) = rf; *(LAS v4u*)(RAWV + tok * 128 + c8) = rv; if (OUT) *(LAS v4u*)(RAWQ + tok * 128 + c8) = rq;
        if (ch < 7) { const size_t ro = (size_t)(j * 256 + (ch + 1) * 32 + tok) * NIN + h * 128 + c8; rf = *(const v4u*)(U + ro + C_BF); rv = *(const v4u*)(U + ro + C_BI); if (OUT) rq = *(const v4u*)(U + ro + C_BQ); }
        __syncthreads();
        float kin[8], cum[8]; float c = 0.f;
#pragma unroll
        for (int i = 0; i < 8; ++i) { const float x = b2f(RAWF[(8 * tq + i) * 128 + k]); const float f = lb + oml * sigmoid_f(x); kin[i] = 1.f - f; c += __logf(f); cum[i] = c; }
        QS[tq * 128 + k] = c;
        __syncthreads();
        const float q0 = QS[k], q1 = QS[128 + k], q2 = QS[256 + k], q3 = QS[384 + k];
        const float pre = (tq > 0 ? q0 : 0.f) + (tq > 1 ? q1 : 0.f) + (tq > 2 ? q2 : 0.f), tot = (q0 + q1) + (q2 + q3);
        { unsigned khw[4], vtw[4];
#pragma unroll
          for (int i2 = 0; i2 < 4; ++i2) { float kh2[2]; unsigned short vv2[2];
#pragma unroll
              for (int e = 0; e < 2; ++e) { const int i = 2 * i2 + e, t = 8 * tq + i; const float b = pre + cum[i];
                  if (OUT) { const float eb = __expf(b); QT[t * HG_QT_STRIDE + k] = (bf16)f2bf(b2f(RAWQ[t * 128 + k]) * eb); KT[t * HG_QT_STRIDE + k] = (bf16)f2bf(kin[i] * __expf(fminf(-b, 80.f))); }
                  kh2[e] = kin[i] * __expf(tot - b); vv2[e] = RAWV[t * 128 + k]; }
              khw[i2] = pk2(kh2[0], kh2[1]); vtw[i2] = (unsigned)vv2[0] | ((unsigned)vv2[1] << 16); }
          v4u a; a.x = khw[0]; a.y = khw[1]; a.z = khw[2]; a.w = khw[3]; *(LAS v4u*)(KH + k * HG_KH_STRIDE + 8 * tq) = a;
          v4u b; b.x = vtw[0]; b.y = vtw[1]; b.z = vtw[2]; b.w = vtw[3]; *(LAS v4u*)(VT + k * HG_KH_STRIDE + 8 * tq) = b; }
        if (tq == 0) { DC[k] = __expf(tot); ptot += tot; }
        __syncthreads();
        const bf16x8 vnat = *(const LAS bf16x8*)(VT + (16 * w + l15) * HG_KH_STRIDE + 8 * q4);
        f32x4 o[2];
        if (OUT) {
            f32x4 a00 = (f32x4){0.f, 0.f, 0.f, 0.f}, a01 = a00, a11 = a00;
#pragma unroll
            for (int kk = 0; kk < 4; ++kk) { const bf16x8 k0 = *(const LAS bf16x8*)(KT + l15 * HG_QT_STRIDE + 32 * kk + 8 * q4), k1 = *(const LAS bf16x8*)(KT + (16 + l15) * HG_QT_STRIDE + 32 * kk + 8 * q4);
                const bf16x8 t0 = *(const LAS bf16x8*)(QT + l15 * HG_QT_STRIDE + 32 * kk + 8 * q4), t1 = *(const LAS bf16x8*)(QT + (16 + l15) * HG_QT_STRIDE + 32 * kk + 8 * q4);
                a00 = MFMA16(k0, t0, a00); a01 = MFMA16(k0, t1, a01); a11 = MFMA16(k1, t1, a11); }
#pragma unroll
            for (int r = 0; r < 4; ++r) { const bool ok = (4 * q4 + r) <= l15; a00[r] = ok ? a00[r] : 0.f; a11[r] = ok ? a11[r] : 0.f; }
            v4u p0, p1; p0.x = pk2(a00[0], a00[1]); p0.y = pk2(a00[2], a00[3]); p0.z = 0u; p0.w = 0u;
            p1.x = pk2(a01[0], a01[1]); p1.y = pk2(a01[2], a01[3]); p1.z = pk2(a11[0], a11[1]); p1.w = pk2(a11[2], a11[3]);
            const LAS bf16* vp = VT + (16 * w + l15) * HG_KH_STRIDE + 4 * q4; const v2u vlo = *(const LAS v2u*)vp, vhi = *(const LAS v2u*)(vp + 16);
            v4u vw; vw.x = vlo.x; vw.y = vlo.y; vw.z = vhi.x; vw.w = vhi.y; const bf16x8 vperm = __builtin_bit_cast(bf16x8, vw);
            o[0] = MFMA16(vperm, __builtin_bit_cast(bf16x8, p0), ((f32x4){0.f, 0.f, 0.f, 0.f}));
            o[1] = MFMA16(vperm, __builtin_bit_cast(bf16x8, p1), ((f32x4){0.f, 0.f, 0.f, 0.f}));
#pragma unroll
            for (int kk = 0; kk < 4; ++kk) { v4u sw; sw.x = pk2(S[2 * kk][0], S[2 * kk][1]); sw.y = pk2(S[2 * kk][2], S[2 * kk][3]); sw.z = pk2(S[2 * kk + 1][0], S[2 * kk + 1][1]); sw.w = pk2(S[2 * kk + 1][2], S[2 * kk + 1][3]);
                const bf16x8 sf = __builtin_bit_cast(bf16x8, sw);
#pragma unroll
                for (int tt = 0; tt < 2; ++tt) { const LAS bf16* qp = QT + (16 * tt + l15) * HG_QT_STRIDE + 32 * kk + 4 * q4; const v2u qlo = *(const LAS v2u*)qp, qhi = *(const LAS v2u*)(qp + 16);
                    v4u qw; qw.x = qlo.x; qw.y = qlo.y; qw.z = qhi.x; qw.w = qhi.y; o[tt] = MFMA16(sf, __builtin_bit_cast(bf16x8, qw), o[tt]); } }
        }
#pragma unroll
        for (int kt = 0; kt < 8; ++kt) { const f32x4 d = *(const LAS f32x4*)(DC + 16 * kt + 4 * q4); const bf16x8 kf = *(const LAS bf16x8*)(KH + (16 * kt + l15) * HG_KH_STRIDE + 8 * q4);
            S[kt] = MFMA16(kf, vnat, S[kt] * d); }
        if (OUT) {
#pragma unroll
            for (int tt = 0; tt < 2; ++tt) { float p = (o[tt][0] * o[tt][0] + o[tt][1] * o[tt][1]) + (o[tt][2] * o[tt][2] + o[tt][3] * o[tt][3]); p += __shfl_xor(p, 16); p += __shfl_xor(p, 32); if (q4 == 0) SSQ[w * 32 + 16 * tt + l15] = p; }
            __syncthreads();
            const f32x4 g4 = *(const f32x4*)(hgn + h * 128 + 16 * w + 4 * q4);
#pragma unroll
            for (int tt = 0; tt < 2; ++tt) { float ss = 0.f;
#pragma unroll
                for (int q = 0; q < 8; ++q) ss += SSQ[q * 32 + 16 * tt + l15];
                const float rstd = rsqrtf(ss * (1.f / 128.f) + EPS);
                const size_t t = (size_t)(j * 256 + ch * 32 + 16 * tt + l15);
                const v2u z = *(const v2u*)(U + t * NIN + C_BZ + h * 128 + 16 * w + 4 * q4); v2u y;
                y.x = pk2(o[tt][0] * rstd * g4[0] * blo(z.x), o[tt][1] * rstd * g4[1] * bhi(z.x)); y.y = pk2(o[tt][2] * rstd * g4[2] * blo(z.y), o[tt][3] * rstd * g4[3] * bhi(z.y));
                *(v2u*)(YB + t * YPITCH + h * 128 + 16 * w + 4 * q4) = y; }
        }
    }
    if (!OUT) { float* up = HU + (size_t)(j * 4 + h) * 16384 + (size_t)(4 * q4) * 128 + 16 * w + l15;
#pragma unroll
        for (int kt = 0; kt < 8; ++kt)
#pragma unroll
            for (int r = 0; r < 4; ++r) up[(size_t)(16 * kt + r) * 128] = S[kt][r];
        if (tq == 0) HP[(size_t)(j * 4 + h) * 128 + k] = __expf(ptot); }
}
__device__ __forceinline__ void attn_merge_row(const bf16* U, const bf16* OG, const float* LSE, bf16* YA, int t, int lane) {
    const int hd = lane >> 3, c8 = lane * 8;
    const float l0 = LSE[((size_t)0 * MROWS + t) * 8 + hd], l1 = LSE[((size_t)1 * MROWS + t) * 8 + hd], l2 = LSE[((size_t)2 * MROWS + t) * 8 + hd];
    const float mx = fmaxf(l0, fmaxf(l1, l2)); float w0 = __expf(l0 - mx), w1 = __expf(l1 - mx), w2 = __expf(l2 - mx); const float inv = 1.f / (w0 + w1 + w2); w0 *= inv; w1 *= inv; w2 *= inv;
    const v4u a = *(const v4u*)(OG + ((size_t)0 * MROWS + t) * 512 + c8), b = *(const v4u*)(OG + ((size_t)1 * MROWS + t) * 512 + c8), c = *(const v4u*)(OG + ((size_t)2 * MROWS + t) * 512 + c8);
    const v4u z = *(const v4u*)(U + (size_t)t * NIN + C_AZ + c8);
    const unsigned aa[4] = {a.x, a.y, a.z, a.w}, ba[4] = {b.x, b.y, b.z, b.w}, ca[4] = {c.x, c.y, c.z, c.w}, za[4] = {z.x, z.y, z.z, z.w}; unsigned oa[4];
#pragma unroll
    for (int e = 0; e < 4; ++e) oa[e] = pk2((w0 * blo(aa[e]) + w1 * blo(ba[e]) + w2 * blo(ca[e])) * blo(za[e]), (w0 * bhi(aa[e]) + w1 * bhi(ba[e]) + w2 * bhi(ca[e])) * bhi(za[e]));
    v4u o; o.x = oa[0]; o.y = oa[1]; o.z = oa[2]; o.w = oa[3]; *(v4u*)(YA + (size_t)t * YPITCH + c8) = o;
}
__device__ __forceinline__ void samp_attn_unit(const Args& A, const bf16* U, bf16* YA, int b, int tid) {
    const int lane = tid & 63, h = tid >> 6, ks = lane >> 4, dp = lane & 15; const size_t row = T_SEQ + b; const bf16* ur = U + row * NIN;
    float m = -1e30f, l = 0.f; f32x4 acc = (f32x4){0.f, 0.f, 0.f, 0.f};
#pragma unroll
    for (int g = 0; g < 3; ++g) { const int dil = (g == 0) ? 1 : (g == 1 ? 4 : 16), Wb = 128 * dil; const float* cache = ((g == 0) ? A.c128 : (g == 1 ? A.c512 : A.c2048)) + (size_t)b * Wb * 1024 + h * 64 + 4 * dp;
        const v2u qw = *(const v2u*)(ur + C_AQ + g * 512 + h * 64 + 4 * dp); const f32x4 q = (f32x4){blo(qw.x), bhi(qw.x), blo(qw.y), bhi(qw.y)};
        if (ks == 0) { const v2u kw = *(const v2u*)(ur + C_AK + g * 512 + h * 64 + 4 * dp), vw = *(const v2u*)(ur + C_AV + g * 512 + h * 64 + 4 * dp);
            float sc = q[0] * blo(kw.x) + q[1] * bhi(kw.x) + q[2] * blo(kw.y) + q[3] * bhi(kw.y);
            sc += __shfl_xor(sc, 1); sc += __shfl_xor(sc, 2); sc += __shfl_xor(sc, 4); sc += __shfl_xor(sc, 8);
            const float mn = fmaxf(m, sc), corr = __expf(m - mn), pe = __expf(sc - mn); l = l * corr + pe;
            acc = acc * corr + pe * (f32x4){blo(vw.x), bhi(vw.x), blo(vw.y), bhi(vw.y)}; m = mn; }
#pragma unroll 4
        for (int it = 0; it < 32; ++it) { const int jj = 1 + ks + 4 * it, idx = Wb - dil * jj; const float* kp = cache + (size_t)idx * 1024;
            const f32x4 k4 = *(const f32x4*)kp, v4 = *(const f32x4*)(kp + 512);
            float sc = (q[0] * k4[0] + q[1] * k4[1]) + (q[2] * k4[2] + q[3] * k4[3]);
            sc += __shfl_xor(sc, 1); sc += __shfl_xor(sc, 2); sc += __shfl_xor(sc, 4); sc += __shfl_xor(sc, 8);
            const float mn = fmaxf(m, sc), corr = __expf(m - mn), pe = __expf(sc - mn); l = l * corr + pe; acc = acc * corr + pe * v4; m = mn; } }
    float ma = fmaxf(m, __shfl_xor(m, 16)); ma = fmaxf(ma, __shfl_xor(ma, 32));
    const float sc = __expf(m - ma); l *= sc; acc = acc * sc;
    l += __shfl_xor(l, 16); l += __shfl_xor(l, 32);
#pragma unroll
    for (int e = 0; e < 4; ++e) { acc[e] += __shfl_xor(acc[e], 16); acc[e] += __shfl_xor(acc[e], 32); }
    if (ks == 0) { const float inv = 1.f / l; const v2u z = *(const v2u*)(ur + C_AZ + h * 64 + 4 * dp); v2u o;
        o.x = pk2(acc[0] * inv * blo(z.x), acc[1] * inv * bhi(z.x)); o.y = pk2(acc[2] * inv * blo(z.y), acc[3] * inv * bhi(z.y)); *(v2u*)(YA + row * YPITCH + h * 64 + 4 * dp) = o; }
}
__device__ __forceinline__ void samp_hgrn_unit(ldsp lds, const Args& A, const bf16* U, bf16* YB, int b, int h, int tid) {
    LAS float* fb = (LAS float*)lds; LAS float* kb = fb + 128; LAS float* qb = kb + 128; LAS float* red = qb + 128;
    const size_t row = T_SEQ + b; const bf16* ur = U + row * NIN;
    __syncthreads();
    if (tid < 128) { const float lb = lb_of(A.lbl, h * 128 + tid), f = lb + (1.f - lb) * sigmoid_f(b2f(ur[C_BF + h * 128 + tid])); fb[tid] = f; kb[tid] = 1.f - f; qb[tid] = b2f(ur[C_BQ + h * 128 + tid]); }
    __syncthreads();
    const int v4i = (tid & 31) * 4, kk = tid >> 5;
    const v2u vw = *(const v2u*)(ur + C_BI + h * 128 + v4i); const f32x4 vv = (f32x4){blo(vw.x), bhi(vw.x), blo(vw.y), bhi(vw.y)};
    const float* sp = A.sth + (size_t)(b * 4 + h) * 16384; float* dp = A.out + O_HGS + (size_t)(b * 4 + h) * 16384;
    f32x4 oacc = (f32x4){0.f, 0.f, 0.f, 0.f};
#pragma unroll
    for (int p = 0; p < 8; ++p) { const int k = kk + 16 * p; const f32x4 S = *(const f32x4*)(sp + k * 128 + v4i); const f32x4 Sn = fb[k] * S + kb[k] * vv; *(f32x4*)(dp + k * 128 + v4i) = Sn; oacc += Sn * qb[k]; }
    *(LAS f32x4*)(red + kk * 128 + v4i) = oacc;
    __syncthreads();
    if (tid < 64) { float o0 = 0.f, o1 = 0.f;
#pragma unroll
        for (int q = 0; q < 16; ++q) { o0 += red[q * 128 + tid]; o1 += red[q * 128 + 64 + tid]; }
        const float rstd = rsqrtf(wave_sum(o0 * o0 + o1 * o1) * (1.f / 128.f) + EPS);
        bf16* yp = YB + row * YPITCH + h * 128;
        yp[tid] = (bf16)f2bf(o0 * rstd * A.hgn[h * 128 + tid] * b2f(ur[C_BZ + h * 128 + tid])); yp[64 + tid] = (bf16)f2bf(o1 * rstd * A.hgn[h * 128 + 64 + tid] * b2f(ur[C_BZ + h * 128 + 64 + tid])); }
}
__device__ __forceinline__ void samp_xattn_unit(ldsp lds, const Args& A, const bf16* U, bf16* YC, int b, int h, int tid) {
    LAS float* part = (LAS float*)lds;
    const int lane = tid & 63, w = tid >> 6, sub = lane >> 5, dp = lane & 31; const size_t row = T_SEQ + b; const bf16* ur = U + row * NIN;
    const v2u qw = *(const v2u*)(ur + C_CQ + h * 128 + 4 * dp); const f32x4 q = (f32x4){blo(qw.x), bhi(qw.x), blo(qw.y), bhi(qw.y)} * 0.08838834764831845f;
    const float* mem = A.cmem + (size_t)b * 256 * 1024 + h * 128 + 4 * dp;
    float m = -1e30f, l = 0.f; f32x4 acc = (f32x4){0.f, 0.f, 0.f, 0.f};
#pragma unroll 4
    for (int it = 0; it < 16; ++it) { const float* kp = mem + (size_t)(32 * w + 2 * it + sub) * 1024; const f32x4 k4 = *(const f32x4*)kp, v4 = *(const f32x4*)(kp + 512);
        float sc = (q[0] * k4[0] + q[1] * k4[1]) + (q[2] * k4[2] + q[3] * k4[3]);
        sc += __shfl_xor(sc, 1); sc += __shfl_xor(sc, 2); sc += __shfl_xor(sc, 4); sc += __shfl_xor(sc, 8); sc += __shfl_xor(sc, 16);
        const float mn = fmaxf(m, sc), corr = __expf(m - mn), pe = __expf(sc - mn); l = l * corr + pe; acc = acc * corr + pe * v4; m = mn; }
    const float ma = fmaxf(m, __shfl_xor(m, 32)); const float sc = __expf(m - ma); l *= sc; acc = acc * sc; l += __shfl_xor(l, 32);
#pragma unroll
    for (int e = 0; e < 4; ++e) acc[e] += __shfl_xor(acc[e], 32);
    __syncthreads();
    if (sub == 0) { *(LAS f32x4*)(part + w * 132 + 4 * dp) = acc; if (dp == 0) { part[w * 132 + 128] = ma; part[w * 132 + 129] = l; } }
    __syncthreads();
    if (tid < 128) { float M = -1e30f;
#pragma unroll
        for (int q8 = 0; q8 < 8; ++q8) M = fmaxf(M, part[q8 * 132 + 128]);
        float L = 0.f, O = 0.f;
#pragma unroll
        for (int q8 = 0; q8 < 8; ++q8) { const float e = __expf(part[q8 * 132 + 128] - M); L += part[q8 * 132 + 129] * e; O += part[q8 * 132 + tid] * e; }
        YC[row * YPITCH + h * 128 + tid] = (bf16)f2bf(O / L * b2f(ur[C_CZ + h * 128 + tid])); }
}
template <int NKS>
__device__ __forceinline__ void small_tile(f32x4 (&acc)[4], const bf16* A, int lda, const bf16* Bt, int ldb, int r0, int n0, int k0, int lane) {
    const int l15 = lane & 15, q4 = lane >> 4;
    const bf16* ap = A + (size_t)(r0 + l15) * lda + k0 + 8 * q4; const bf16* bp = Bt + (size_t)(n0 + l15) * ldb + k0 + 8 * q4;
#pragma unroll
    for (int ct = 0; ct < 4; ++ct) acc[ct] = (f32x4){0.f, 0.f, 0.f, 0.f};
#pragma unroll
    for (int ks = 0; ks < NKS; ++ks) { const bf16x8 a = *(const bf16x8*)(ap + 32 * ks);
#pragma unroll
        for (int ct = 0; ct < 4; ++ct) acc[ct] = MFMA16(a, *(const bf16x8*)(bp + (size_t)(16 * ct) * ldb + 32 * ks), acc[ct]); }
}
__device__ __forceinline__ void samp_branch_unit(ldsp lds, const bf16* U, const bf16* Y, const bf16* WPT, bf16* MG, int rt, int cg, int tid) {
    LAS float* part = (LAS float*)lds;
    const int lane = tid & 63, w = __builtin_amdgcn_readfirstlane(tid >> 6), l15 = lane & 15, q4 = lane >> 4, r0 = T_SEQ + 16 * rt, n0 = 64 * cg;
    __syncthreads();
    if (w < 6) { f32x4 acc[4]; small_tile<8>(acc, Y, YPITCH, WPT, 1536, r0, n0, (w >> 1) * 512 + (w & 1) * 256, lane);
#pragma unroll
        for (int ct = 0; ct < 4; ++ct)
#pragma unroll
            for (int r = 0; r < 4; ++r) part[(w * 16 + 4 * q4 + r) * 64 + 16 * ct + l15] = acc[ct][r]; }
    __syncthreads();
    { const int e = tid * 2, row = e >> 6, col = e & 63; const bf16* gp = U + (size_t)(r0 + row) * NIN + C_GA + n0 + col; float m0 = 0.f, m1 = 0.f;
#pragma unroll
      for (int br = 0; br < 3; ++br) { const unsigned gw = *(const unsigned*)(gp + br * 1024); const LAS float* p0 = part + ((2 * br) * 16 + row) * 64 + col; const LAS float* p1 = p0 + 16 * 64;
          m0 += blo(gw) * (p0[0] + p1[0]); m1 += bhi(gw) * (p0[1] + p1[1]); }
      *(unsigned*)(MG + (size_t)(r0 + row) * 1024 + n0 + col) = pk2(m0, m1); }
}
__device__ __forceinline__ void samp_out_unit(ldsp lds, const bf16* MG, const bf16* WOT, float* Z, int rt, int cg, int tid) {
    LAS float* part = (LAS float*)lds;
    const int lane = tid & 63, w = __builtin_amdgcn_readfirstlane(tid >> 6), l15 = lane & 15, q4 = lane >> 4, r0 = T_SEQ + 16 * rt, n0 = 64 * cg;
    __syncthreads();
    { f32x4 acc[4]; small_tile<4>(acc, MG, 1024, WOT, 1024, r0, n0, 128 * w, lane);
#pragma unroll
      for (int ct = 0; ct < 4; ++ct)
#pragma unroll
          for (int r = 0; r < 4; ++r) part[(w * 16 + 4 * q4 + r) * 64 + 16 * ct + l15] = acc[ct][r]; }
    __syncthreads();
    { const int e = tid * 2, row = e >> 6, col = e & 63; float z0 = 0.f, z1 = 0.f;
#pragma unroll
      for (int q = 0; q < 8; ++q) { const LAS float* p = part + (q * 16 + row) * 64 + col; z0 += p[0]; z1 += p[1]; }
      *(float2*)(Z + (size_t)(r0 + row) * 1024 + n0 + col) = make_float2(z0, z1); }
}
__device__ __forceinline__ void final_row(const float* z, const float* hrow, const float* g, float* yrow, int lane) {
    const f32x4* zr = (const f32x4*)z + lane; const f32x4* hr = (const f32x4*)hrow + lane; const f32x4* gr = (const f32x4*)g + lane; f32x4* yr = (f32x4*)yrow + lane;
    f32x4 v[4]; float s = 0.f;
#pragma unroll
    for (int j = 0; j < 4; ++j) { v[j] = zr[64 * j]; s += (v[j].x * v[j].x + v[j].y * v[j].y) + (v[j].z * v[j].z + v[j].w * v[j].w); }
    const float rstd = rsqrtf(wave_sum(s) * (1.f / 1024.f) + EPS);
#pragma unroll
    for (int j = 0; j < 4; ++j) yr[64 * j] = hr[64 * j] + v[j] * rstd * gr[64 * j];
}
__global__ void __launch_bounds__(512, 2) fwd_kernel(Args A) {
    extern __shared__ __attribute__((aligned(16))) unsigned char lds_raw[];
    ldsp lds = (ldsp)lds_raw;
    volatile LAS unsigned* MISC = (volatile LAS unsigned*)(lds + MISC_OFF);
    int tid = threadIdx.x; const int G = gridDim.x, bid = blockIdx.x;
#define NEWTID() do { tid = threadIdx.x; asm volatile("" : "+v"(tid)); } while (0)
    for (int u = tid; u < (LDS_BYTES - LDSCTL_OFF) / 4; u += 512) ((LAS unsigned*)(lds + LDSCTL_OFF))[u] = 0u;
    __syncthreads();
    unsigned char* ws = A.ws;
    unsigned* ctl = (unsigned*)(ws + WS_CTL);
    XcdBarrier bar = xcd_barrier_post(ctl + CW_BAR, MISC + 8);
    bf16* U = (bf16*)(ws + WS_U); bf16* MKV = (bf16*)(ws + WS_MEMKV);
    bf16* YA = (bf16*)(ws + WS_YA); bf16* YB = YA + 512; bf16* YC = YA + 1024;
    bf16* OG = (bf16*)(ws + WS_OG); float* LSE = (float*)(ws + WS_LSE);
    float* HU = (float*)(ws + WS_HU); float* HP = (float*)(ws + WS_HP); float* HS = (float*)(ws + WS_HS);

    NEWTID();
    p0_prologue(A, lds, tid, G);
    xcd_barrier(bar);

    { pg8::Gemm g{(const pg8::bf16_t*)(ws + WS_MN), (const pg8::bf16_t*)(ws + WS_WMEM), 256, 1024, 1024}; pg8::StaticOrder S; S.init(256, 1024, G, (bid + 4) % G);
      pg8::EpiMem E{A.out + O_MEMKV, (pg8::bf16_t*)MKV};
      pg8::gemm_phase<pg8::EpiMem, pg8::StaticOrder, false, PG8_SP2>(lds, g, S, E); }
    __syncthreads();
    { pg8::Gemm g{(const pg8::bf16_t*)(ws + WS_XN), (const pg8::bf16_t*)(ws + WS_WIN), MROWS, NIN, 1024}; pg8::StaticOrder S; S.init(MROWS, NIN, G, bid);
      pg8::EpiU E{(pg8::bf16_t*)U, (const float*)(ws + WS_CS), A.out, (pg8::bf16_t*)(ws + WS_GT)};
      pg8::gemm_phase<pg8::EpiU, pg8::StaticOrder, PG8_ALIGN, PG8_SP2>(lds, g, S, E); }
    xcd_barrier(bar);

    NEWTID();
    for (int u = bid; u < 128; u += G) samp_attn_unit(A, U, YA, u, tid);
    NEWTID();
    for (int u = bid; u < 512; u += G) samp_xattn_unit(lds, A, U, YC, u >> 2, u & 3, tid);
    NEWTID();
    for (int u = bid; u < 512; u += G) samp_hgrn_unit(lds, A, U, YB, u >> 2, u & 3, tid);
    NEWTID();
    for (int u = bid; u < 256; u += G) hgrn_mfma_unit<false>(lds, U, A.lbl, A.hgn, HS, HU, HP, YB, u & 3, u >> 2, tid);
    NEWTID();
    for (int u = bid; u < 3072; u += G) { const int g = u >> 10, rem = u & 1023, h = rem & 7, rb = rem >> 3, dil = (g == 0) ? 1 : (g == 1 ? 4 : 16), nblk = 128 / dil;
        attn_dil_unit(lds, U, OG, LSE, g, dil, rb / nblk, rb % nblk, h, tid); }
    NEWTID();
    for (int u = bid; u < 512; u += G) xattn_unit(lds, U, MKV, YC, u >> 2, u & 3, tid);
    xcd_barrier(bar);

    NEWTID();
    for (int u = bid - 128; u >= 0 && u < 128; u += G) samp_branch_unit(lds, U, YA, (const bf16*)(ws + WS_WPA), (bf16*)(ws + WS_MG), u >> 4, u & 15, tid);
    NEWTID();
    for (int u = bid; u < 256; u += G) hgrn_scan_unit(HU, HP, HS, A.out + O_HGP, u, tid);
    NEWTID();
    for (int t = bid * 8 + (tid >> 6); t < T_SEQ; t += G * 8) attn_merge_row(U, OG, LSE, YA, t, tid & 63);
    xcd_barrier(bar);

    NEWTID();
    for (int u = bid; u < 256; u += G) hgrn_mfma_unit<true>(lds, U, A.lbl, A.hgn, HS, HU, HP, YB, u & 3, u >> 2, tid);
    NEWTID();
    for (int u = bid - 128; u >= 0 && u < 128; u += G) samp_out_unit(lds, (const bf16*)(ws + WS_MG), (const bf16*)(ws + WS_WOUT), (float*)(ws + WS_Z), u >> 4, u & 15, tid);
    xcd_barrier(bar);

    { pg8::Gemm g{(const pg8::bf16_t*)YA, (const pg8::bf16_t*)(ws + WS_WPA), T_SEQ, 1024, 1536}; pg8::StaticOrder S; S.init(T_SEQ, 1024, G, bid);
      pg8::EpiMerged E{(const pg8::bf16_t*)(ws + WS_GT), (pg8::bf16_t*)(ws + WS_MG)};
      pg8::gemm_phase<pg8::EpiMerged, pg8::StaticOrder, PG8_ALIGN, PG8_SP2>(lds, g, S, E); }
    xcd_barrier(bar);

    { pg8::Gemm g{(const pg8::bf16_t*)(ws + WS_MG), (const pg8::bf16_t*)(ws + WS_WOUT), T_SEQ, 1024, 1024}; pg8::StaticOrder S; S.init(T_SEQ, 1024, G, bid);
      pg8::EpiZ E{(float*)(ws + WS_Z)};
      pg8::gemm_phase<pg8::EpiZ, pg8::StaticOrder, PG8_ALIGN, PG8_SP2>(lds, g, S, E); }
    xcd_barrier(bar);

    NEWTID();
    { const float* Z = (const float*)(ws + WS_Z); const int lane = tid & 63;
      for (int m = bid * 8 + (tid >> 6); m < T_SEQ + NSAMP; m += G * 8) {
          if (m < T_SEQ) final_row(Z + (size_t)m * 1024, A.xp + (size_t)m * 1024, A.npost, A.out + O_YP + (size_t)m * 1024, lane);
          else final_row(Z + (size_t)m * 1024, A.xs + (size_t)(m - T_SEQ) * 1024, A.npost, A.out + O_YS + (size_t)(m - T_SEQ) * 1024, lane); } }
}

extern "C" void kernel_launch(void* const* d_in, const int* in_sizes, int n_in, void* d_out, int out_size, void* d_ws, size_t ws_size, hipStream_t stream) {
    static int grid = 0;
    if (grid == 0) {
        if (n_in != 19 || out_size != (int)O_END || ws_size < WS_END) { fprintf(stderr, "kernel_launch: unexpected shapes (n_in %d, out %d, ws %zu); nothing launched\n", n_in, out_size, ws_size); grid = -1; return; }
        int dev = 0, cus = 0, per_cu = 0;
        if (hipGetDevice(&dev) != hipSuccess || hipDeviceGetAttribute(&cus, hipDeviceAttributeMultiprocessorCount, dev) != hipSuccess) { grid = -1; return; }
        if (hipFuncSetAttribute((const void*)fwd_kernel, hipFuncAttributeMaxDynamicSharedMemorySize, LDS_BYTES) != hipSuccess) { fprintf(stderr, "kernel_launch: hipFuncSetAttribute failed\n"); grid = -1; return; }
        if (hipOccupancyMaxActiveBlocksPerMultiprocessor(&per_cu, (const void*)fwd_kernel, 512, LDS_BYTES) != hipSuccess || per_cu < 1) { fprintf(stderr, "kernel_launch: occupancy query says %d blocks per CU\n", per_cu); per_cu = 1; }
        (void)hipGetLastError();
        grid = cus;
    }
    if (grid < 0) return;
    if (hipMemsetAsync((char*)d_ws + WS_CTL, 0, CTL_ZERO_BYTES, stream) != hipSuccess) return;
    Args a{};
    a.xp = (const float*)d_in[0]; a.xs = (const float*)d_in[1]; a.memp = (const float*)d_in[2]; a.c128 = (const float*)d_in[3]; a.c512 = (const float*)d_in[4]; a.c2048 = (const float*)d_in[5];
    a.sth = (const float*)d_in[6]; a.cmem = (const float*)d_in[7]; a.npre = (const float*)d_in[8]; a.npost = (const float*)d_in[9]; a.win = (const float*)d_in[10]; a.lbl = (const float*)d_in[11];
    a.hgn = (const float*)d_in[12]; a.mnorm = (const float*)d_in[13]; a.wmem = (const float*)d_in[14]; a.wpa = (const float*)d_in[15]; a.wpb = (const float*)d_in[16]; a.wpc = (const float*)d_in[17]; a.wout = (const float*)d_in[18];
    a.out = (float*)d_out; a.ws = (unsigned char*)d_ws;
    hipLaunchKernelGGL(fwd_kernel, dim3(grid), dim3(512), LDS_BYTES, stream, a);
    const hipError_t le = hipPeekAtLastError();
    if (le != hipSuccess) fprintf(stderr, "kernel_launch: launch failed: %s\n", hipGetErrorName(le));
}
```

```cpp
#include <hip/hip_runtime.h>
#include <cstdio>
#include <cstdint>
constexpr int T_SEQ = 16384, DMODEL = 1024, NSAMP = 128, MROWS = 16640  , NIN = 11264;
constexpr int C_AQ = 0, C_AK = 1536, C_AV = 3072, C_AZ = 4608, C_BQ = 5120, C_BF = 5632, C_BI = 6144, C_BZ = 6656, C_CQ = 7168, C_CZ = 7680, C_GA = 8192;
constexpr float EPS = 1e-6f;
constexpr int YPITCH = 1536;
constexpr size_t O_YP = 0, O_YS = 16777216, O_W128P = 16908288, O_W512P = 17039360, O_W2048P = 17563648, O_HGP = 19660800, O_MEMKV = 19726336,
                 O_W128S = 19988480, O_W512S = 20119552, O_W2048S = 20250624, O_HGS = 20381696, O_END = 28770304;
constexpr size_t MiB = 1u << 20;
constexpr size_t WS_CTL = 0, CTL_ZERO_BYTES = 1 * MiB;
constexpr size_t WS_WIN = 2 * MiB, WS_WMEM = 24 * MiB, WS_WPA = 26 * MiB, WS_WPB = 27 * MiB, WS_WPC = 28 * MiB, WS_WOUT = 29 * MiB, WS_MN = 31 * MiB, WS_MEMKV = 31 * MiB + 512 * 1024;
constexpr size_t WS_CS = 32 * MiB, WS_XN = 36 * MiB, WS_U = 70 * MiB, WS_OG = 428 * MiB, WS_LSE = 477 * MiB, WS_HU = 479 * MiB, WS_HP = 495 * MiB, WS_HS = 496 * MiB;
constexpr size_t WS_YA = 512 * MiB, WS_YB = 529 * MiB, WS_YC = 546 * MiB, WS_M32 = 563 * MiB, WS_MG = 628 * MiB, WS_Z = 661 * MiB, WS_GT = 726 * MiB, WS_END = 824 * MiB;
constexpr int CW_BAR = 4096;
namespace pg8 {
#define PG8_LAS __attribute__((address_space(3)))
typedef unsigned short bf16_t;
typedef short bf16x8 __attribute__((ext_vector_type(8)));
typedef float f32x4 __attribute__((ext_vector_type(4)));
typedef unsigned u32x4 __attribute__((ext_vector_type(4)));
constexpr int BM = 256, BK = 64, HALF = 128, HTB = HALF * BK * 2  , STAGE_BYTES = 8 * HTB, NXCD = 8, WGM = 8;

__host__ __device__ __forceinline__ int lds_byte(int r, int c) { const int st = (r >> 4) * 2 + (c >> 5), rr = r & 15, cc = c & 31, ob = rr * 64 + cc * 2; return st * 1024 + (ob ^ (((ob >> 9) & 1) << 5)); }
__host__ __device__ __forceinline__ void stage_rc(int b, int& R, int& C) { const int st = b / 1024, sb = b % 1024, swz = sb ^ (((sb >> 9) & 1) << 5); R = (st >> 1) * 16 + swz / 64; C = (st & 1) * 32 + (swz % 64) / 2; }
__host__ __device__ __forceinline__ int perm32(int rho) { const int n = rho >> 4, i = rho & 15; return 8 * (i >> 2) + 4 * n + (i & 3); }

struct Unit { int pm, pn; };
struct Gemm { const bf16_t* A; const bf16_t* Bt; int M, N, K; };

struct StaticOrder {
    int nM, nN, nwg, G, c;
    __host__ __device__ void init(int M, int N, int G_, int c_) { nM = M / BM; nN = N / BM; nwg = nM * nN; G = G_; c = c_; }
    __host__ __device__ bool next(int i, Unit& u) const {
        const long L = (long)i * G + c; if (L >= nwg) return false;
        int wgid = (int)L; { const int q = nwg / NXCD, r = nwg % NXCD, xcd = wgid % NXCD, off = wgid / NXCD; wgid = (xcd < r ? xcd * (q + 1) : r * (q + 1) + (xcd - r) * q) + off; }
        const int nig = WGM * nN, gid = wgid / nig, fm = gid * WGM, gsz = (nM - fm) < WGM ? (nM - fm) : WGM;
        u.pm = fm + ((wgid % nig) % gsz); u.pn = (wgid % nig) / gsz; return true;
    }
    __device__ __forceinline__ void a_ready(const Unit&) const {}
    __device__ __forceinline__ void done(const Unit&) const {}
};

struct PanelOrder {
    int pm, n, c;
    __device__ __forceinline__ bool next(int i, Unit& u) const { if (i > 0 || c < 0 || c >= n) return false; u.pm = pm; u.pn = c; return true; }
    __device__ __forceinline__ void a_ready(const Unit&) const {}
    __device__ __forceinline__ void done(const Unit&) const {}
};
__device__ __forceinline__ unsigned cvt_pk_bf16(float lo, float hi) { unsigned r; asm volatile("v_cvt_pk_bf16_f32 %0, %1, %2" : "=v"(r) : "v"(lo), "v"(hi)); return r; }
typedef unsigned u32x2 __attribute__((ext_vector_type(2)));
typedef float f32x2 __attribute__((ext_vector_type(2)));
__device__ __forceinline__ float sigm(float x) { return __builtin_amdgcn_rcpf(1.0f + __builtin_amdgcn_exp2f(x * -1.4426950408889634f)); }
__device__ __forceinline__ float bflo(unsigned w) { return __uint_as_float(w << 16); }
__device__ __forceinline__ float bfhi(unsigned w) { return __uint_as_float(w & 0xffff0000u); }

struct EpiU {
    static constexpr bool PERM = true, AFTER_DRAIN = false, MID = false;
    bf16_t* U; const float* cs; float* out; bf16_t* GT;
    __device__ __forceinline__ void operator()(const f32x4 (&acc)[2][2][4][2], const Unit& u, int wr, int wc, int fr, int fq) const {
        const int pn = u.pn, rbase = u.pm * 256 + wr * 64 + fr, cbase = pn * 256 + wc * 32 + 8 * fq;
        if (pn < 12) {
            const bool isk = pn >= 6; const int g = isk ? ((pn - 6) >> 1) : 0;
            const int t0 = (g == 0) ? 16256 : (g == 1 ? 15872 : 14336);
            const size_t offp = (g == 0) ? O_W128P : (g == 1 ? O_W512P : O_W2048P), offs = (g == 0) ? O_W128S : (g == 1 ? O_W512S : O_W2048S);
            const float qs = isk ? 1.0f : 0.125f;
            const int i0 = 16 * (wc & 1) + 4 * fq, hb0 = pn * 256 + (wc >> 1) * 64;
#pragma unroll
            for (int ai = 0; ai < 2; ++ai)
#pragma unroll
                for (int m = 0; m < 4; ++m) { const int row = rbase + ai * 128 + m * 16, pos = row < T_SEQ ? row : 8192;
                    float* dstr = nullptr;
                    if (isk) { if (row < T_SEQ) { if (row >= t0) dstr = out + offp + (size_t)(row - t0) * 1024; } else if (row < T_SEQ + NSAMP) dstr = out + offs + (size_t)(row - T_SEQ) * 1024; }
                    const float* cp = cs + ((size_t)pos * 32 + i0) * 2; const f32x4 ca = *(const f32x4*)cp * qs, cb = *(const f32x4*)(cp + 4) * qs;
                    const f32x4 cc = (f32x4){ca[0], ca[2], cb[0], cb[2]}, ss = (f32x4){ca[1], ca[3], cb[1], cb[3]};
#pragma unroll
                    for (int bj = 0; bj < 2; ++bj) { const f32x4 xl = acc[ai][bj][m][0], xh = acc[ai][bj][m][1];
                        const f32x4 lo = xl * cc - xh * ss, hi = xh * cc + xl * ss;
                        bf16_t* up = U + (size_t)row * NIN + hb0 + bj * 128 + i0;
                        u32x2 wl; wl.x = cvt_pk_bf16(lo[0], lo[1]); wl.y = cvt_pk_bf16(lo[2], lo[3]); *(u32x2*)up = wl;
                        u32x2 wh; wh.x = cvt_pk_bf16(hi[0], hi[1]); wh.y = cvt_pk_bf16(hi[2], hi[3]); *(u32x2*)(up + 32) = wh;
                        if (dstr) { float* d = dstr + (((hb0 + bj * 128 - C_AK) >> 6) & 7) * 64 + i0; *(f32x4*)d = lo; *(f32x4*)(d + 32) = hi; } } }
        } else if (pn < 18) {
            const int g = (pn - 12) >> 1; const int t0 = (g == 0) ? 16256 : (g == 1 ? 15872 : 14336);
            const size_t offp = (g == 0) ? O_W128P : (g == 1 ? O_W512P : O_W2048P), offs = (g == 0) ? O_W128S : (g == 1 ? O_W512S : O_W2048S);
#pragma unroll
            for (int ai = 0; ai < 2; ++ai)
#pragma unroll
                for (int m = 0; m < 4; ++m) { const int row = rbase + ai * 128 + m * 16;
                    float* dstr = nullptr;
                    if (row < T_SEQ) { if (row >= t0) dstr = out + offp + (size_t)(row - t0) * 1024 + 512; } else if (row < T_SEQ + NSAMP) dstr = out + offs + (size_t)(row - T_SEQ) * 1024 + 512;
#pragma unroll
                    for (int bj = 0; bj < 2; ++bj) { const int vc = cbase + bj * 128; const f32x4 x0 = acc[ai][bj][m][0], x1 = acc[ai][bj][m][1];
                        u32x4 w; w.x = cvt_pk_bf16(x0[0], x0[1]); w.y = cvt_pk_bf16(x0[2], x0[3]); w.z = cvt_pk_bf16(x1[0], x1[1]); w.w = cvt_pk_bf16(x1[2], x1[3]); *(u32x4*)(U + (size_t)row * NIN + vc) = w;
                        if (dstr) { float* d = dstr + ((vc - C_AV) & 511); *(f32x4*)d = x0; *(f32x4*)(d + 4) = x1; } } }
        } else if (pn < 32) {
            const bool act = (pn < 20 || pn == 26 || pn == 27 || pn == 30 || pn == 31);
#pragma unroll
            for (int ai = 0; ai < 2; ++ai)
#pragma unroll
                for (int m = 0; m < 4; ++m) { const int row = rbase + ai * 128 + m * 16;
#pragma unroll
                    for (int bj = 0; bj < 2; ++bj) { const int vc = cbase + bj * 128; f32x4 x0 = acc[ai][bj][m][0], x1 = acc[ai][bj][m][1];
                        if (act) {
#pragma unroll
                            for (int j = 0; j < 4; ++j) { x0[j] *= sigm(x0[j]); x1[j] *= sigm(x1[j]); } }
                        u32x4 w; w.x = cvt_pk_bf16(x0[0], x0[1]); w.y = cvt_pk_bf16(x0[2], x0[3]); w.z = cvt_pk_bf16(x1[0], x1[1]); w.w = cvt_pk_bf16(x1[2], x1[3]); *(u32x4*)(U + (size_t)row * NIN + vc) = w; } }
        } else {
            const int br = (pn - 32) >> 2, pt = (pn - 32) & 3, wid = wr * 4 + wc, lane = fq * 16 + fr;
            bf16_t* gp = GT + ((((size_t)(br * 65 + u.pm) * 4 + pt) * 8 + wid) * 16) * 512 + lane * 8;
#pragma unroll
            for (int ai = 0; ai < 2; ++ai)
#pragma unroll
                for (int bj = 0; bj < 2; ++bj)
#pragma unroll
                    for (int m = 0; m < 4; ++m) { f32x4 x0 = acc[ai][bj][m][0], x1 = acc[ai][bj][m][1];
#pragma unroll
                        for (int j = 0; j < 4; ++j) { x0[j] = fmaxf(sigm(x0[j]), 1e-30f); x1[j] = fmaxf(sigm(x1[j]), 1e-30f); }
                        u32x4 w; w.x = cvt_pk_bf16(x0[0], x0[1]); w.y = cvt_pk_bf16(x0[2], x0[3]); w.z = cvt_pk_bf16(x1[0], x1[1]); w.w = cvt_pk_bf16(x1[2], x1[3]);
                        *(u32x4*)(gp + ((ai * 2 + bj) * 4 + m) * 512) = w;
                        if (u.pm == 64) *(u32x4*)(U + (size_t)(rbase + ai * 128 + m * 16) * NIN + cbase + bj * 128) = w; }
        }
    }
};
struct EpiMem {
    static constexpr bool PERM = false, AFTER_DRAIN = false, MID = false;
    float* O; bf16_t* B;
    __device__ __forceinline__ void operator()(const f32x4 (&acc)[2][2][4][2], const Unit& u, int wr, int wc, int fr, int fq) const {
        const int rbase = u.pm * 256 + wr * 64 + fr, cbase = u.pn * 256 + wc * 32 + 4 * fq;
#pragma unroll
        for (int ai = 0; ai < 2; ++ai)
#pragma unroll
            for (int m = 0; m < 4; ++m) { const int row = rbase + ai * 128 + m * 16;
#pragma unroll
                for (int bj = 0; bj < 2; ++bj)
#pragma unroll
                    for (int n = 0; n < 2; ++n) { const int c = cbase + bj * 128 + n * 16; const f32x4 x = acc[ai][bj][m][n];
                        *(f32x4*)(O + (size_t)row * 1024 + c) = x; u32x2 w; w.x = cvt_pk_bf16(x[0], x[1]); w.y = cvt_pk_bf16(x[2], x[3]); *(u32x2*)(B + (size_t)row * 1024 + c) = w; } }
    }
};
struct EpiMerged {
    static constexpr bool PERM = true, AFTER_DRAIN = false, MID = true;
    const bf16_t* GT; bf16_t* MG;
    __device__ __forceinline__ const bf16_t* gtp(int br, const Unit& u, int wr, int wc, int fr, int fq) const {
        return GT + ((((size_t)(br * 65 + u.pm) * 4 + u.pn) * 8 + wr * 4 + wc) * 16) * 512 + (fq * 16 + fr) * 8; }
    __device__ __forceinline__ void mid(f32x4 (&acc)[2][2][4][2], const Unit& u, int t, int wr, int wc, int fr, int fq) const {
        int lo = (fq * 16 + fr) * 8; asm volatile("" : "+v"(lo));
        const int br = (t == 8) ? 0 : 1;
        const bf16_t* pa = GT + ((((size_t)(br * 65 + u.pm) * 4 + u.pn) * 8 + wr * 4 + wc) * 16) * 512 + lo; const bf16_t* pb = pa + (size_t)65 * 4 * 8 * 16 * 512;
#pragma unroll
        for (int ai = 0; ai < 2; ++ai)
#pragma unroll
            for (int bj = 0; bj < 2; ++bj) {
#pragma unroll
                for (int m = 0; m < 4; ++m) { const int i2 = (ai * 2 + bj) * 4 + m; const u32x4 a = *(const u32x4*)(pa + i2 * 512), b = *(const u32x4*)(pb + i2 * 512);
                    f32x4 r0, r1; r0[0] = bflo(a.x) * __builtin_amdgcn_rcpf(bflo(b.x)); r0[1] = bfhi(a.x) * __builtin_amdgcn_rcpf(bfhi(b.x)); r0[2] = bflo(a.y) * __builtin_amdgcn_rcpf(bflo(b.y)); r0[3] = bfhi(a.y) * __builtin_amdgcn_rcpf(bfhi(b.y));
                    r1[0] = bflo(a.z) * __builtin_amdgcn_rcpf(bflo(b.z)); r1[1] = bfhi(a.z) * __builtin_amdgcn_rcpf(bfhi(b.z)); r1[2] = bflo(a.w) * __builtin_amdgcn_rcpf(bflo(b.w)); r1[3] = bfhi(a.w) * __builtin_amdgcn_rcpf(bfhi(b.w));
                    acc[ai][bj][m][0] = acc[ai][bj][m][0] * r0; acc[ai][bj][m][1] = acc[ai][bj][m][1] * r1; }
                asm volatile("" ::: "memory"); }
    }
    __device__ __forceinline__ void operator()(const f32x4 (&acc)[2][2][4][2], const Unit& u, int wr, int wc, int fr, int fq) const {
        const int rbase = u.pm * 256 + wr * 64 + fr, cbase = u.pn * 256 + wc * 32 + 8 * fq;
        const bf16_t* pc = gtp(2, u, wr, wc, fr, fq);
#pragma unroll
        for (int ai = 0; ai < 2; ++ai)
#pragma unroll
            for (int m = 0; m < 4; ++m) { const int row = rbase + ai * 128 + m * 16;
#pragma unroll
                for (int bj = 0; bj < 2; ++bj) { const int c = cbase + bj * 128; const f32x4 x0 = acc[ai][bj][m][0], x1 = acc[ai][bj][m][1];
                    const u32x4 gw = *(const u32x4*)(pc + ((ai * 2 + bj) * 4 + m) * 512);
                    u32x4 w; w.x = cvt_pk_bf16(x0[0] * bflo(gw.x), x0[1] * bfhi(gw.x)); w.y = cvt_pk_bf16(x0[2] * bflo(gw.y), x0[3] * bfhi(gw.y));
                    w.z = cvt_pk_bf16(x1[0] * bflo(gw.z), x1[1] * bfhi(gw.z)); w.w = cvt_pk_bf16(x1[2] * bflo(gw.w), x1[3] * bfhi(gw.w)); *(u32x4*)(MG + (size_t)row * 1024 + c) = w; } }
    }
};
struct EpiZ {
    static constexpr bool PERM = false, AFTER_DRAIN = false, MID = false;
    float* Z;
    __device__ __forceinline__ void operator()(const f32x4 (&acc)[2][2][4][2], const Unit& u, int wr, int wc, int fr, int fq) const {
        const int rbase = u.pm * 256 + wr * 64 + fr, cbase = u.pn * 256 + wc * 32 + 4 * fq;
#pragma unroll
        for (int ai = 0; ai < 2; ++ai)
#pragma unroll
            for (int m = 0; m < 4; ++m) { const int row = rbase + ai * 128 + m * 16;
#pragma unroll
                for (int bj = 0; bj < 2; ++bj)
#pragma unroll
                    for (int n = 0; n < 2; ++n) *(f32x4*)(Z + (size_t)row * 1024 + cbase + bj * 128 + n * 16) = acc[ai][bj][m][n]; }
    }
};
template <class Epi, class Sched, bool ALIGN_EPI = false, bool SP2 = false>
__device__ __forceinline__ void gemm_phase(PG8_LAS unsigned char* lds, const Gemm g, const Sched& S, const Epi& E) {
    int tid = threadIdx.x; asm volatile("" : "+v"(tid));
    const int wid = __builtin_amdgcn_readfirstlane(tid >> 6), lane = tid & 63, wr = wid >> 2, wc = wid & 3, fr = lane & 15, fq = lane >> 4;
    const int K = g.K, nt = K / BK;
    unsigned voffA[2], voffB[2];
#pragma unroll
    for (int i = 0; i < 2; ++i) { int R, C; stage_rc(tid * 16 + i * 8192, R, C); const int Rb = Epi::PERM ? ((R & ~31) + perm32(R & 31)) : R;
        voffA[i] = (unsigned)(R * K + C) * 2u; voffB[i] = (unsigned)(Rb * K + C) * 2u; }
    const size_t kstep = (size_t)(BK * 2);
    const size_t hstep = (size_t)HALF * K * 2;
    const size_t tstep = 2 * hstep;
    const unsigned ldsw = (unsigned)wid * 1024u;
    const int aoff = lds_byte(wr * 64 + fr, fq * 8), boff = lds_byte(wc * 32 + fr, fq * 8);
#define PG8_SA(b, h) (((b) * 2 + (h)) * HTB)
#define PG8_SB(b, h) ((4 + (b) * 2 + (h)) * HTB)
#define PG8_STAGE(bufoff, gbase, voff) do { _Pragma("unroll") for (int _i = 0; _i < 2; ++_i) \
        __builtin_amdgcn_global_load_lds((const unsigned*)((const char*)(gbase) + (voff)[_i]), (PG8_LAS unsigned*)(lds + (bufoff) + ldsw + _i * 8192), 16, 0, 0); } while (0)
#define PG8_LDA(dst, b, h) do { _Pragma("unroll") for (int m = 0; m < 4; ++m) _Pragma("unroll") for (int k = 0; k < 2; ++k) dst[m][k] = *(const PG8_LAS bf16x8*)(lds + PG8_SA(b, h) + aoff + m * 2048 + k * 1024); } while (0)
#define PG8_LDB(dst, b, h) do { _Pragma("unroll") for (int n = 0; n < 2; ++n) _Pragma("unroll") for (int k = 0; k < 2; ++k) dst[n][k] = *(const PG8_LAS bf16x8*)(lds + PG8_SB(b, h) + boff + n * 2048 + k * 1024); } while (0)
#define PG8_MMA(ai, bj, At, Bt) do { __builtin_amdgcn_s_setprio(1); _Pragma("unroll") for (int m = 0; m < 4; ++m) _Pragma("unroll") for (int n = 0; n < 2; ++n) _Pragma("unroll") for (int k = 0; k < 2; ++k) \
        acc[ai][bj][m][n] = __builtin_amdgcn_mfma_f32_16x16x32_bf16(Bt[n][k], At[m][k], acc[ai][bj][m][n], 0, 0, 0); __builtin_amdgcn_s_setprio(0); } while (0)
#define PG8_WAIT_V(n) asm volatile("s_waitcnt vmcnt(" #n ")" ::: "memory")
#define PG8_WAIT_L(n) asm volatile("s_waitcnt lgkmcnt(" #n ")" ::: "memory")
#define PG8_BAR __builtin_amdgcn_s_barrier()
#define PG8_SCHED __builtin_amdgcn_sched_barrier(0)
    Unit cur, nxt; int ui = 0;
    if (!S.next(0, cur)) return;
    f32x4 acc[2][2][4][2];
#pragma unroll
    for (int a = 0; a < 2; ++a)
#pragma unroll
        for (int b = 0; b < 2; ++b)
#pragma unroll
            for (int m = 0; m < 4; ++m)
#pragma unroll
                for (int n = 0; n < 2; ++n) acc[a][b][m][n] = (f32x4){0.f, 0.f, 0.f, 0.f};
    bf16x8 At[4][2], B0[2][2], B1[2][2];
    const char* cA = (const char*)g.A + (size_t)cur.pm * tstep; const char* cB = (const char*)g.Bt + (size_t)cur.pn * tstep;
    S.a_ready(cur);
    if constexpr (SP2) {
        PG8_STAGE(PG8_SB(0, 0), cB, voffB); PG8_STAGE(PG8_SB(0, 1), cB + hstep, voffB); PG8_STAGE(PG8_SA(0, 0), cA, voffA); PG8_STAGE(PG8_SA(0, 1), cA + hstep, voffA);
        if (wr == 1) PG8_BAR;
        PG8_WAIT_V(2); PG8_BAR;
        PG8_STAGE(PG8_SB(1, 0), cB + kstep, voffB); PG8_STAGE(PG8_SA(1, 0), cA + kstep, voffA); PG8_STAGE(PG8_SB(1, 1), cB + hstep + kstep, voffB);
        PG8_WAIT_V(6); PG8_BAR;
    } else {
        PG8_STAGE(PG8_SB(0, 0), cB, voffB); PG8_STAGE(PG8_SA(0, 0), cA, voffA); PG8_STAGE(PG8_SB(0, 1), cB + hstep, voffB); PG8_STAGE(PG8_SA(0, 1), cA + hstep, voffA);
        if (wr == 1) PG8_BAR;
        PG8_WAIT_V(4); PG8_BAR;
        PG8_STAGE(PG8_SB(1, 0), cB + kstep, voffB); PG8_STAGE(PG8_SA(1, 0), cA + kstep, voffA); PG8_STAGE(PG8_SB(1, 1), cB + hstep + kstep, voffB);
        PG8_WAIT_V(6); PG8_BAR;
    }
    for (;;) {
        const bool has_next = S.next(ui + 1, nxt);
        const char* nA = has_next ? (const char*)g.A + (size_t)nxt.pm * tstep : cA; const char* nB = has_next ? (const char*)g.Bt + (size_t)nxt.pn * tstep : cB;
        for (int t = 0; t < nt; t += 2) {
            const bool last = (t == nt - 2);
            const char* a1 = cA + (size_t)(t + 1) * kstep;
            const char* a2 = last ? nA : cA + (size_t)(t + 2) * kstep; const char* b2 = last ? nB : cB + (size_t)(t + 2) * kstep;
            const char* a3 = a2 + kstep; const char* b3 = b2 + kstep;
            if (last && has_next) S.a_ready(nxt);
            if constexpr (Epi::MID) { if (t == 8 || t == 16) E.mid(acc, cur, t, wr, wc, fr, fq); }
            if constexpr (SP2) {
            PG8_LDB(B0, 0, 0); PG8_LDB(B1, 0, 1); PG8_SCHED; PG8_LDA(At, 0, 0); PG8_STAGE(PG8_SA(1, 1), a1 + hstep, voffA);
            PG8_WAIT_V(8); PG8_WAIT_L(0); PG8_BAR; PG8_MMA(0, 0, At, B0); PG8_MMA(0, 1, At, B1); PG8_BAR; PG8_SCHED;
            PG8_LDA(At, 0, 1); PG8_STAGE(PG8_SB(0, 0), b2, voffB); PG8_STAGE(PG8_SB(0, 1), b2 + hstep, voffB); PG8_STAGE(PG8_SA(0, 0), a2, voffA);
            PG8_WAIT_V(8); PG8_WAIT_L(0); PG8_BAR; PG8_MMA(1, 0, At, B0); PG8_MMA(1, 1, At, B1); PG8_BAR; PG8_SCHED;
            PG8_LDB(B0, 1, 0); PG8_LDB(B1, 1, 1); PG8_SCHED; PG8_LDA(At, 1, 0); PG8_STAGE(PG8_SA(0, 1), a2 + hstep, voffA);
            PG8_WAIT_V(8); PG8_WAIT_L(0); PG8_BAR; PG8_MMA(0, 0, At, B0); PG8_MMA(0, 1, At, B1); PG8_BAR; PG8_SCHED;
            PG8_LDA(At, 1, 1); PG8_STAGE(PG8_SB(1, 0), b3, voffB); PG8_STAGE(PG8_SB(1, 1), b3 + hstep, voffB); PG8_STAGE(PG8_SA(1, 0), a3, voffA);
            PG8_WAIT_V(8); PG8_WAIT_L(0); PG8_BAR; PG8_MMA(1, 0, At, B0); PG8_MMA(1, 1, At, B1); PG8_BAR; PG8_SCHED;
            } else {
            PG8_LDB(B0, 0, 0); PG8_SCHED; PG8_LDA(At, 0, 0); PG8_STAGE(PG8_SA(1, 1), a1 + hstep, voffA);
            PG8_WAIT_L(8); PG8_BAR; PG8_WAIT_L(0); PG8_MMA(0, 0, At, B0); PG8_BAR; PG8_SCHED;
            PG8_LDB(B1, 0, 1); PG8_STAGE(PG8_SB(0, 0), b2, voffB);
            PG8_BAR; PG8_WAIT_L(0); PG8_MMA(0, 1, At, B1); PG8_BAR;
            PG8_LDA(At, 0, 1); PG8_STAGE(PG8_SA(0, 0), a2, voffA);
            PG8_BAR; PG8_WAIT_L(0); PG8_MMA(1, 0, At, B0); PG8_BAR; PG8_SCHED;
            PG8_STAGE(PG8_SB(0, 1), b2 + hstep, voffB);
            PG8_WAIT_V(6); PG8_BAR; PG8_MMA(1, 1, At, B1); PG8_BAR;
            PG8_LDB(B0, 1, 0); PG8_SCHED; PG8_LDA(At, 1, 0); PG8_STAGE(PG8_SA(0, 1), a2 + hstep, voffA);
            PG8_WAIT_L(8); PG8_BAR; PG8_WAIT_L(0); PG8_MMA(0, 0, At, B0); PG8_BAR; PG8_SCHED;
            PG8_LDB(B1, 1, 1); PG8_STAGE(PG8_SB(1, 0), b3, voffB);
            PG8_BAR; PG8_WAIT_L(0); PG8_MMA(0, 1, At, B1); PG8_BAR;
            PG8_LDA(At, 1, 1); PG8_STAGE(PG8_SA(1, 0), a3, voffA);
            PG8_BAR; PG8_WAIT_L(0); PG8_MMA(1, 0, At, B0); PG8_BAR; PG8_SCHED;
            PG8_STAGE(PG8_SB(1, 1), b3 + hstep, voffB);
            PG8_WAIT_V(6); PG8_BAR; PG8_MMA(1, 1, At, B1); PG8_BAR;
            }
        }
        if constexpr (ALIGN_EPI) { if (wr == 0) PG8_BAR; }
        if constexpr (!Epi::AFTER_DRAIN) { E(acc, cur, wr, wc, fr, fq); S.done(cur); }
        if (!has_next) break;
#pragma unroll
        for (int a = 0; a < 2; ++a)
#pragma unroll
            for (int b = 0; b < 2; ++b)
#pragma unroll
                for (int m = 0; m < 4; ++m)
#pragma unroll
                    for (int n = 0; n < 2; ++n) acc[a][b][m][n] = (f32x4){0.f, 0.f, 0.f, 0.f};
        cur = nxt; cA = nA; cB = nB; ++ui;
        if constexpr (ALIGN_EPI) { if (wr == 1) PG8_BAR; }
    }
    PG8_WAIT_V(0);
    if constexpr (!ALIGN_EPI) { if (wr == 0) PG8_BAR; }
    PG8_BAR;
    if constexpr (Epi::AFTER_DRAIN) { E.fused(acc, cur, wr, wc, fr, fq, lds, wid, lane); S.done(cur); }
#undef PG8_SA
#undef PG8_SB
#undef PG8_STAGE
#undef PG8_LDA
#undef PG8_LDB
#undef PG8_MMA
#undef PG8_WAIT_V
#undef PG8_WAIT_L
#undef PG8_BAR
#undef PG8_SCHED
}
}
#ifndef PG8_SP2
#define PG8_SP2 true
#endif
#ifndef PG8_ALIGN
#define PG8_ALIGN true
#endif
constexpr int RING_BYTES = 143360;
constexpr int LDSCTL_OFF = RING_BYTES, MISC_OFF = LDSCTL_OFF + 320;
constexpr int LDS_BYTES = 147456;
#define GAS __attribute__((address_space(1)))
#define LAS __attribute__((address_space(3)))
#define XB_TMO      128
#define XB_XCNT(j)  (256  + 64 * (j))
#define XB_XSUB(j)  (1280 + 64 * (j))
#define XB_XGEN(j)  (2304 + 64 * (j))
#define XB_TOP      3328
#define XB_TOPGEN   3392
#define XCD_BAR_WORDS 3456
#define XB_SPIN_CAP (1u << 18)

__device__ __forceinline__ unsigned xb_ld(unsigned* p)              { return __hip_atomic_load(p, __ATOMIC_RELAXED, __HIP_MEMORY_SCOPE_AGENT); }
__device__ __forceinline__ unsigned xb_add(unsigned* p, unsigned v) { return __hip_atomic_fetch_add(p, v, __ATOMIC_RELAXED, __HIP_MEMORY_SCOPE_AGENT); }
__device__ __forceinline__ unsigned xb_xcc_id() { return (unsigned)__builtin_amdgcn_s_getreg((3 << 11) | 20) & 0xFu; }
#define XB_SPIN(cond, bar) do { unsigned _sp = 0; while (cond) { __builtin_amdgcn_s_sleep(1); \
    if ((++_sp & 255u) == 0u) { if (xb_ld(&(bar)[XB_TMO])) break; if (_sp > XB_SPIN_CAP) { atomicAdd(&(bar)[XB_TMO], 1u); break; } } } } while (0)

struct XcdBarrier {
    unsigned* bar; unsigned x;
    volatile LAS unsigned* st;
};

__device__ __forceinline__ XcdBarrier xcd_barrier_post(unsigned* bar, volatile LAS unsigned* st) {
    XcdBarrier b; b.bar = bar; b.x = xb_xcc_id(); b.st = st;
    if (threadIdx.x == 0) (void)xb_add(&bar[XB_XCNT(b.x)], 1u);
    return b;
}
__device__ __forceinline__ void xcd_barrier_complete(unsigned* bar, unsigned x, unsigned& nloc, unsigned& nx) {
    const unsigned G = gridDim.x * gridDim.y * gridDim.z;
    unsigned sum, cnt, mine, sp = 0u;
    for (;;) {
        sum = 0u; cnt = 0u; mine = 0u;
#pragma unroll
        for (unsigned j = 0; j < 16; ++j) { const unsigned c = xb_ld(&bar[XB_XCNT(j)]); sum += c; cnt += (c > 0u) ? 1u : 0u; mine = (j == x) ? c : mine; }
        if (sum == G) break;
        __builtin_amdgcn_s_sleep(1);
        if ((++sp & 255u) == 0u) { if (xb_ld(&bar[XB_TMO])) break; if (sp > XB_SPIN_CAP) { atomicAdd(&bar[XB_TMO], 1u); break; } }
    }
    nloc = mine > 0u ? mine : 1u; nx = cnt > 0u ? cnt : 1u;
}

__device__ __forceinline__ void xcd_barrier(const XcdBarrier& b) {
    asm volatile("s_waitcnt vmcnt(0)" ::: "memory");
    __syncthreads();
    if (threadIdx.x == 0) {
        unsigned* bar = b.bar;
        __builtin_amdgcn_s_waitcnt(0);
        unsigned nloc = b.st[0], nx = b.st[1];
        if (nloc == 0u) { xcd_barrier_complete(bar, b.x, nloc, nx); b.st[0] = nloc; b.st[1] = nx; }
        const unsigned old = xb_add(&bar[XB_XSUB(b.x)], 1u);
        const unsigned gen = old / nloc;
        if (old + 1u == (gen + 1u) * nloc) {
            __builtin_amdgcn_fence(__ATOMIC_RELEASE, "agent");
            asm volatile("s_waitcnt vmcnt(0)" ::: "memory");
            const unsigned og = xb_add(&bar[XB_TOP], 1u);
            const unsigned tg = og / nx;
            if (og + 1u == (tg + 1u) * nx) xb_add(&bar[XB_TOPGEN], 1u);
            else XB_SPIN(xb_ld(&bar[XB_TOPGEN]) == tg, bar);
            __builtin_amdgcn_fence(__ATOMIC_ACQUIRE, "agent");
            xb_add(&bar[XB_XGEN(b.x)], 1u);
            asm volatile("s_waitcnt vmcnt(0)" ::: "memory");
        } else {
            XB_SPIN(xb_ld(&bar[XB_XGEN(b.x)]) == gen, bar);
            __builtin_amdgcn_fence(__ATOMIC_ACQUIRE, "agent");
            asm volatile("s_waitcnt vmcnt(0)" ::: "memory");
        }
    }
    __syncthreads();
}
typedef unsigned short bf16;
typedef unsigned v4u __attribute__((ext_vector_type(4)));
typedef unsigned v2u __attribute__((ext_vector_type(2)));
typedef float f32x4 __attribute__((ext_vector_type(4)));
typedef short bf16x8 __attribute__((ext_vector_type(8)));
typedef LAS unsigned char* ldsp;
#define LDS_WAIT() asm volatile("s_waitcnt lgkmcnt(0)" ::: "memory")
typedef float f32x2_t __attribute__((ext_vector_type(2))); typedef __bf16 bf16x2_t __attribute__((ext_vector_type(2)));
__device__ __forceinline__ unsigned pk2(float lo, float hi) { const f32x2_t v = {lo, hi}; const bf16x2_t b = __builtin_convertvector(v, bf16x2_t); return __builtin_bit_cast(unsigned, b); }
__device__ __forceinline__ unsigned f2bf(float f) { return pk2(f, f) & 0xffffu; }
__device__ __forceinline__ float blo(unsigned w) { return __uint_as_float(w << 16); }
__device__ __forceinline__ float bhi(unsigned w) { return __uint_as_float(w & 0xffff0000u); }
__device__ __forceinline__ float b2f(bf16 b) { return __uint_as_float(((unsigned)b) << 16); }
__device__ __forceinline__ float sigmoid_f(float x) { return __builtin_amdgcn_rcpf(1.0f + __builtin_amdgcn_exp2f(x * -1.4426950408889634f)); }
__device__ __forceinline__ float wave_sum(float v) {
#pragma unroll
    for (int o = 1; o < 64; o <<= 1) v += __shfl_xor(v, o);
    return v;
}
#define MFMA16(a, b, c) __builtin_amdgcn_mfma_f32_16x16x32_bf16((a), (b), (c), 0, 0, 0)

struct Args {
    const float *xp, *xs, *memp, *c128, *c512, *c2048, *sth, *cmem, *npre, *npost, *win, *lbl, *hgn, *mnorm, *wmem, *wpa, *wpb, *wpc, *wout;
    float* out; unsigned char* ws;
};

__device__ __forceinline__ int win_vrow(int n) { if (n < 3072) { const int d = n & 63; return (n & ~63) + ((d & 3) | (((d >> 5) & 1) << 2) | (((d >> 2) & 3) << 3) | (((d >> 4) & 1) << 5)); } return n; }
struct TrDesc { const float* W; bf16* WT; int K, N, ldk, koff; bool rope; };
__device__ __forceinline__ void tr_load(const TrDesc& d, int item, int lane, f32x4 (&v)[8]) {
    const int nblk = d.N / 32, kb = item / nblk, nb = item % nblk; const float* p = d.W + (size_t)(64 * kb + (lane >> 3)) * d.N + 32 * nb + (lane & 7) * 4;
#pragma unroll
    for (int i = 0; i < 8; ++i) v[i] = *(const f32x4*)(p + (size_t)(8 * i) * d.N);
}
__device__ __forceinline__ void tr_store(const TrDesc& d, int item, int lane, const f32x4 (&v)[8], LAS float* scr) {
    const int nblk = d.N / 32, kb = item / nblk, nb = item % nblk, k0 = 64 * kb, n0 = 32 * nb;
#pragma unroll
    for (int i = 0; i < 8; ++i) { LAS float* q = scr + (8 * i + (lane >> 3)) * 33 + (lane & 7) * 4; q[0] = v[i][0]; q[1] = v[i][1]; q[2] = v[i][2]; q[3] = v[i][3]; }
    LDS_WAIT(); asm volatile("" ::: "memory");
    const int c = lane & 7;
#pragma unroll
    for (int j = 0; j < 4; ++j) { const int n = (lane >> 3) + 8 * j; const LAS float* s = scr + (8 * c) * 33 + n;
        v4u o; o.x = pk2(s[0 * 33], s[1 * 33]); o.y = pk2(s[2 * 33], s[3 * 33]); o.z = pk2(s[4 * 33], s[5 * 33]); o.w = pk2(s[6 * 33], s[7 * 33]);
        const int dr = d.rope ? win_vrow(n0 + n) : (n0 + n);
        *(v4u*)(d.WT + (size_t)dr * d.ldk + d.koff + k0 + 8 * c) = o; }
    LDS_WAIT(); asm volatile("" ::: "memory");
}
__device__ __forceinline__ void rms_rows2_to_bf16(const float* x0, const float* x1, const float* g, bf16* o0, bf16* o1, int lane) {
    const f32x4* xr0 = (const f32x4*)x0 + lane; const f32x4* xr1 = (const f32x4*)x1 + lane; const f32x4* gr = (const f32x4*)g + lane;
    f32x4 a[4], b[4]; float sa = 0.f, sb = 0.f;
#pragma unroll
    for (int j = 0; j < 4; ++j) { a[j] = xr0[64 * j]; b[j] = xr1[64 * j]; }
#pragma unroll
    for (int j = 0; j < 4; ++j) { sa += (a[j].x * a[j].x + a[j].y * a[j].y) + (a[j].z * a[j].z + a[j].w * a[j].w); sb += (b[j].x * b[j].x + b[j].y * b[j].y) + (b[j].z * b[j].z + b[j].w * b[j].w); }
#pragma unroll
    for (int o = 1; o < 64; o <<= 1) { sa += __shfl_xor(sa, o); sb += __shfl_xor(sb, o); }
    const float ra = rsqrtf(sa * (1.f / 1024.f) + EPS), rb = rsqrtf(sb * (1.f / 1024.f) + EPS);
    v2u* p0 = (v2u*)o0 + lane; v2u* p1 = (v2u*)o1 + lane;
#pragma unroll
    for (int j = 0; j < 4; ++j) { const f32x4 gv = gr[64 * j]; v2u w;
        w.x = pk2(a[j].x * ra * gv.x, a[j].y * ra * gv.y); w.y = pk2(a[j].z * ra * gv.z, a[j].w * ra * gv.w); p0[64 * j] = w;
        w.x = pk2(b[j].x * rb * gv.x, b[j].y * rb * gv.y); w.y = pk2(b[j].z * rb * gv.z, b[j].w * rb * gv.w); p1[64 * j] = w; }
}
__device__ __forceinline__ void sincos_entry(int pos, int i, float& c, float& s) {
    const float invf[32] = {1.000000000e+00f, 7.498942018e-01f, 5.623413324e-01f, 4.216965139e-01f, 3.162277639e-01f, 2.371373773e-01f, 1.778279394e-01f, 1.333521456e-01f, 1.000000015e-01f, 7.498942316e-02f, 5.623413250e-02f, 4.216964915e-02f, 3.162277490e-02f, 2.371373773e-02f, 1.778279431e-02f, 1.333521400e-02f, 9.999999776e-03f, 7.498942316e-03f, 5.623413250e-03f, 4.216964822e-03f, 3.162277630e-03f, 2.371373819e-03f, 1.778279431e-03f, 1.333521446e-03f, 1.000000047e-03f, 7.498941850e-04f, 5.623413017e-04f, 4.216965172e-04f, 3.162277571e-04f, 2.371373703e-04f, 1.778279402e-04f, 1.333521504e-04f};
    const float ang = (float)pos * invf[i];
    const double x = (double)ang, kq = rint(x * 0.63661977236758134308);
    double r = fma(-kq, 1.57079632679489655800, x); r = fma(-kq, 6.12323399573676603587e-17, r);
    const float rf = (float)r, r2 = rf * rf; const int q = ((int)kq) & 3;
    const float sp = rf + rf * r2 * (-1.6666654611e-1f + r2 * (8.3321608736e-3f + r2 * (-1.9515295891e-4f)));
    const float cp = 1.0f - 0.5f * r2 + r2 * r2 * (4.166664568298827e-2f + r2 * (-1.388731625493765e-3f + r2 * 2.443315711809948e-5f));
    c = (q == 0) ? cp : (q == 1 ? -sp : (q == 2 ? -cp : sp));
    s = (q == 0) ? sp : (q == 1 ? cp : (q == 2 ? -sp : -cp));
}
__device__ __forceinline__ TrDesc tr_desc(const Args& A, int& r) {
    unsigned char* ws = A.ws; constexpr int I_IN = 16 * 352, I_MEM = 16 * 32, I_BR = 8 * 32;
    if (r < I_IN) return TrDesc{A.win, (bf16*)(ws + WS_WIN), 1024, NIN, 1024, 0, true}; r -= I_IN;
    if (r < I_MEM) return TrDesc{A.wmem, (bf16*)(ws + WS_WMEM), 1024, 1024, 1024, 0, false}; r -= I_MEM;
    if (r < I_BR) return TrDesc{A.wpa, (bf16*)(ws + WS_WPA), 512, 1024, 1536, 0, false}; r -= I_BR;
    if (r < I_BR) return TrDesc{A.wpb, (bf16*)(ws + WS_WPA), 512, 1024, 1536, 512, false}; r -= I_BR;
    if (r < I_BR) return TrDesc{A.wpc, (bf16*)(ws + WS_WPA), 512, 1024, 1536, 1024, false}; r -= I_BR;
    return TrDesc{A.wout, (bf16*)(ws + WS_WOUT), 1024, 1024, 1024, 0, false};
}
__device__ __forceinline__ void p0_prologue(const Args& A, ldsp lds, int tid, int G) {
    const int lane = tid & 63, wave = tid >> 6;
    unsigned char* ws = A.ws;
    LAS float* scr = (LAS float*)(lds + wave * 16384);
    const int gw = blockIdx.x * 8 + wave, NGW = G * 8;
    bf16* XN = (bf16*)(ws + WS_XN); bf16* MN = (bf16*)(ws + WS_MN);
    for (int m2 = gw; m2 < (T_SEQ + NSAMP + 256) / 2; m2 += NGW) { const int m = 2 * m2;
        if (m < T_SEQ) rms_rows2_to_bf16(A.xp + (size_t)m * 1024, A.xp + (size_t)(m + 1) * 1024, A.npre, XN + (size_t)m * 1024, XN + (size_t)(m + 1) * 1024, lane);
        else if (m < T_SEQ + NSAMP) rms_rows2_to_bf16(A.xs + (size_t)(m - T_SEQ) * 1024, A.xs + (size_t)(m + 1 - T_SEQ) * 1024, A.npre, XN + (size_t)m * 1024, XN + (size_t)(m + 1) * 1024, lane);
        else { const int q = m - T_SEQ - NSAMP; rms_rows2_to_bf16(A.memp + (size_t)q * 1024, A.memp + (size_t)(q + 1) * 1024, A.mnorm, MN + (size_t)q * 1024, MN + (size_t)(q + 1) * 1024, lane); } }
    constexpr int NITEMS = 16 * 352 + 16 * 32 + 3 * 8 * 32 + 16 * 32;
    for (int it = gw; it < NITEMS / 2; it += NGW) { int r0 = 2 * it, r1 = 2 * it + 1; const TrDesc d0 = tr_desc(A, r0), d1 = tr_desc(A, r1);
        f32x4 v0[8], v1[8]; tr_load(d0, r0, lane, v0); tr_load(d1, r1, lane, v1);
        tr_store(d0, r0, lane, v0, scr); tr_store(d1, r1, lane, v1, scr); }
    float* cs = (float*)(ws + WS_CS);
    for (int e = blockIdx.x * 512 + tid; e < T_SEQ * 32; e += G * 512) { float c, s; sincos_entry(e >> 5, e & 31, c, s); *(float2*)(cs + (size_t)e * 2) = make_float2(c, s); }
}

constexpr int VT_STRIDE = 276;
__device__ __forceinline__ void attn_dil_unit(ldsp lds, const bf16* U, bf16* OG, float* LSE, int g, int dil, int r, int nb, int h, int tid) {
    const int lane = tid & 63, w = __builtin_amdgcn_readfirstlane(tid >> 6), l15 = lane & 15, q4 = lane >> 4;
    LAS bf16* VT = (LAS bf16*)lds;
    const int colq = C_AQ + g * 512 + h * 64, colk = C_AK + g * 512 + h * 64, colv = C_AV + g * 512 + h * 64;
    __syncthreads();
#pragma unroll
    for (int it = 0; it < 4; ++it) { const int key = (tid >> 3) + 64 * it, d8 = (tid & 7) * 8, kp = (nb - 1) * 128 + key;
        bf16x8 v = (bf16x8){0, 0, 0, 0, 0, 0, 0, 0};
        if (kp >= 0) v = *(const bf16x8*)(U + (size_t)(kp * dil + r) * NIN + colv + d8);
#pragma unroll
        for (int j = 0; j < 8; ++j) VT[(d8 + j) * VT_STRIDE + key] = (bf16)v[j]; }
    for (int e = tid; e < 64 * 20; e += 512) VT[(e / 20) * VT_STRIDE + 256 + (e % 20)] = 0;
    __syncthreads();
    const int tq = (nb * 128 + w * 16 + l15) * dil + r;
    bf16x8 qf[2];
#pragma unroll
    for (int kk = 0; kk < 2; ++kk) qf[kk] = *(const bf16x8*)(U + (size_t)tq * NIN + colq + 32 * kk + 8 * q4);
    f32x4 s[9];
#pragma unroll
    for (int kt = 0; kt < 9; ++kt) { int kp = (nb - 1) * 128 + 16 * w + 16 * kt + l15; kp = kp < 0 ? 0 : kp;
        const bf16* kr = U + (size_t)(kp * dil + r) * NIN + colk + 8 * q4;
        f32x4 a = (f32x4){0.f, 0.f, 0.f, 0.f};
#pragma unroll
        for (int kk = 0; kk < 2; ++kk) a = MFMA16(*(const bf16x8*)(kr + 32 * kk), qf[kk], a);
        s[kt] = a; }
    float m = -1e30f;
#pragma unroll
    for (int kt = 0; kt < 9; ++kt)
#pragma unroll
        for (int j = 0; j < 4; ++j) { const int klr = 16 * kt + 4 * q4 + j, dist = l15 + 128 - klr;
            const bool ok = dist >= 0 && dist <= 128 && (nb > 0 || (16 * w + klr) >= 128);
            s[kt][j] = ok ? s[kt][j] : -1e30f; m = fmaxf(m, s[kt][j]); }
    m = fmaxf(m, __shfl_xor(m, 16)); m = fmaxf(m, __shfl_xor(m, 32));
    float l = 0.f;
#pragma unroll
    for (int kt = 0; kt < 9; ++kt)
#pragma unroll
        for (int j = 0; j < 4; ++j) { const float p = __expf(s[kt][j] - m); s[kt][j] = p; l += p; }
    l += __shfl_xor(l, 16); l += __shfl_xor(l, 32);
    f32x4 o[4];
#pragma unroll
    for (int dt = 0; dt < 4; ++dt) o[dt] = (f32x4){0.f, 0.f, 0.f, 0.f};
#pragma unroll
    for (int ks = 0; ks < 5; ++ks) {
        v4u pw; pw.x = pk2(s[2 * ks][0], s[2 * ks][1]); pw.y = pk2(s[2 * ks][2], s[2 * ks][3]);
        if (ks < 4) { pw.z = pk2(s[2 * ks + 1][0], s[2 * ks + 1][1]); pw.w = pk2(s[2 * ks + 1][2], s[2 * ks + 1][3]); } else { pw.z = 0u; pw.w = 0u; }
        const bf16x8 pf = __builtin_bit_cast(bf16x8, pw);
#pragma unroll
        for (int dt = 0; dt < 4; ++dt) { const LAS bf16* vp = VT + (16 * dt + l15) * VT_STRIDE + 16 * w + 32 * ks + 4 * q4;
            const v2u lo = *(const LAS v2u*)vp, hi = *(const LAS v2u*)(vp + 16);
            v4u vw; vw.x = lo.x; vw.y = lo.y; vw.z = hi.x; vw.w = hi.y;
            o[dt] = MFMA16(__builtin_bit_cast(bf16x8, vw), pf, o[dt]); } }
    const float inv = 1.0f / l;
    bf16* op = OG + ((size_t)g * MROWS + tq) * 512 + h * 64 + 4 * q4;
#pragma unroll
    for (int dt = 0; dt < 4; ++dt) { v2u wv; wv.x = pk2(o[dt][0] * inv, o[dt][1] * inv); wv.y = pk2(o[dt][2] * inv, o[dt][3] * inv); *(v2u*)(op + 16 * dt) = wv; }
    if (q4 == 0) LSE[((size_t)g * MROWS + tq) * 8 + h] = m + __logf(l);
}
constexpr int XK_STRIDE = 136;
__device__ __forceinline__ void xattn_unit(ldsp lds, const bf16* U, const bf16* MKV, bf16* YC, int cg, int h, int tid) {
    const int lane = tid & 63, w = __builtin_amdgcn_readfirstlane(tid >> 6), l15 = lane & 15, q4 = lane >> 4;
    LAS bf16* KS = (LAS bf16*)lds;
    LAS bf16* VT = (LAS bf16*)(lds + 256 * XK_STRIDE * 2);
    __syncthreads();
    { const int key = tid >> 1, hf = tid & 1; const bf16* kp = MKV + (size_t)key * 1024 + h * 128 + 64 * hf; v4u kv[8];
#pragma unroll
      for (int i = 0; i < 8; ++i) kv[i] = *(const v4u*)(kp + 8 * i);
#pragma unroll
      for (int i = 0; i < 8; ++i) *(LAS v4u*)(KS + key * XK_STRIDE + 64 * hf + 8 * i) = kv[i]; }
#pragma unroll
    for (int it = 0; it < 8; ++it) { const int key = (tid >> 4) + 32 * it, d8 = (tid & 15) * 8;
        const bf16x8 v = *(const bf16x8*)(MKV + (size_t)key * 1024 + 512 + h * 128 + d8);
#pragma unroll
        for (int j = 0; j < 8; ++j) VT[(d8 + j) * VT_STRIDE + key] = (bf16)v[j]; }
    __syncthreads();
#pragma unroll 1
    for (int qt = 0; qt < 2; ++qt) {
        const int row = (2 * cg + qt) * 128 + w * 16 + l15;
        int lofs = 8 * q4; asm volatile("" : "+v"(lofs));
        bf16x8 qf[4];
#pragma unroll
        for (int kk = 0; kk < 4; ++kk) qf[kk] = *(const bf16x8*)(U + (size_t)row * NIN + C_CQ + h * 128 + 32 * kk + 8 * q4);
        f32x4 s[16];
#pragma unroll
        for (int kt = 0; kt < 16; ++kt) { const LAS bf16* kr = KS + (16 * kt + l15) * XK_STRIDE + lofs;
            f32x4 a = (f32x4){0.f, 0.f, 0.f, 0.f};
#pragma unroll
            for (int kk = 0; kk < 4; ++kk) a = MFMA16(*(const LAS bf16x8*)(kr + 32 * kk), qf[kk], a);
            s[kt] = a * 0.08838834764831845f; }
        float m = -1e30f;
#pragma unroll
        for (int kt = 0; kt < 16; ++kt)
#pragma unroll
            for (int j = 0; j < 4; ++j) m = fmaxf(m, s[kt][j]);
        m = fmaxf(m, __shfl_xor(m, 16)); m = fmaxf(m, __shfl_xor(m, 32));
        float l = 0.f;
#pragma unroll
        for (int kt = 0; kt < 16; ++kt)
#pragma unroll
            for (int j = 0; j < 4; ++j) { const float p = __expf(s[kt][j] - m); s[kt][j] = p; l += p; }
        l += __shfl_xor(l, 16); l += __shfl_xor(l, 32);
        f32x4 o[8];
#pragma unroll
        for (int dt = 0; dt < 8; ++dt) o[dt] = (f32x4){0.f, 0.f, 0.f, 0.f};
#pragma unroll
        for (int ks = 0; ks < 8; ++ks) {
            v4u pw; pw.x = pk2(s[2 * ks][0], s[2 * ks][1]); pw.y = pk2(s[2 * ks][2], s[2 * ks][3]); pw.z = pk2(s[2 * ks + 1][0], s[2 * ks + 1][1]); pw.w = pk2(s[2 * ks + 1][2], s[2 * ks + 1][3]);
            const bf16x8 pf = __builtin_bit_cast(bf16x8, pw);
#pragma unroll
            for (int dt = 0; dt < 8; ++dt) { const LAS bf16* vp = VT + (16 * dt + l15) * VT_STRIDE + 32 * ks + (lofs >> 1);
                const v2u lo = *(const LAS v2u*)vp, hi = *(const LAS v2u*)(vp + 16);
                v4u vw; vw.x = lo.x; vw.y = lo.y; vw.z = hi.x; vw.w = hi.y;
                o[dt] = MFMA16(__builtin_bit_cast(bf16x8, vw), pf, o[dt]); } }
        const float inv = 1.0f / l;
        const bf16* zp = U + (size_t)row * NIN + C_CZ + h * 128 + 4 * q4; bf16* op = YC + (size_t)row * YPITCH + h * 128 + 4 * q4;
#pragma unroll
        for (int dt = 0; dt < 8; ++dt) { const v2u z = *(const v2u*)(zp + 16 * dt); v2u wv;
            wv.x = pk2(o[dt][0] * inv * blo(z.x), o[dt][1] * inv * bhi(z.x)); wv.y = pk2(o[dt][2] * inv * blo(z.y), o[dt][3] * inv * bhi(z.y)); *(v2u*)(op + 16 * dt) = wv; }
    }
}
__device__ __forceinline__ float lb_of(const float* lbl, int c) { return 1.0f / (1.0f + __expf(lbl[512 + c] - lbl[c])); }
__device__ __forceinline__ void hgrn_pass1_unit(ldsp lds, const bf16* U, const float* lbl, float* HU, float* HP, int h, int j, int tid) {
    LAS float* fb = (LAS float*)lds; LAS float* kb = fb + 32 * 128; LAS float* vb = kb + 32 * 128;
    const int v = tid & 127, kq = __builtin_amdgcn_readfirstlane(tid >> 7), tok = tid >> 4, c8 = (tid & 15) * 8;
    float s[32], lbr[8];
#pragma unroll
    for (int i = 0; i < 32; ++i) s[i] = 0.f;
#pragma unroll
    for (int e = 0; e < 8; ++e) lbr[e] = lb_of(lbl, h * 128 + c8 + e);
    float pacc = 1.f;
    for (int ch = 0; ch < 8; ++ch) {
        __syncthreads();
        { const size_t ro = (size_t)(j * 256 + ch * 32 + tok) * NIN + h * 128 + c8;
          const v4u fw = *(const v4u*)(U + ro + C_BF), vw = *(const v4u*)(U + ro + C_BI);
          const unsigned fa[4] = {fw.x, fw.y, fw.z, fw.w}, va[4] = {vw.x, vw.y, vw.z, vw.w};
#pragma unroll
          for (int e = 0; e < 4; ++e) { const float x0 = blo(fa[e]), x1 = bhi(fa[e]);
              const float f0 = lbr[2 * e] + (1.f - lbr[2 * e]) * sigmoid_f(x0), f1 = lbr[2 * e + 1] + (1.f - lbr[2 * e + 1]) * sigmoid_f(x1);
              const int o = tok * 128 + c8 + 2 * e;
              fb[o] = f0; fb[o + 1] = f1; kb[o] = 1.f - f0; kb[o + 1] = 1.f - f1; vb[o] = blo(va[e]); vb[o + 1] = bhi(va[e]); } }
        __syncthreads();
        for (int tt = 0; tt < 32; ++tt) { const float vv = vb[tt * 128 + v]; const LAS f32x4* f4 = (const LAS f32x4*)(fb + tt * 128 + kq * 32); const LAS f32x4* k4 = (const LAS f32x4*)(kb + tt * 128 + kq * 32);
#pragma unroll
            for (int i4 = 0; i4 < 8; ++i4) { const f32x4 f = f4[i4], k = k4[i4];
#pragma unroll
                for (int e = 0; e < 4; ++e) s[4 * i4 + e] = f[e] * s[4 * i4 + e] + k[e] * vv; } }
        if (tid < 128) { for (int tt = 0; tt < 32; ++tt) pacc *= fb[tt * 128 + tid]; }
    }
    float* up = HU + ((size_t)(j * 4 + h) * 128 + kq * 32) * 128 + v;
#pragma unroll
    for (int i = 0; i < 32; ++i) up[(size_t)i * 128] = s[i];
    if (tid < 128) HP[(size_t)(j * 4 + h) * 128 + tid] = pacc;
}
__device__ __forceinline__ void hgrn_scan_unit(const float* __restrict__ HU, const float* __restrict__ HP, float* __restrict__ HS, float* __restrict__ outS, int e, int tid) {
    if (tid >= 256) return;
    const int idx = e * 256 + tid, h = idx >> 14, k = (idx >> 7) & 127, vk = idx & 16383;
    float S = 0.f;
#pragma unroll 1
    for (int j0 = 0; j0 < 64; j0 += 16) { float hu[16], hp[16];
#pragma unroll
        for (int q = 0; q < 16; ++q) { hu[q] = HU[(size_t)((j0 + q) * 4 + h) * 16384 + vk]; hp[q] = HP[(size_t)((j0 + q) * 4 + h) * 128 + k]; }
#pragma unroll
        for (int q = 0; q < 16; ++q) { HS[(size_t)((j0 + q) * 4 + h) * 16384 + vk] = S; S = hp[q] * S + hu[q]; } }
    outS[idx] = S;
}
__device__ __forceinline__ void hgrn_pass3_unit(ldsp lds, const bf16* U, const float* lbl, const float* hgn, const float* HS, bf16* YB, int h, int j, int tid) {
    LAS float* fb = (LAS float*)lds; LAS float* kb = fb + 32 * 128; LAS float* vb = kb + 32 * 128; LAS float* qb = vb + 32 * 128; LAS float* ob = qb + 32 * 128;
    const int lane = tid & 63, wv = tid >> 6, v = tid & 127, kq = __builtin_amdgcn_readfirstlane(tid >> 7), tok = tid >> 4, c8 = (tid & 15) * 8;
    float s[32], lbr[8];
    { const float* sp = HS + ((size_t)(j * 4 + h) * 128 + kq * 32) * 128 + v;
#pragma unroll
      for (int i = 0; i < 32; ++i) s[i] = sp[(size_t)i * 128]; }
#pragma unroll
    for (int e = 0; e < 8; ++e) lbr[e] = lb_of(lbl, h * 128 + c8 + e);
    const float g0 = hgn[h * 128 + lane], g1 = hgn[h * 128 + 64 + lane];
    for (int ch = 0; ch < 8; ++ch) {
        __syncthreads();
        { const size_t ro = (size_t)(j * 256 + ch * 32 + tok) * NIN + h * 128 + c8;
          const v4u fw = *(const v4u*)(U + ro + C_BF), vw = *(const v4u*)(U + ro + C_BI), qw = *(const v4u*)(U + ro + C_BQ);
          const unsigned fa[4] = {fw.x, fw.y, fw.z, fw.w}, va[4] = {vw.x, vw.y, vw.z, vw.w}, qa[4] = {qw.x, qw.y, qw.z, qw.w};
#pragma unroll
          for (int e = 0; e < 4; ++e) { const float x0 = blo(fa[e]), x1 = bhi(fa[e]);
              const float f0 = lbr[2 * e] + (1.f - lbr[2 * e]) * sigmoid_f(x0), f1 = lbr[2 * e + 1] + (1.f - lbr[2 * e + 1]) * sigmoid_f(x1);
              const int o = tok * 128 + c8 + 2 * e;
              fb[o] = f0; fb[o + 1] = f1; kb[o] = 1.f - f0; kb[o + 1] = 1.f - f1; vb[o] = blo(va[e]); vb[o + 1] = bhi(va[e]); qb[o] = blo(qa[e]); qb[o + 1] = bhi(qa[e]); } }
        __syncthreads();
        for (int tt = 0; tt < 32; ++tt) { const float vv = vb[tt * 128 + v]; const LAS f32x4* f4 = (const LAS f32x4*)(fb + tt * 128 + kq * 32); const LAS f32x4* k4 = (const LAS f32x4*)(kb + tt * 128 + kq * 32); const LAS f32x4* q4p = (const LAS f32x4*)(qb + tt * 128 + kq * 32);
            float acc = 0.f;
#pragma unroll
            for (int i4 = 0; i4 < 8; ++i4) { const f32x4 f = f4[i4], k = k4[i4], q = q4p[i4];
#pragma unroll
                for (int e = 0; e < 4; ++e) { s[4 * i4 + e] = f[e] * s[4 * i4 + e] + k[e] * vv; acc += s[4 * i4 + e] * q[e]; } }
            ob[(tt * 4 + kq) * 128 + v] = acc; }
        __syncthreads();
#pragma unroll
        for (int q = 0; q < 4; ++q) { const int tt = wv * 4 + q; const LAS float* op = ob + tt * 512;
            const float o0 = (op[lane] + op[128 + lane]) + (op[256 + lane] + op[384 + lane]), o1 = (op[64 + lane] + op[192 + lane]) + (op[320 + lane] + op[448 + lane]);
            const float rstd = rsqrtf(wave_sum(o0 * o0 + o1 * o1) * (1.f / 128.f) + EPS);
            const size_t t = (size_t)(j * 256 + ch * 32 + tt);
            const bf16* zp = U + t * NIN + C_BZ + h * 128; bf16* yp = YB + t * YPITCH + h * 128;
            yp[lane] = (bf16)f2bf(o0 * rstd * g0 * b2f(zp[lane])); yp[64 + lane] = (bf16)f2bf(o1 * rstd * g1 * b2f(zp[64 + lane])); }
    }
}
constexpr int HG_QT_STRIDE = 136, HG_KH_STRIDE = 40, HG_BUF = 38400;
template <bool OUT>
__device__ __forceinline__ void hgrn_mfma_unit(ldsp lds, const bf16* U, const float* lbl, const float* hgn, const float* HS, float* HU, float* HP, bf16* YB, int h, int j, int tid) {
    const int lane = tid & 63, w = __builtin_amdgcn_readfirstlane(tid >> 6), l15 = lane & 15, q4 = lane >> 4;
    const int k = 16 * w + l15, tq = q4;
    LAS float* SSQ = (LAS float*)(lds + 2 * HG_BUF);
    const float lb = lb_of(lbl, h * 128 + k), oml = 1.f - lb;
    f32x4 S[8];
    if (OUT) { const float* sp = HS + (size_t)(j * 4 + h) * 16384 + (size_t)(4 * q4) * 128 + 16 * w + l15;
#pragma unroll
        for (int kt = 0; kt < 8; ++kt)
#pragma unroll
            for (int r = 0; r < 4; ++r) S[kt][r] = sp[(size_t)(16 * kt + r) * 128]; }
    else {
#pragma unroll
        for (int kt = 0; kt < 8; ++kt) S[kt] = (f32x4){0.f, 0.f, 0.f, 0.f}; }
    float ptot = 0.f;
    bf16 rq[8], rf[8], rv[8];
    const bf16* ub = U + (size_t)(j * 256 + 8 * tq) * NIN + h * 128 + k;
#pragma unroll
    for (int i = 0; i < 8; ++i) { rf[i] = ub[(size_t)i * NIN + C_BF]; rv[i] = ub[(size_t)i * NIN + C_BI]; rq[i] = OUT ? ub[(size_t)i * NIN + C_BQ] : (bf16)0; }
    f32x4 op[2] = {(f32x4){0.f, 0.f, 0.f, 0.f}, (f32x4){0.f, 0.f, 0.f, 0.f}};
    __syncthreads();
    for (int ch = 0; ch < 8; ++ch) {
        ldsp ib = lds + (ch & 1) * HG_BUF;
        LAS bf16* QT = (LAS bf16*)ib; LAS bf16* KT = (LAS bf16*)(ib + 8704); LAS bf16* KH = (LAS bf16*)(ib + 17408); LAS bf16* VT = (LAS bf16*)(ib + 27648); LAS float* DC = (LAS float*)(ib + 37888);
        float kin[8], cum[8]; float c = 0.f;
#pragma unroll
        for (int i = 0; i < 8; ++i) { const float f = lb + oml * sigmoid_f(b2f(rf[i])); kin[i] = 1.f - f; c += __logf(f); cum[i] = c; }
        const float t0 = __shfl(c, l15), t1 = __shfl(c, 16 + l15), t2 = __shfl(c, 32 + l15), t3 = __shfl(c, 48 + l15);
        const float pre = (tq > 0 ? t0 : 0.f) + (tq > 1 ? t1 : 0.f) + (tq > 2 ? t2 : 0.f), tot = (t0 + t1) + (t2 + t3);
        { unsigned khw[4], vtw[4];
#pragma unroll
          for (int i2 = 0; i2 < 4; ++i2) { float kh2[2];
#pragma unroll
              for (int e = 0; e < 2; ++e) { const int i = 2 * i2 + e, t = 8 * tq + i; const float b = pre + cum[i];
                  if (OUT) { QT[t * HG_QT_STRIDE + k] = (bf16)f2bf(b2f(rq[i]) * __expf(b)); KT[t * HG_QT_STRIDE + k] = (bf16)f2bf(kin[i] * __expf(fminf(-b, 80.f))); }
                  kh2[e] = kin[i] * __expf(tot - b); }
              khw[i2] = pk2(kh2[0], kh2[1]); vtw[i2] = (unsigned)rv[2 * i2] | ((unsigned)rv[2 * i2 + 1] << 16); }
          v4u a; a.x = khw[0]; a.y = khw[1]; a.z = khw[2]; a.w = khw[3]; *(LAS v4u*)(KH + k * HG_KH_STRIDE + 8 * tq) = a;
          v4u b; b.x = vtw[0]; b.y = vtw[1]; b.z = vtw[2]; b.w = vtw[3]; *(LAS v4u*)(VT + k * HG_KH_STRIDE + 8 * tq) = b; }
        if (tq == 0) { DC[k] = __expf(tot); ptot += tot; }
        __syncthreads();
        if (ch < 7) { const bf16* un = ub + (size_t)((ch + 1) * 32) * NIN;
#pragma unroll
            for (int i = 0; i < 8; ++i) { rf[i] = un[(size_t)i * NIN + C_BF]; rv[i] = un[(size_t)i * NIN + C_BI]; if (OUT) rq[i] = un[(size_t)i * NIN + C_BQ]; } }
        if (OUT && ch > 0) {
            const LAS float* sq = SSQ + ((ch - 1) & 1) * 256; const f32x4 g4 = *(const f32x4*)(hgn + h * 128 + 16 * w + 4 * q4);
#pragma unroll
            for (int tt = 0; tt < 2; ++tt) { float ss = 0.f;
#pragma unroll
                for (int q = 0; q < 8; ++q) ss += sq[q * 32 + 16 * tt + l15];
                const float rstd = rsqrtf(ss * (1.f / 128.f) + EPS);
                const size_t t = (size_t)(j * 256 + (ch - 1) * 32 + 16 * tt + l15);
                const v2u z = *(const v2u*)(U + t * NIN + C_BZ + h * 128 + 16 * w + 4 * q4); v2u y;
                y.x = pk2(op[tt][0] * rstd * g4[0] * blo(z.x), op[tt][1] * rstd * g4[1] * bhi(z.x)); y.y = pk2(op[tt][2] * rstd * g4[2] * blo(z.y), op[tt][3] * rstd * g4[3] * bhi(z.y));
                *(v2u*)(YB + t * YPITCH + h * 128 + 16 * w + 4 * q4) = y; } }
        const bf16x8 vnat = *(const LAS bf16x8*)(VT + (16 * w + l15) * HG_KH_STRIDE + 8 * q4);
        if (OUT) {
            f32x4 a00 = (f32x4){0.f, 0.f, 0.f, 0.f}, a01 = a00, a11 = a00;
#pragma unroll
            for (int kk = 0; kk < 4; ++kk) { const bf16x8 k0 = *(const LAS bf16x8*)(KT + l15 * HG_QT_STRIDE + 32 * kk + 8 * q4), k1 = *(const LAS bf16x8*)(KT + (16 + l15) * HG_QT_STRIDE + 32 * kk + 8 * q4);
                const bf16x8 u0 = *(const LAS bf16x8*)(QT + l15 * HG_QT_STRIDE + 32 * kk + 8 * q4), u1 = *(const LAS bf16x8*)(QT + (16 + l15) * HG_QT_STRIDE + 32 * kk + 8 * q4);
                a00 = MFMA16(k0, u0, a00); a01 = MFMA16(k0, u1, a01); a11 = MFMA16(k1, u1, a11); }
#pragma unroll
            for (int r = 0; r < 4; ++r) { const bool ok = (4 * q4 + r) <= l15; a00[r] = ok ? a00[r] : 0.f; a11[r] = ok ? a11[r] : 0.f; }
            v4u p0, p1; p0.x = pk2(a00[0], a00[1]); p0.y = pk2(a00[2], a00[3]); p0.z = 0u; p0.w = 0u;
            p1.x = pk2(a01[0], a01[1]); p1.y = pk2(a01[2], a01[3]); p1.z = pk2(a11[0], a11[1]); p1.w = pk2(a11[2], a11[3]);
            const LAS bf16* vp = VT + (16 * w + l15) * HG_KH_STRIDE + 4 * q4; const v2u vlo = *(const LAS v2u*)vp, vhi = *(const LAS v2u*)(vp + 16);
            v4u vw; vw.x = vlo.x; vw.y = vlo.y; vw.z = vhi.x; vw.w = vhi.y; const bf16x8 vperm = __builtin_bit_cast(bf16x8, vw);
            f32x4 o[2];
            o[0] = MFMA16(vperm, __builtin_bit_cast(bf16x8, p0), ((f32x4){0.f, 0.f, 0.f, 0.f}));
            o[1] = MFMA16(vperm, __builtin_bit_cast(bf16x8, p1), ((f32x4){0.f, 0.f, 0.f, 0.f}));
#pragma unroll
            for (int kk = 0; kk < 4; ++kk) { v4u sw; sw.x = pk2(S[2 * kk][0], S[2 * kk][1]); sw.y = pk2(S[2 * kk][2], S[2 * kk][3]); sw.z = pk2(S[2 * kk + 1][0], S[2 * kk + 1][1]); sw.w = pk2(S[2 * kk + 1][2], S[2 * kk + 1][3]);
                const bf16x8 sf = __builtin_bit_cast(bf16x8, sw);
#pragma unroll
                for (int tt = 0; tt < 2; ++tt) { const LAS bf16* qp = QT + (16 * tt + l15) * HG_QT_STRIDE + 32 * kk + 4 * q4; const v2u qlo = *(const LAS v2u*)qp, qhi = *(const LAS v2u*)(qp + 16);
                    v4u qw; qw.x = qlo.x; qw.y = qlo.y; qw.z = qhi.x; qw.w = qhi.y; o[tt] = MFMA16(sf, __builtin_bit_cast(bf16x8, qw), o[tt]); } }
            LAS float* sq = SSQ + (ch & 1) * 256;
#pragma unroll
            for (int tt = 0; tt < 2; ++tt) { float p = (o[tt][0] * o[tt][0] + o[tt][1] * o[tt][1]) + (o[tt][2] * o[tt][2] + o[tt][3] * o[tt][3]); p += __shfl_xor(p, 16); p += __shfl_xor(p, 32); if (q4 == 0) sq[w * 32 + 16 * tt + l15] = p; op[tt] = o[tt]; }
        }
#pragma unroll
        for (int kt = 0; kt < 8; ++kt) { const f32x4 d = *(const LAS f32x4*)(DC + 16 * kt + 4 * q4); const bf16x8 kf = *(const LAS bf16x8*)(KH + (16 * kt + l15) * HG_KH_STRIDE + 8 * q4);
            S[kt] = MFMA16(kf, vnat, S[kt] * d); }
    }
    if (OUT) {
        __syncthreads();
        const LAS float* sq = SSQ + 256; const f32x4 g4 = *(const f32x4*)(hgn + h * 128 + 16 * w + 4 * q4);
#pragma unroll
        for (int tt = 0; tt < 2; ++tt) { float ss = 0.f;
#pragma unroll
            for (int q = 0; q < 8; ++q) ss += sq[q * 32 + 16 * tt + l15];
            const float rstd = rsqrtf(ss * (1.f / 128.f) + EPS);
            const size_t t = (size_t)(j * 256 + 7 * 32 + 16 * tt + l15);
            const v2u z = *(const v2u*)(U + t * NIN + C_BZ + h * 128 + 16 * w + 4 * q4); v2u y;
            y.x = pk2(op[tt][0] * rstd * g4[0] * blo(z.x), op[tt][1] * rstd * g4[1] * bhi(z.x)); y.y = pk2(op[tt][2] * rstd * g4[2] * blo(z.y), op[tt][3] * rstd * g4[3] * bhi(z.y));
            *(v2u*)(YB + t * YPITCH + h * 128 + 16 * w + 4 * q4) = y; }
    }
    if (!OUT) { float* up = HU + (size_t)(j * 4 + h) * 16384 + (size_t)(4 * q4) * 128 + 16 * w + l15;
#pragma unroll
        for (int kt = 0; kt < 8; ++kt)
#pragma unroll
            for (int r = 0; r < 4; ++r) up[(size_t)(16 * kt + r) * 128] = S[kt][r];
        if (tq == 0) HP[(size_t)(j * 4 + h) * 128 + k] = __expf(ptot); }
}
__device__ __forceinline__ void attn_merge_row(const bf16* U, const bf16* OG, const float* LSE, bf16* YA, int t, int lane) {
    const int hd = lane >> 3, c8 = lane * 8;
    const float l0 = LSE[((size_t)0 * MROWS + t) * 8 + hd], l1 = LSE[((size_t)1 * MROWS + t) * 8 + hd], l2 = LSE[((size_t)2 * MROWS + t) * 8 + hd];
    const float mx = fmaxf(l0, fmaxf(l1, l2)); float w0 = __expf(l0 - mx), w1 = __expf(l1 - mx), w2 = __expf(l2 - mx); const float inv = 1.f / (w0 + w1 + w2); w0 *= inv; w1 *= inv; w2 *= inv;
    const v4u a = *(const v4u*)(OG + ((size_t)0 * MROWS + t) * 512 + c8), b = *(const v4u*)(OG + ((size_t)1 * MROWS + t) * 512 + c8), c = *(const v4u*)(OG + ((size_t)2 * MROWS + t) * 512 + c8);
    const v4u z = *(const v4u*)(U + (size_t)t * NIN + C_AZ + c8);
    const unsigned aa[4] = {a.x, a.y, a.z, a.w}, ba[4] = {b.x, b.y, b.z, b.w}, ca[4] = {c.x, c.y, c.z, c.w}, za[4] = {z.x, z.y, z.z, z.w}; unsigned oa[4];
#pragma unroll
    for (int e = 0; e < 4; ++e) oa[e] = pk2((w0 * blo(aa[e]) + w1 * blo(ba[e]) + w2 * blo(ca[e])) * blo(za[e]), (w0 * bhi(aa[e]) + w1 * bhi(ba[e]) + w2 * bhi(ca[e])) * bhi(za[e]));
    v4u o; o.x = oa[0]; o.y = oa[1]; o.z = oa[2]; o.w = oa[3]; *(v4u*)(YA + (size_t)t * YPITCH + c8) = o;
}
__device__ __forceinline__ void samp_attn_unit(ldsp lds, const Args& A, const bf16* U, bf16* YA, int b, int hh, int tid) {
    LAS float* xch = (LAS float*)lds;
    const int lane = tid & 63, w = tid >> 6, h = 4 * hh + (w >> 1), kh = w & 1, ks = lane >> 4, dp = lane & 15; const size_t row = T_SEQ + b; const bf16* ur = U + row * NIN;
    float m = -1e30f, l = 0.f; f32x4 acc = (f32x4){0.f, 0.f, 0.f, 0.f};
#pragma unroll
    for (int g = 0; g < 3; ++g) { const int dil = (g == 0) ? 1 : (g == 1 ? 4 : 16), Wb = 128 * dil; const float* cache = ((g == 0) ? A.c128 : (g == 1 ? A.c512 : A.c2048)) + (size_t)b * Wb * 1024 + h * 64 + 4 * dp;
        const v2u qw = *(const v2u*)(ur + C_AQ + g * 512 + h * 64 + 4 * dp); const f32x4 q = (f32x4){blo(qw.x), bhi(qw.x), blo(qw.y), bhi(qw.y)};
        if (ks == 0 && kh == 0) { const v2u kw = *(const v2u*)(ur + C_AK + g * 512 + h * 64 + 4 * dp), vw = *(const v2u*)(ur + C_AV + g * 512 + h * 64 + 4 * dp);
            float sc = q[0] * blo(kw.x) + q[1] * bhi(kw.x) + q[2] * blo(kw.y) + q[3] * bhi(kw.y);
            sc += __shfl_xor(sc, 1); sc += __shfl_xor(sc, 2); sc += __shfl_xor(sc, 4); sc += __shfl_xor(sc, 8);
            const float mn = fmaxf(m, sc), corr = __expf(m - mn), pe = __expf(sc - mn); l = l * corr + pe;
            acc = acc * corr + pe * (f32x4){blo(vw.x), bhi(vw.x), blo(vw.y), bhi(vw.y)}; m = mn; }
#pragma unroll 8
        for (int it = 0; it < 16; ++it) { const int jj = 1 + ks + 4 * (16 * kh + it), idx = Wb - dil * jj; const float* kp = cache + (size_t)idx * 1024;
            const f32x4 k4 = *(const f32x4*)kp, v4 = *(const f32x4*)(kp + 512);
            float sc = (q[0] * k4[0] + q[1] * k4[1]) + (q[2] * k4[2] + q[3] * k4[3]);
            sc += __shfl_xor(sc, 1); sc += __shfl_xor(sc, 2); sc += __shfl_xor(sc, 4); sc += __shfl_xor(sc, 8);
            const float mn = fmaxf(m, sc), corr = __expf(m - mn), pe = __expf(sc - mn); l = l * corr + pe; acc = acc * corr + pe * v4; m = mn; } }
    float ma = fmaxf(m, __shfl_xor(m, 16)); ma = fmaxf(ma, __shfl_xor(ma, 32));
    { const float sc = __expf(m - ma); l *= sc; acc = acc * sc; }
    l += __shfl_xor(l, 16); l += __shfl_xor(l, 32);
#pragma unroll
    for (int e = 0; e < 4; ++e) { acc[e] += __shfl_xor(acc[e], 16); acc[e] += __shfl_xor(acc[e], 32); }
    __syncthreads();
    if (kh == 1 && ks == 0) { LAS float* x = xch + ((w >> 1) * 16 + dp) * 6; x[0] = acc[0]; x[1] = acc[1]; x[2] = acc[2]; x[3] = acc[3]; x[4] = ma; x[5] = l; }
    __syncthreads();
    if (kh == 0 && ks == 0) { const LAS float* x = xch + ((w >> 1) * 16 + dp) * 6; const float mb = x[4], M = fmaxf(ma, mb), ea = __expf(ma - M), eb = __expf(mb - M);
        const float inv = 1.f / (l * ea + x[5] * eb); const v2u z = *(const v2u*)(ur + C_AZ + h * 64 + 4 * dp); v2u o;
        o.x = pk2((acc[0] * ea + x[0] * eb) * inv * blo(z.x), (acc[1] * ea + x[1] * eb) * inv * bhi(z.x)); o.y = pk2((acc[2] * ea + x[2] * eb) * inv * blo(z.y), (acc[3] * ea + x[3] * eb) * inv * bhi(z.y));
        *(v2u*)(YA + row * YPITCH + h * 64 + 4 * dp) = o; }
}
__device__ __forceinline__ void samp_hgrn_unit(ldsp lds, const Args& A, const bf16* U, bf16* YB, int b, int h, int tid) {
    LAS float* fb = (LAS float*)lds; LAS float* kb = fb + 128; LAS float* qb = kb + 128; LAS float* red = qb + 128;
    const size_t row = T_SEQ + b; const bf16* ur = U + row * NIN;
    __syncthreads();
    if (tid < 128) { const float lb = lb_of(A.lbl, h * 128 + tid), f = lb + (1.f - lb) * sigmoid_f(b2f(ur[C_BF + h * 128 + tid])); fb[tid] = f; kb[tid] = 1.f - f; qb[tid] = b2f(ur[C_BQ + h * 128 + tid]); }
    __syncthreads();
    const int v4i = (tid & 31) * 4, kk = tid >> 5;
    const v2u vw = *(const v2u*)(ur + C_BI + h * 128 + v4i); const f32x4 vv = (f32x4){blo(vw.x), bhi(vw.x), blo(vw.y), bhi(vw.y)};
    const float* sp = A.sth + (size_t)(b * 4 + h) * 16384; float* dp = A.out + O_HGS + (size_t)(b * 4 + h) * 16384;
    f32x4 oacc = (f32x4){0.f, 0.f, 0.f, 0.f};
#pragma unroll
    for (int p = 0; p < 8; ++p) { const int k = kk + 16 * p; const f32x4 S = *(const f32x4*)(sp + k * 128 + v4i); const f32x4 Sn = fb[k] * S + kb[k] * vv; *(f32x4*)(dp + k * 128 + v4i) = Sn; oacc += Sn * qb[k]; }
    *(LAS f32x4*)(red + kk * 128 + v4i) = oacc;
    __syncthreads();
    if (tid < 64) { float o0 = 0.f, o1 = 0.f;
#pragma unroll
        for (int q = 0; q < 16; ++q) { o0 += red[q * 128 + tid]; o1 += red[q * 128 + 64 + tid]; }
        const float rstd = rsqrtf(wave_sum(o0 * o0 + o1 * o1) * (1.f / 128.f) + EPS);
        bf16* yp = YB + row * YPITCH + h * 128;
        yp[tid] = (bf16)f2bf(o0 * rstd * A.hgn[h * 128 + tid] * b2f(ur[C_BZ + h * 128 + tid])); yp[64 + tid] = (bf16)f2bf(o1 * rstd * A.hgn[h * 128 + 64 + tid] * b2f(ur[C_BZ + h * 128 + 64 + tid])); }
}
__device__ __forceinline__ void samp_xattn_unit(ldsp lds, const Args& A, const bf16* U, bf16* YC, int b, int h, int tid) {
    LAS float* part = (LAS float*)lds;
    const int lane = tid & 63, w = tid >> 6, sub = lane >> 5, dp = lane & 31; const size_t row = T_SEQ + b; const bf16* ur = U + row * NIN;
    const v2u qw = *(const v2u*)(ur + C_CQ + h * 128 + 4 * dp); const f32x4 q = (f32x4){blo(qw.x), bhi(qw.x), blo(qw.y), bhi(qw.y)} * 0.08838834764831845f;
    const float* mem = A.cmem + (size_t)b * 256 * 1024 + h * 128 + 4 * dp;
    float m = -1e30f, l = 0.f; f32x4 acc = (f32x4){0.f, 0.f, 0.f, 0.f};
#pragma unroll 8
    for (int it = 0; it < 16; ++it) { const float* kp = mem + (size_t)(32 * w + 2 * it + sub) * 1024; const f32x4 k4 = *(const f32x4*)kp, v4 = *(const f32x4*)(kp + 512);
        float sc = (q[0] * k4[0] + q[1] * k4[1]) + (q[2] * k4[2] + q[3] * k4[3]);
        sc += __shfl_xor(sc, 1); sc += __shfl_xor(sc, 2); sc += __shfl_xor(sc, 4); sc += __shfl_xor(sc, 8); sc += __shfl_xor(sc, 16);
        const float mn = fmaxf(m, sc), corr = __expf(m - mn), pe = __expf(sc - mn); l = l * corr + pe; acc = acc * corr + pe * v4; m = mn; }
    const float ma = fmaxf(m, __shfl_xor(m, 32)); const float sc = __expf(m - ma); l *= sc; acc = acc * sc; l += __shfl_xor(l, 32);
#pragma unroll
    for (int e = 0; e < 4; ++e) acc[e] += __shfl_xor(acc[e], 32);
    __syncthreads();
    if (sub == 0) { *(LAS f32x4*)(part + w * 132 + 4 * dp) = acc; if (dp == 0) { part[w * 132 + 128] = ma; part[w * 132 + 129] = l; } }
    __syncthreads();
    if (tid < 128) { float M = -1e30f;
#pragma unroll
        for (int q8 = 0; q8 < 8; ++q8) M = fmaxf(M, part[q8 * 132 + 128]);
        float L = 0.f, O = 0.f;
#pragma unroll
        for (int q8 = 0; q8 < 8; ++q8) { const float e = __expf(part[q8 * 132 + 128] - M); L += part[q8 * 132 + 129] * e; O += part[q8 * 132 + tid] * e; }
        YC[row * YPITCH + h * 128 + tid] = (bf16)f2bf(O / L * b2f(ur[C_CZ + h * 128 + tid])); }
}
template <int NKS>
__device__ __forceinline__ void small_tile(f32x4 (&acc)[4], const bf16* A, int lda, const bf16* Bt, int ldb, int r0, int n0, int k0, int lane) {
    const int l15 = lane & 15, q4 = lane >> 4;
    const bf16* ap = A + (size_t)(r0 + l15) * lda + k0 + 8 * q4; const bf16* bp = Bt + (size_t)(n0 + l15) * ldb + k0 + 8 * q4;
#pragma unroll
    for (int ct = 0; ct < 4; ++ct) acc[ct] = (f32x4){0.f, 0.f, 0.f, 0.f};
#pragma unroll
    for (int ks = 0; ks < NKS; ++ks) { const bf16x8 a = *(const bf16x8*)(ap + 32 * ks);
#pragma unroll
        for (int ct = 0; ct < 4; ++ct) acc[ct] = MFMA16(a, *(const bf16x8*)(bp + (size_t)(16 * ct) * ldb + 32 * ks), acc[ct]); }
}
__device__ __forceinline__ void samp_branch_unit(ldsp lds, const bf16* U, const bf16* Y, const bf16* WPT, bf16* MG, int rt, int cg, int tid) {
    LAS float* part = (LAS float*)lds;
    const int lane = tid & 63, w = __builtin_amdgcn_readfirstlane(tid >> 6), l15 = lane & 15, q4 = lane >> 4, r0 = T_SEQ + 16 * rt, n0 = 64 * cg;
    __syncthreads();
    if (w < 6) { f32x4 acc[4]; small_tile<8>(acc, Y, YPITCH, WPT, 1536, r0, n0, (w >> 1) * 512 + (w & 1) * 256, lane);
#pragma unroll
        for (int ct = 0; ct < 4; ++ct)
#pragma unroll
            for (int r = 0; r < 4; ++r) part[(w * 16 + 4 * q4 + r) * 64 + 16 * ct + l15] = acc[ct][r]; }
    __syncthreads();
    { const int e = tid * 2, row = e >> 6, col = e & 63; const bf16* gp = U + (size_t)(r0 + row) * NIN + C_GA + n0 + col; float m0 = 0.f, m1 = 0.f;
#pragma unroll
      for (int br = 0; br < 3; ++br) { const unsigned gw = *(const unsigned*)(gp + br * 1024); const LAS float* p0 = part + ((2 * br) * 16 + row) * 64 + col; const LAS float* p1 = p0 + 16 * 64;
          m0 += blo(gw) * (p0[0] + p1[0]); m1 += bhi(gw) * (p0[1] + p1[1]); }
      *(unsigned*)(MG + (size_t)(r0 + row) * 1024 + n0 + col) = pk2(m0, m1); }
}
__device__ __forceinline__ void samp_out_unit(ldsp lds, const bf16* MG, const bf16* WOT, float* Z, int rt, int cg, int tid) {
    LAS float* part = (LAS float*)lds;
    const int lane = tid & 63, w = __builtin_amdgcn_readfirstlane(tid >> 6), l15 = lane & 15, q4 = lane >> 4, r0 = T_SEQ + 16 * rt, n0 = 64 * cg;
    __syncthreads();
    { f32x4 acc[4]; small_tile<4>(acc, MG, 1024, WOT, 1024, r0, n0, 128 * w, lane);
#pragma unroll
      for (int ct = 0; ct < 4; ++ct)
#pragma unroll
          for (int r = 0; r < 4; ++r) part[(w * 16 + 4 * q4 + r) * 64 + 16 * ct + l15] = acc[ct][r]; }
    __syncthreads();
    { const int e = tid * 2, row = e >> 6, col = e & 63; float z0 = 0.f, z1 = 0.f;
#pragma unroll
      for (int q = 0; q < 8; ++q) { const LAS float* p = part + (q * 16 + row) * 64 + col; z0 += p[0]; z1 += p[1]; }
      *(float2*)(Z + (size_t)(r0 + row) * 1024 + n0 + col) = make_float2(z0, z1); }
}
__device__ __forceinline__ void final_row(const float* z, const float* hrow, const float* g, float* yrow, int lane) {
    const f32x4* zr = (const f32x4*)z + lane; const f32x4* hr = (const f32x4*)hrow + lane; const f32x4* gr = (const f32x4*)g + lane; f32x4* yr = (f32x4*)yrow + lane;
    f32x4 v[4]; float s = 0.f;
#pragma unroll
    for (int j = 0; j < 4; ++j) { v[j] = zr[64 * j]; s += (v[j].x * v[j].x + v[j].y * v[j].y) + (v[j].z * v[j].z + v[j].w * v[j].w); }
    const float rstd = rsqrtf(wave_sum(s) * (1.f / 1024.f) + EPS);
#pragma unroll
    for (int j = 0; j < 4; ++j) yr[64 * j] = hr[64 * j] + v[j] * rstd * gr[64 * j];
}
__global__ void __launch_bounds__(512, 2) fwd_kernel(Args A) {
    extern __shared__ __attribute__((aligned(16))) unsigned char lds_raw[];
    ldsp lds = (ldsp)lds_raw;
    volatile LAS unsigned* MISC = (volatile LAS unsigned*)(lds + MISC_OFF);
    int tid = threadIdx.x; const int G = gridDim.x, bid = blockIdx.x;
#define NEWTID() do { tid = threadIdx.x; asm volatile("" : "+v"(tid)); } while (0)
    for (int u = tid; u < (LDS_BYTES - LDSCTL_OFF) / 4; u += 512) ((LAS unsigned*)(lds + LDSCTL_OFF))[u] = 0u;
    __syncthreads();
    unsigned char* ws = A.ws;
    unsigned* ctl = (unsigned*)(ws + WS_CTL);
    XcdBarrier bar = xcd_barrier_post(ctl + CW_BAR, MISC + 8);
    bf16* U = (bf16*)(ws + WS_U); bf16* MKV = (bf16*)(ws + WS_MEMKV);
    bf16* YA = (bf16*)(ws + WS_YA); bf16* YB = YA + 512; bf16* YC = YA + 1024;
    bf16* OG = (bf16*)(ws + WS_OG); float* LSE = (float*)(ws + WS_LSE);
    float* HU = (float*)(ws + WS_HU); float* HP = (float*)(ws + WS_HP); float* HS = (float*)(ws + WS_HS);

    NEWTID();
    p0_prologue(A, lds, tid, G);
    xcd_barrier(bar);

    { pg8::Gemm g{(const pg8::bf16_t*)(ws + WS_MN), (const pg8::bf16_t*)(ws + WS_WMEM), 256, 1024, 1024}; pg8::StaticOrder S; S.init(256, 1024, G, (bid + 4) % G);
      pg8::EpiMem E{A.out + O_MEMKV, (pg8::bf16_t*)MKV};
      pg8::gemm_phase<pg8::EpiMem, pg8::StaticOrder, false, PG8_SP2>(lds, g, S, E); }
    __syncthreads();
    { pg8::Gemm g{(const pg8::bf16_t*)(ws + WS_XN), (const pg8::bf16_t*)(ws + WS_WIN), MROWS, NIN, 1024}; pg8::StaticOrder S; S.init(MROWS, NIN, G, bid);
      pg8::EpiU E{(pg8::bf16_t*)U, (const float*)(ws + WS_CS), A.out, (pg8::bf16_t*)(ws + WS_GT)};
      pg8::gemm_phase<pg8::EpiU, pg8::StaticOrder, PG8_ALIGN, PG8_SP2>(lds, g, S, E); }
    xcd_barrier(bar);

    NEWTID();
    for (int u = bid; u < 256; u += G) samp_attn_unit(lds, A, U, YA, u >> 1, u & 1, tid);
    NEWTID();
    for (int u = bid; u < 512; u += G) samp_xattn_unit(lds, A, U, YC, u >> 2, u & 3, tid);
    NEWTID();
    for (int u = bid; u < 512; u += G) samp_hgrn_unit(lds, A, U, YB, u >> 2, u & 3, tid);
    NEWTID();
    for (int u = bid; u < 256; u += G) hgrn_mfma_unit<false>(lds, U, A.lbl, A.hgn, HS, HU, HP, YB, u & 3, u >> 2, tid);
    NEWTID();
    for (int u = bid; u < 3072; u += G) { const int g = u >> 10, rem = u & 1023, h = rem & 7, rb = rem >> 3, dil = (g == 0) ? 1 : (g == 1 ? 4 : 16), nblk = 128 / dil;
        attn_dil_unit(lds, U, OG, LSE, g, dil, rb / nblk, rb % nblk, h, tid); }
    NEWTID();
    for (int u = bid; u < 256; u += G) xattn_unit(lds, U, MKV, YC, u >> 2, u & 3, tid);
    xcd_barrier(bar);

    NEWTID();
    for (int u = bid - 128; u >= 0 && u < 128; u += G) samp_branch_unit(lds, U, YA, (const bf16*)(ws + WS_WPA), (bf16*)(ws + WS_MG), u >> 4, u & 15, tid);
    NEWTID();
    for (int u = bid; u < 256; u += G) hgrn_scan_unit(HU, HP, HS, A.out + O_HGP, u, tid);
    NEWTID();
    for (int t = bid * 8 + (tid >> 6); t < T_SEQ; t += G * 8) attn_merge_row(U, OG, LSE, YA, t, tid & 63);
    xcd_barrier(bar);

    NEWTID();
    for (int u = bid; u < 256; u += G) hgrn_mfma_unit<true>(lds, U, A.lbl, A.hgn, HS, HU, HP, YB, u & 3, u >> 2, tid);
    NEWTID();
    for (int u = bid - 128; u >= 0 && u < 128; u += G) samp_out_unit(lds, (const bf16*)(ws + WS_MG), (const bf16*)(ws + WS_WOUT), (float*)(ws + WS_Z), u >> 4, u & 15, tid);
    xcd_barrier(bar);

    { pg8::Gemm g{(const pg8::bf16_t*)YA, (const pg8::bf16_t*)(ws + WS_WPA), T_SEQ, 1024, 1536}; pg8::StaticOrder S; S.init(T_SEQ, 1024, G, bid);
      pg8::EpiMerged E{(const pg8::bf16_t*)(ws + WS_GT), (pg8::bf16_t*)(ws + WS_MG)};
      pg8::gemm_phase<pg8::EpiMerged, pg8::StaticOrder, PG8_ALIGN, PG8_SP2>(lds, g, S, E); }
    xcd_barrier(bar);

    { pg8::Gemm g{(const pg8::bf16_t*)(ws + WS_MG), (const pg8::bf16_t*)(ws + WS_WOUT), T_SEQ, 1024, 1024}; pg8::StaticOrder S; S.init(T_SEQ, 1024, G, bid);
      pg8::EpiZ E{(float*)(ws + WS_Z)};
      pg8::gemm_phase<pg8::EpiZ, pg8::StaticOrder, PG8_ALIGN, PG8_SP2>(lds, g, S, E); }
    xcd_barrier(bar);

    NEWTID();
    { const float* Z = (const float*)(ws + WS_Z); const int lane = tid & 63;
      for (int m = bid * 8 + (tid >> 6); m < T_SEQ + NSAMP; m += G * 8) {
          if (m < T_SEQ) final_row(Z + (size_t)m * 1024, A.xp + (size_t)m * 1024, A.npost, A.out + O_YP + (size_t)m * 1024, lane);
          else final_row(Z + (size_t)m * 1024, A.xs + (size_t)(m - T_SEQ) * 1024, A.npost, A.out + O_YS + (size_t)(m - T_SEQ) * 1024, lane); } }
}

extern "C" void kernel_launch(void* const* d_in, const int* in_sizes, int n_in, void* d_out, int out_size, void* d_ws, size_t ws_size, hipStream_t stream) {
    static int grid = 0;
    if (grid == 0) {
        if (n_in != 19 || out_size != (int)O_END || ws_size < WS_END) { fprintf(stderr, "kernel_launch: unexpected shapes (n_in %d, out %d, ws %zu); nothing launched\n", n_in, out_size, ws_size); grid = -1; return; }
        int dev = 0, cus = 0, per_cu = 0;
        if (hipGetDevice(&dev) != hipSuccess || hipDeviceGetAttribute(&cus, hipDeviceAttributeMultiprocessorCount, dev) != hipSuccess) { grid = -1; return; }
        if (hipFuncSetAttribute((const void*)fwd_kernel, hipFuncAttributeMaxDynamicSharedMemorySize, LDS_BYTES) != hipSuccess) { fprintf(stderr, "kernel_launch: hipFuncSetAttribute failed\n"); grid = -1; return; }
        if (hipOccupancyMaxActiveBlocksPerMultiprocessor(&per_cu, (const void*)fwd_kernel, 512, LDS_BYTES) != hipSuccess || per_cu < 1) { fprintf(stderr, "kernel_launch: occupancy query says %d blocks per CU\n", per_cu); per_cu = 1; }
        (void)hipGetLastError();
        grid = cus;
    }
    if (grid < 0) return;
    if (hipMemsetAsync((char*)d_ws + WS_CTL, 0, CTL_ZERO_BYTES, stream) != hipSuccess) return;
    Args a{};
    a.xp = (const float*)d_in[0]; a.xs = (const float*)d_in[1]; a.memp = (const float*)d_in[2]; a.c128 = (const float*)d_in[3]; a.c512 = (const float*)d_in[4]; a.c2048 = (const float*)d_in[5];
    a.sth = (const float*)d_in[6]; a.cmem = (const float*)d_in[7]; a.npre = (const float*)d_in[8]; a.npost = (const float*)d_in[9]; a.win = (const float*)d_in[10]; a.lbl = (const float*)d_in[11];
    a.hgn = (const float*)d_in[12]; a.mnorm = (const float*)d_in[13]; a.wmem = (const float*)d_in[14]; a.wpa = (const float*)d_in[15]; a.wpb = (const float*)d_in[16]; a.wpc = (const float*)d_in[17]; a.wout = (const float*)d_in[18];
    a.out = (float*)d_out; a.ws = (unsigned char*)d_ws;
    hipLaunchKernelGGL(fwd_kernel, dim3(grid), dim3(512), LDS_BYTES, stream, a);
    const hipError_t le = hipPeekAtLastError();
    if (le != hipSuccess) fprintf(stderr, "kernel_launch: launch failed: %s\n", hipGetErrorName(le));
}
```

```cpp
#include <hip/hip_runtime.h>
#include <cstdio>
#include <cstdint>
constexpr int T_SEQ = 16384, DMODEL = 1024, NSAMP = 128, MROWS = 16640  , NIN = 11264;
constexpr int C_AQ = 0, C_AK = 1536, C_AV = 3072, C_AZ = 4608, C_BQ = 5120, C_BF = 5632, C_BI = 6144, C_BZ = 6656, C_CQ = 7168, C_CZ = 7680, C_GA = 8192;
constexpr float EPS = 1e-6f;
constexpr int YPITCH = 1536;
constexpr size_t O_YP = 0, O_YS = 16777216, O_W128P = 16908288, O_W512P = 17039360, O_W2048P = 17563648, O_HGP = 19660800, O_MEMKV = 19726336,
                 O_W128S = 19988480, O_W512S = 20119552, O_W2048S = 20250624, O_HGS = 20381696, O_END = 28770304;
constexpr size_t MiB = 1u << 20;
constexpr size_t WS_CTL = 0, CTL_ZERO_BYTES = 1 * MiB;
constexpr size_t WS_WIN = 2 * MiB, WS_WMEM = 24 * MiB, WS_WPA = 26 * MiB, WS_WPB = 27 * MiB, WS_WPC = 28 * MiB, WS_WOUT = 29 * MiB, WS_MN = 31 * MiB, WS_MEMKV = 31 * MiB + 512 * 1024;
constexpr size_t WS_CS = 32 * MiB, WS_XN = 36 * MiB, WS_U = 70 * MiB, WS_OG = 428 * MiB, WS_LSE = 477 * MiB, WS_HU = 479 * MiB, WS_HP = 495 * MiB, WS_HS = 496 * MiB;
constexpr size_t WS_YA = 512 * MiB, WS_YB = 529 * MiB, WS_YC = 546 * MiB, WS_M32 = 563 * MiB, WS_MG = 628 * MiB, WS_Z = 661 * MiB, WS_GT = 726 * MiB, WS_END = 824 * MiB;
constexpr int CW_BAR = 4096;
namespace pg8 {
#define PG8_LAS __attribute__((address_space(3)))
typedef unsigned short bf16_t;
typedef short bf16x8 __attribute__((ext_vector_type(8)));
typedef float f32x4 __attribute__((ext_vector_type(4)));
typedef unsigned u32x4 __attribute__((ext_vector_type(4)));
constexpr int BM = 256, BK = 64, HALF = 128, HTB = HALF * BK * 2  , STAGE_BYTES = 8 * HTB, NXCD = 8, WGM = 8;

__host__ __device__ __forceinline__ int lds_byte(int r, int c) { const int st = (r >> 4) * 2 + (c >> 5), rr = r & 15, cc = c & 31, ob = rr * 64 + cc * 2; return st * 1024 + (ob ^ (((ob >> 9) & 1) << 5)); }
__host__ __device__ __forceinline__ void stage_rc(int b, int& R, int& C) { const int st = b / 1024, sb = b % 1024, swz = sb ^ (((sb >> 9) & 1) << 5); R = (st >> 1) * 16 + swz / 64; C = (st & 1) * 32 + (swz % 64) / 2; }
__host__ __device__ __forceinline__ int perm32(int rho) { const int n = rho >> 4, i = rho & 15; return 8 * (i >> 2) + 4 * n + (i & 3); }

struct Unit { int pm, pn; };
struct Gemm { const bf16_t* A; const bf16_t* Bt; int M, N, K; };

struct StaticOrder {
    int nM, nN, nwg, G, c;
    __host__ __device__ void init(int M, int N, int G_, int c_) { nM = M / BM; nN = N / BM; nwg = nM * nN; G = G_; c = c_; }
    __host__ __device__ bool next(int i, Unit& u) const {
        const long L = (long)i * G + c; if (L >= nwg) return false;
        int wgid = (int)L; { const int q = nwg / NXCD, r = nwg % NXCD, xcd = wgid % NXCD, off = wgid / NXCD; wgid = (xcd < r ? xcd * (q + 1) : r * (q + 1) + (xcd - r) * q) + off; }
        const int nig = WGM * nN, gid = wgid / nig, fm = gid * WGM, gsz = (nM - fm) < WGM ? (nM - fm) : WGM;
        u.pm = fm + ((wgid % nig) % gsz); u.pn = (wgid % nig) / gsz; return true;
    }
    __device__ __forceinline__ void a_ready(const Unit&) const {}
    __device__ __forceinline__ void done(const Unit&) const {}
};

struct PanelOrder {
    int pm, n, c;
    __device__ __forceinline__ bool next(int i, Unit& u) const { if (i > 0 || c < 0 || c >= n) return false; u.pm = pm; u.pn = c; return true; }
    __device__ __forceinline__ void a_ready(const Unit&) const {}
    __device__ __forceinline__ void done(const Unit&) const {}
};
__device__ __forceinline__ unsigned cvt_pk_bf16(float lo, float hi) { unsigned r; asm volatile("v_cvt_pk_bf16_f32 %0, %1, %2" : "=v"(r) : "v"(lo), "v"(hi)); return r; }
typedef unsigned u32x2 __attribute__((ext_vector_type(2)));
typedef float f32x2 __attribute__((ext_vector_type(2)));
__device__ __forceinline__ float sigm(float x) { return __builtin_amdgcn_rcpf(1.0f + __builtin_amdgcn_exp2f(x * -1.4426950408889634f)); }
__device__ __forceinline__ float bflo(unsigned w) { return __uint_as_float(w << 16); }
__device__ __forceinline__ float bfhi(unsigned w) { return __uint_as_float(w & 0xffff0000u); }

struct EpiU {
    static constexpr bool PERM = true, AFTER_DRAIN = false, MID = false;
    bf16_t* U; const float* cs; float* out; bf16_t* GT;
    __device__ __forceinline__ void operator()(const f32x4 (&acc)[2][2][4][2], const Unit& u, int wr, int wc, int fr, int fq) const {
        const int pn = u.pn, rbase = u.pm * 256 + wr * 64 + fr, cbase = pn * 256 + wc * 32 + 8 * fq;
        if (pn < 12) {
            const bool isk = pn >= 6; const int g = isk ? ((pn - 6) >> 1) : 0;
            const int t0 = (g == 0) ? 16256 : (g == 1 ? 15872 : 14336);
            const size_t offp = (g == 0) ? O_W128P : (g == 1 ? O_W512P : O_W2048P), offs = (g == 0) ? O_W128S : (g == 1 ? O_W512S : O_W2048S);
            const float qs = isk ? 1.0f : 0.125f;
            const int i0 = 16 * (wc & 1) + 4 * fq, hb0 = pn * 256 + (wc >> 1) * 64;
#pragma unroll
            for (int ai = 0; ai < 2; ++ai)
#pragma unroll
                for (int m = 0; m < 4; ++m) { const int row = rbase + ai * 128 + m * 16, pos = row < T_SEQ ? row : 8192;
                    float* dstr = nullptr;
                    if (isk) { if (row < T_SEQ) { if (row >= t0) dstr = out + offp + (size_t)(row - t0) * 1024; } else if (row < T_SEQ + NSAMP) dstr = out + offs + (size_t)(row - T_SEQ) * 1024; }
                    const float* cp = cs + ((size_t)pos * 32 + i0) * 2; const f32x4 ca = *(const f32x4*)cp * qs, cb = *(const f32x4*)(cp + 4) * qs;
                    const f32x4 cc = (f32x4){ca[0], ca[2], cb[0], cb[2]}, ss = (f32x4){ca[1], ca[3], cb[1], cb[3]};
#pragma unroll
                    for (int bj = 0; bj < 2; ++bj) { const f32x4 xl = acc[ai][bj][m][0], xh = acc[ai][bj][m][1];
                        const f32x4 lo = xl * cc - xh * ss, hi = xh * cc + xl * ss;
                        bf16_t* up = U + (size_t)row * NIN + hb0 + bj * 128 + i0;
                        u32x2 wl; wl.x = cvt_pk_bf16(lo[0], lo[1]); wl.y = cvt_pk_bf16(lo[2], lo[3]); *(u32x2*)up = wl;
                        u32x2 wh; wh.x = cvt_pk_bf16(hi[0], hi[1]); wh.y = cvt_pk_bf16(hi[2], hi[3]); *(u32x2*)(up + 32) = wh;
                        if (dstr) { float* d = dstr + (((hb0 + bj * 128 - C_AK) >> 6) & 7) * 64 + i0; *(f32x4*)d = lo; *(f32x4*)(d + 32) = hi; } } }
        } else if (pn < 18) {
            const int g = (pn - 12) >> 1; const int t0 = (g == 0) ? 16256 : (g == 1 ? 15872 : 14336);
            const size_t offp = (g == 0) ? O_W128P : (g == 1 ? O_W512P : O_W2048P), offs = (g == 0) ? O_W128S : (g == 1 ? O_W512S : O_W2048S);
#pragma unroll
            for (int ai = 0; ai < 2; ++ai)
#pragma unroll
                for (int m = 0; m < 4; ++m) { const int row = rbase + ai * 128 + m * 16;
                    float* dstr = nullptr;
                    if (row < T_SEQ) { if (row >= t0) dstr = out + offp + (size_t)(row - t0) * 1024 + 512; } else if (row < T_SEQ + NSAMP) dstr = out + offs + (size_t)(row - T_SEQ) * 1024 + 512;
#pragma unroll
                    for (int bj = 0; bj < 2; ++bj) { const int vc = cbase + bj * 128; const f32x4 x0 = acc[ai][bj][m][0], x1 = acc[ai][bj][m][1];
                        u32x4 w; w.x = cvt_pk_bf16(x0[0], x0[1]); w.y = cvt_pk_bf16(x0[2], x0[3]); w.z = cvt_pk_bf16(x1[0], x1[1]); w.w = cvt_pk_bf16(x1[2], x1[3]); *(u32x4*)(U + (size_t)row * NIN + vc) = w;
                        if (dstr) { float* d = dstr + ((vc - C_AV) & 511); *(f32x4*)d = x0; *(f32x4*)(d + 4) = x1; } } }
        } else if (pn < 32) {
            const bool act = (pn < 20 || pn == 26 || pn == 27 || pn == 30 || pn == 31);
#pragma unroll
            for (int ai = 0; ai < 2; ++ai)
#pragma unroll
                for (int m = 0; m < 4; ++m) { const int row = rbase + ai * 128 + m * 16;
#pragma unroll
                    for (int bj = 0; bj < 2; ++bj) { const int vc = cbase + bj * 128; f32x4 x0 = acc[ai][bj][m][0], x1 = acc[ai][bj][m][1];
                        if (act) {
#pragma unroll
                            for (int j = 0; j < 4; ++j) { x0[j] *= sigm(x0[j]); x1[j] *= sigm(x1[j]); } }
                        u32x4 w; w.x = cvt_pk_bf16(x0[0], x0[1]); w.y = cvt_pk_bf16(x0[2], x0[3]); w.z = cvt_pk_bf16(x1[0], x1[1]); w.w = cvt_pk_bf16(x1[2], x1[3]); *(u32x4*)(U + (size_t)row * NIN + vc) = w; } }
        } else {
            const int br = (pn - 32) >> 2, pt = (pn - 32) & 3, wid = wr * 4 + wc, lane = fq * 16 + fr;
            bf16_t* gp = GT + ((((size_t)(br * 65 + u.pm) * 4 + pt) * 8 + wid) * 16) * 512 + lane * 8;
#pragma unroll
            for (int ai = 0; ai < 2; ++ai)
#pragma unroll
                for (int bj = 0; bj < 2; ++bj)
#pragma unroll
                    for (int m = 0; m < 4; ++m) { f32x4 x0 = acc[ai][bj][m][0], x1 = acc[ai][bj][m][1];
#pragma unroll
                        for (int j = 0; j < 4; ++j) { x0[j] = fmaxf(sigm(x0[j]), 1e-30f); x1[j] = fmaxf(sigm(x1[j]), 1e-30f); }
                        u32x4 w; w.x = cvt_pk_bf16(x0[0], x0[1]); w.y = cvt_pk_bf16(x0[2], x0[3]); w.z = cvt_pk_bf16(x1[0], x1[1]); w.w = cvt_pk_bf16(x1[2], x1[3]);
                        *(u32x4*)(gp + ((ai * 2 + bj) * 4 + m) * 512) = w;
                        if (u.pm == 64) *(u32x4*)(U + (size_t)(rbase + ai * 128 + m * 16) * NIN + cbase + bj * 128) = w; }
        }
    }
};
struct EpiMem {
    static constexpr bool PERM = false, AFTER_DRAIN = false, MID = false;
    float* O; bf16_t* B;
    __device__ __forceinline__ void operator()(const f32x4 (&acc)[2][2][4][2], const Unit& u, int wr, int wc, int fr, int fq) const {
        const int rbase = u.pm * 256 + wr * 64 + fr, cbase = u.pn * 256 + wc * 32 + 4 * fq;
#pragma unroll
        for (int ai = 0; ai < 2; ++ai)
#pragma unroll
            for (int m = 0; m < 4; ++m) { const int row = rbase + ai * 128 + m * 16;
#pragma unroll
                for (int bj = 0; bj < 2; ++bj)
#pragma unroll
                    for (int n = 0; n < 2; ++n) { const int c = cbase + bj * 128 + n * 16; const f32x4 x = acc[ai][bj][m][n];
                        *(f32x4*)(O + (size_t)row * 1024 + c) = x; u32x2 w; w.x = cvt_pk_bf16(x[0], x[1]); w.y = cvt_pk_bf16(x[2], x[3]); *(u32x2*)(B + (size_t)row * 1024 + c) = w; } }
    }
};
struct EpiMerged {
    static constexpr bool PERM = true, AFTER_DRAIN = false, MID = true;
    const bf16_t* GT; bf16_t* MG;
    __device__ __forceinline__ const bf16_t* gtp(int br, const Unit& u, int wr, int wc, int fr, int fq) const {
        return GT + ((((size_t)(br * 65 + u.pm) * 4 + u.pn) * 8 + wr * 4 + wc) * 16) * 512 + (fq * 16 + fr) * 8; }
    __device__ __forceinline__ void mid(f32x4 (&acc)[2][2][4][2], const Unit& u, int t, int wr, int wc, int fr, int fq) const {
        int lo = (fq * 16 + fr) * 8; asm volatile("" : "+v"(lo));
        const int br = (t == 8) ? 0 : 1;
        const bf16_t* pa = GT + ((((size_t)(br * 65 + u.pm) * 4 + u.pn) * 8 + wr * 4 + wc) * 16) * 512 + lo; const bf16_t* pb = pa + (size_t)65 * 4 * 8 * 16 * 512;
#pragma unroll
        for (int ai = 0; ai < 2; ++ai)
#pragma unroll
            for (int bj = 0; bj < 2; ++bj) {
#pragma unroll
                for (int m = 0; m < 4; ++m) { const int i2 = (ai * 2 + bj) * 4 + m; const u32x4 a = *(const u32x4*)(pa + i2 * 512), b = *(const u32x4*)(pb + i2 * 512);
                    f32x4 r0, r1; r0[0] = bflo(a.x) * __builtin_amdgcn_rcpf(bflo(b.x)); r0[1] = bfhi(a.x) * __builtin_amdgcn_rcpf(bfhi(b.x)); r0[2] = bflo(a.y) * __builtin_amdgcn_rcpf(bflo(b.y)); r0[3] = bfhi(a.y) * __builtin_amdgcn_rcpf(bfhi(b.y));
                    r1[0] = bflo(a.z) * __builtin_amdgcn_rcpf(bflo(b.z)); r1[1] = bfhi(a.z) * __builtin_amdgcn_rcpf(bfhi(b.z)); r1[2] = bflo(a.w) * __builtin_amdgcn_rcpf(bflo(b.w)); r1[3] = bfhi(a.w) * __builtin_amdgcn_rcpf(bfhi(b.w));
                    acc[ai][bj][m][0] = acc[ai][bj][m][0] * r0; acc[ai][bj][m][1] = acc[ai][bj][m][1] * r1; }
                asm volatile("" ::: "memory"); }
    }
    __device__ __forceinline__ void operator()(const f32x4 (&acc)[2][2][4][2], const Unit& u, int wr, int wc, int fr, int fq) const {
        const int rbase = u.pm * 256 + wr * 64 + fr, cbase = u.pn * 256 + wc * 32 + 8 * fq;
        const bf16_t* pc = gtp(2, u, wr, wc, fr, fq);
#pragma unroll
        for (int ai = 0; ai < 2; ++ai)
#pragma unroll
            for (int m = 0; m < 4; ++m) { const int row = rbase + ai * 128 + m * 16;
#pragma unroll
                for (int bj = 0; bj < 2; ++bj) { const int c = cbase + bj * 128; const f32x4 x0 = acc[ai][bj][m][0], x1 = acc[ai][bj][m][1];
                    const u32x4 gw = *(const u32x4*)(pc + ((ai * 2 + bj) * 4 + m) * 512);
                    u32x4 w; w.x = cvt_pk_bf16(x0[0] * bflo(gw.x), x0[1] * bfhi(gw.x)); w.y = cvt_pk_bf16(x0[2] * bflo(gw.y), x0[3] * bfhi(gw.y));
                    w.z = cvt_pk_bf16(x1[0] * bflo(gw.z), x1[1] * bfhi(gw.z)); w.w = cvt_pk_bf16(x1[2] * bflo(gw.w), x1[3] * bfhi(gw.w)); *(u32x4*)(MG + (size_t)row * 1024 + c) = w; } }
    }
};
struct EpiZ {
    static constexpr bool PERM = false, AFTER_DRAIN = false, MID = false;
    float* Z;
    __device__ __forceinline__ void operator()(const f32x4 (&acc)[2][2][4][2], const Unit& u, int wr, int wc, int fr, int fq) const {
        const int rbase = u.pm * 256 + wr * 64 + fr, cbase = u.pn * 256 + wc * 32 + 4 * fq;
#pragma unroll
        for (int ai = 0; ai < 2; ++ai)
#pragma unroll
            for (int m = 0; m < 4; ++m) { const int row = rbase + ai * 128 + m * 16;
#pragma unroll
                for (int bj = 0; bj < 2; ++bj)
#pragma unroll
                    for (int n = 0; n < 2; ++n) *(f32x4*)(Z + (size_t)row * 1024 + cbase + bj * 128 + n * 16) = acc[ai][bj][m][n]; }
    }
};
template <class Epi, class Sched, bool ALIGN_EPI = false, bool SP2 = false>
__device__ __forceinline__ void gemm_phase(PG8_LAS unsigned char* lds, const Gemm g, const Sched& S, const Epi& E) {
    int tid = threadIdx.x; asm volatile("" : "+v"(tid));
    const int wid = __builtin_amdgcn_readfirstlane(tid >> 6), lane = tid & 63, wr = wid >> 2, wc = wid & 3, fr = lane & 15, fq = lane >> 4;
    const int K = g.K, nt = K / BK;
    unsigned voffA[2], voffB[2];
#pragma unroll
    for (int i = 0; i < 2; ++i) { int R, C; stage_rc(tid * 16 + i * 8192, R, C); const int Rb = Epi::PERM ? ((R & ~31) + perm32(R & 31)) : R;
        voffA[i] = (unsigned)(R * K + C) * 2u; voffB[i] = (unsigned)(Rb * K + C) * 2u; }
    const size_t kstep = (size_t)(BK * 2);
    const size_t hstep = (size_t)HALF * K * 2;
    const size_t tstep = 2 * hstep;
    const unsigned ldsw = (unsigned)wid * 1024u;
    const int aoff = lds_byte(wr * 64 + fr, fq * 8), boff = lds_byte(wc * 32 + fr, fq * 8);
#define PG8_SA(b, h) (((b) * 2 + (h)) * HTB)
#define PG8_SB(b, h) ((4 + (b) * 2 + (h)) * HTB)
#define PG8_STAGE(bufoff, gbase, voff) do { _Pragma("unroll") for (int _i = 0; _i < 2; ++_i) \
        __builtin_amdgcn_global_load_lds((const unsigned*)((const char*)(gbase) + (voff)[_i]), (PG8_LAS unsigned*)(lds + (bufoff) + ldsw + _i * 8192), 16, 0, 0); } while (0)
#define PG8_LDA(dst, b, h) do { _Pragma("unroll") for (int m = 0; m < 4; ++m) _Pragma("unroll") for (int k = 0; k < 2; ++k) dst[m][k] = *(const PG8_LAS bf16x8*)(lds + PG8_SA(b, h) + aoff + m * 2048 + k * 1024); } while (0)
#define PG8_LDB(dst, b, h) do { _Pragma("unroll") for (int n = 0; n < 2; ++n) _Pragma("unroll") for (int k = 0; k < 2; ++k) dst[n][k] = *(const PG8_LAS bf16x8*)(lds + PG8_SB(b, h) + boff + n * 2048 + k * 1024); } while (0)
#define PG8_MMA(ai, bj, At, Bt) do { __builtin_amdgcn_s_setprio(1); _Pragma("unroll") for (int m = 0; m < 4; ++m) _Pragma("unroll") for (int n = 0; n < 2; ++n) _Pragma("unroll") for (int k = 0; k < 2; ++k) \
        acc[ai][bj][m][n] = __builtin_amdgcn_mfma_f32_16x16x32_bf16(Bt[n][k], At[m][k], acc[ai][bj][m][n], 0, 0, 0); __builtin_amdgcn_s_setprio(0); } while (0)
#define PG8_WAIT_V(n) asm volatile("s_waitcnt vmcnt(" #n ")" ::: "memory")
#define PG8_WAIT_L(n) asm volatile("s_waitcnt lgkmcnt(" #n ")" ::: "memory")
#define PG8_BAR __builtin_amdgcn_s_barrier()
#define PG8_SCHED __builtin_amdgcn_sched_barrier(0)
    Unit cur, nxt; int ui = 0;
    if (!S.next(0, cur)) return;
    f32x4 acc[2][2][4][2];
#pragma unroll
    for (int a = 0; a < 2; ++a)
#pragma unroll
        for (int b = 0; b < 2; ++b)
#pragma unroll
            for (int m = 0; m < 4; ++m)
#pragma unroll
                for (int n = 0; n < 2; ++n) acc[a][b][m][n] = (f32x4){0.f, 0.f, 0.f, 0.f};
    bf16x8 At[4][2], B0[2][2], B1[2][2];
    const char* cA = (const char*)g.A + (size_t)cur.pm * tstep; const char* cB = (const char*)g.Bt + (size_t)cur.pn * tstep;
    S.a_ready(cur);
    if constexpr (SP2) {
        PG8_STAGE(PG8_SB(0, 0), cB, voffB); PG8_STAGE(PG8_SB(0, 1), cB + hstep, voffB); PG8_STAGE(PG8_SA(0, 0), cA, voffA); PG8_STAGE(PG8_SA(0, 1), cA + hstep, voffA);
        if (wr == 1) PG8_BAR;
        PG8_WAIT_V(2); PG8_BAR;
        PG8_STAGE(PG8_SB(1, 0), cB + kstep, voffB); PG8_STAGE(PG8_SA(1, 0), cA + kstep, voffA); PG8_STAGE(PG8_SB(1, 1), cB + hstep + kstep, voffB);
        PG8_WAIT_V(6); PG8_BAR;
    } else {
        PG8_STAGE(PG8_SB(0, 0), cB, voffB); PG8_STAGE(PG8_SA(0, 0), cA, voffA); PG8_STAGE(PG8_SB(0, 1), cB + hstep, voffB); PG8_STAGE(PG8_SA(0, 1), cA + hstep, voffA);
        if (wr == 1) PG8_BAR;
        PG8_WAIT_V(4); PG8_BAR;
        PG8_STAGE(PG8_SB(1, 0), cB + kstep, voffB); PG8_STAGE(PG8_SA(1, 0), cA + kstep, voffA); PG8_STAGE(PG8_SB(1, 1), cB + hstep + kstep, voffB);
        PG8_WAIT_V(6); PG8_BAR;
    }
    for (;;) {
        const bool has_next = S.next(ui + 1, nxt);
        const char* nA = has_next ? (const char*)g.A + (size_t)nxt.pm * tstep : cA; const char* nB = has_next ? (const char*)g.Bt + (size_t)nxt.pn * tstep : cB;
        for (int t = 0; t < nt; t += 2) {
            const bool last = (t == nt - 2);
            const char* a1 = cA + (size_t)(t + 1) * kstep;
            const char* a2 = last ? nA : cA + (size_t)(t + 2) * kstep; const char* b2 = last ? nB : cB + (size_t)(t + 2) * kstep;
            const char* a3 = a2 + kstep; const char* b3 = b2 + kstep;
            if (last && has_next) S.a_ready(nxt);
            if constexpr (Epi::MID) { if (t == 8 || t == 16) E.mid(acc, cur, t, wr, wc, fr, fq); }
            if constexpr (SP2) {
            PG8_LDB(B0, 0, 0); PG8_LDB(B1, 0, 1); PG8_SCHED; PG8_LDA(At, 0, 0); PG8_STAGE(PG8_SA(1, 1), a1 + hstep, voffA);
            PG8_WAIT_V(8); PG8_WAIT_L(0); PG8_BAR; PG8_MMA(0, 0, At, B0); PG8_MMA(0, 1, At, B1); PG8_BAR; PG8_SCHED;
            PG8_LDA(At, 0, 1); PG8_STAGE(PG8_SB(0, 0), b2, voffB); PG8_STAGE(PG8_SB(0, 1), b2 + hstep, voffB); PG8_STAGE(PG8_SA(0, 0), a2, voffA);
            PG8_WAIT_V(8); PG8_WAIT_L(0); PG8_BAR; PG8_MMA(1, 0, At, B0); PG8_MMA(1, 1, At, B1); PG8_BAR; PG8_SCHED;
            PG8_LDB(B0, 1, 0); PG8_LDB(B1, 1, 1); PG8_SCHED; PG8_LDA(At, 1, 0); PG8_STAGE(PG8_SA(0, 1), a2 + hstep, voffA);
            PG8_WAIT_V(8); PG8_WAIT_L(0); PG8_BAR; PG8_MMA(0, 0, At, B0); PG8_MMA(0, 1, At, B1); PG8_BAR; PG8_SCHED;
            PG8_LDA(At, 1, 1); PG8_STAGE(PG8_SB(1, 0), b3, voffB); PG8_STAGE(PG8_SB(1, 1), b3 + hstep, voffB); PG8_STAGE(PG8_SA(1, 0), a3, voffA);
            PG8_WAIT_V(8); PG8_WAIT_L(0); PG8_BAR; PG8_MMA(1, 0, At, B0); PG8_MMA(1, 1, At, B1); PG8_BAR; PG8_SCHED;
            } else {
            PG8_LDB(B0, 0, 0); PG8_SCHED; PG8_LDA(At, 0, 0); PG8_STAGE(PG8_SA(1, 1), a1 + hstep, voffA);
            PG8_WAIT_L(8); PG8_BAR; PG8_WAIT_L(0); PG8_MMA(0, 0, At, B0); PG8_BAR; PG8_SCHED;
            PG8_LDB(B1, 0, 1); PG8_STAGE(PG8_SB(0, 0), b2, voffB);
            PG8_BAR; PG8_WAIT_L(0); PG8_MMA(0, 1, At, B1); PG8_BAR;
            PG8_LDA(At, 0, 1); PG8_STAGE(PG8_SA(0, 0), a2, voffA);
            PG8_BAR; PG8_WAIT_L(0); PG8_MMA(1, 0, At, B0); PG8_BAR; PG8_SCHED;
            PG8_STAGE(PG8_SB(0, 1), b2 + hstep, voffB);
            PG8_WAIT_V(6); PG8_BAR; PG8_MMA(1, 1, At, B1); PG8_BAR;
            PG8_LDB(B0, 1, 0); PG8_SCHED; PG8_LDA(At, 1, 0); PG8_STAGE(PG8_SA(0, 1), a2 + hstep, voffA);
            PG8_WAIT_L(8); PG8_BAR; PG8_WAIT_L(0); PG8_MMA(0, 0, At, B0); PG8_BAR; PG8_SCHED;
            PG8_LDB(B1, 1, 1); PG8_STAGE(PG8_SB(1, 0), b3, voffB);
            PG8_BAR; PG8_WAIT_L(0); PG8_MMA(0, 1, At, B1); PG8_BAR;
            PG8_LDA(At, 1, 1); PG8_STAGE(PG8_SA(1, 0), a3, voffA);
            PG8_BAR; PG8_WAIT_L(0); PG8_MMA(1, 0, At, B0); PG8_BAR; PG8_SCHED;
            PG8_STAGE(PG8_SB(1, 1), b3 + hstep, voffB);
            PG8_WAIT_V(6); PG8_BAR; PG8_MMA(1, 1, At, B1); PG8_BAR;
            }
        }
        if constexpr (ALIGN_EPI) { if (wr == 0) PG8_BAR; }
        if constexpr (!Epi::AFTER_DRAIN) { E(acc, cur, wr, wc, fr, fq); S.done(cur); }
        if (!has_next) break;
#pragma unroll
        for (int a = 0; a < 2; ++a)
#pragma unroll
            for (int b = 0; b < 2; ++b)
#pragma unroll
                for (int m = 0; m < 4; ++m)
#pragma unroll
                    for (int n = 0; n < 2; ++n) acc[a][b][m][n] = (f32x4){0.f, 0.f, 0.f, 0.f};
        cur = nxt; cA = nA; cB = nB; ++ui;
        if constexpr (ALIGN_EPI) { if (wr == 1) PG8_BAR; }
    }
    PG8_WAIT_V(0);
    if constexpr (!ALIGN_EPI) { if (wr == 0) PG8_BAR; }
    PG8_BAR;
    if constexpr (Epi::AFTER_DRAIN) { E.fused(acc, cur, wr, wc, fr, fq, lds, wid, lane); S.done(cur); }
#undef PG8_SA
#undef PG8_SB
#undef PG8_STAGE
#undef PG8_LDA
#undef PG8_LDB
#undef PG8_MMA
#undef PG8_WAIT_V
#undef PG8_WAIT_L
#undef PG8_BAR
#undef PG8_SCHED
}
}
#ifndef PG8_SP2
#define PG8_SP2 true
#endif
#ifndef PG8_ALIGN
#define PG8_ALIGN true
#endif
constexpr int RING_BYTES = 143360;
constexpr int LDSCTL_OFF = RING_BYTES, MISC_OFF = LDSCTL_OFF + 320;
constexpr int LDS_BYTES = 147456;
#define GAS __attribute__((address_space(1)))
#define LAS __attribute__((address_space(3)))
#define XB_TMO      128
#define XB_XCNT(j)  (256  + 64 * (j))
#define XB_XSUB(j)  (1280 + 64 * (j))
#define XB_XGEN(j)  (2304 + 64 * (j))
#define XB_TOP      3328
#define XB_TOPGEN   3392
#define XCD_BAR_WORDS 3456
#define XB_SPIN_CAP (1u << 18)

__device__ __forceinline__ unsigned xb_ld(unsigned* p)              { return __hip_atomic_load(p, __ATOMIC_RELAXED, __HIP_MEMORY_SCOPE_AGENT); }
__device__ __forceinline__ unsigned xb_add(unsigned* p, unsigned v) { return __hip_atomic_fetch_add(p, v, __ATOMIC_RELAXED, __HIP_MEMORY_SCOPE_AGENT); }
__device__ __forceinline__ unsigned xb_xcc_id() { return (unsigned)__builtin_amdgcn_s_getreg((3 << 11) | 20) & 0xFu; }
#define XB_SPIN(cond, bar) do { unsigned _sp = 0; while (cond) { __builtin_amdgcn_s_sleep(1); \
    if ((++_sp & 255u) == 0u) { if (xb_ld(&(bar)[XB_TMO])) break; if (_sp > XB_SPIN_CAP) { atomicAdd(&(bar)[XB_TMO], 1u); break; } } } } while (0)

struct XcdBarrier {
    unsigned* bar; unsigned x;
    volatile LAS unsigned* st;
};

__device__ __forceinline__ XcdBarrier xcd_barrier_post(unsigned* bar, volatile LAS unsigned* st) {
    XcdBarrier b; b.bar = bar; b.x = xb_xcc_id(); b.st = st;
    if (threadIdx.x == 0) (void)xb_add(&bar[XB_XCNT(b.x)], 1u);
    return b;
}
__device__ __forceinline__ void xcd_barrier_complete(unsigned* bar, unsigned x, unsigned& nloc, unsigned& nx) {
    const unsigned G = gridDim.x * gridDim.y * gridDim.z;
    unsigned sum, cnt, mine, sp = 0u;
    for (;;) {
        sum = 0u; cnt = 0u; mine = 0u;
#pragma unroll
        for (unsigned j = 0; j < 16; ++j) { const unsigned c = xb_ld(&bar[XB_XCNT(j)]); sum += c; cnt += (c > 0u) ? 1u : 0u; mine = (j == x) ? c : mine; }
        if (sum == G) break;
        __builtin_amdgcn_s_sleep(1);
        if ((++sp & 255u) == 0u) { if (xb_ld(&bar[XB_TMO])) break; if (sp > XB_SPIN_CAP) { atomicAdd(&bar[XB_TMO], 1u); break; } }
    }
    nloc = mine > 0u ? mine : 1u; nx = cnt > 0u ? cnt : 1u;
}

__device__ __forceinline__ void xcd_barrier(const XcdBarrier& b) {
    asm volatile("s_waitcnt vmcnt(0)" ::: "memory");
    __syncthreads();
    if (threadIdx.x == 0) {
        unsigned* bar = b.bar;
        __builtin_amdgcn_s_waitcnt(0);
        unsigned nloc = b.st[0], nx = b.st[1];
        if (nloc == 0u) { xcd_barrier_complete(bar, b.x, nloc, nx); b.st[0] = nloc; b.st[1] = nx; }
        const unsigned old = xb_add(&bar[XB_XSUB(b.x)], 1u);
        const unsigned gen = old / nloc;
        if (old + 1u == (gen + 1u) * nloc) {
            __builtin_amdgcn_fence(__ATOMIC_RELEASE, "agent");
            asm volatile("s_waitcnt vmcnt(0)" ::: "memory");
            const unsigned og = xb_add(&bar[XB_TOP], 1u);
            const unsigned tg = og / nx;
            if (og + 1u == (tg + 1u) * nx) xb_add(&bar[XB_TOPGEN], 1u);
            else XB_SPIN(xb_ld(&bar[XB_TOPGEN]) == tg, bar);
            __builtin_amdgcn_fence(__ATOMIC_ACQUIRE, "agent");
            xb_add(&bar[XB_XGEN(b.x)], 1u);
            asm volatile("s_waitcnt vmcnt(0)" ::: "memory");
        } else {
            XB_SPIN(xb_ld(&bar[XB_XGEN(b.x)]) == gen, bar);
            __builtin_amdgcn_fence(__ATOMIC_ACQUIRE, "agent");
            asm volatile("s_waitcnt vmcnt(0)" ::: "memory");
        }
    }
    __syncthreads();
}
typedef unsigned short bf16;
typedef unsigned v4u __attribute__((ext_vector_type(4)));
typedef unsigned v2u __attribute__((ext_vector_type(2)));
typedef float f32x4 __attribute__((ext_vector_type(4)));
typedef short bf16x8 __attribute__((ext_vector_type(8)));
typedef LAS unsigned char* ldsp;
#define LDS_WAIT() asm volatile("s_waitcnt lgkmcnt(0)" ::: "memory")
typedef float f32x2_t __attribute__((ext_vector_type(2))); typedef __bf16 bf16x2_t __attribute__((ext_vector_type(2)));
__device__ __forceinline__ unsigned pk2(float lo, float hi) { const f32x2_t v = {lo, hi}; const bf16x2_t b = __builtin_convertvector(v, bf16x2_t); return __builtin_bit_cast(unsigned, b); }
__device__ __forceinline__ unsigned f2bf(float f) { return pk2(f, f) & 0xffffu; }
__device__ __forceinline__ float blo(unsigned w) { return __uint_as_float(w << 16); }
__device__ __forceinline__ float bhi(unsigned w) { return __uint_as_float(w & 0xffff0000u); }
__device__ __forceinline__ float b2f(bf16 b) { return __uint_as_float(((unsigned)b) << 16); }
__device__ __forceinline__ float sigmoid_f(float x) { return __builtin_amdgcn_rcpf(1.0f + __builtin_amdgcn_exp2f(x * -1.4426950408889634f)); }
__device__ __forceinline__ float wave_sum(float v) {
#pragma unroll
    for (int o = 1; o < 64; o <<= 1) v += __shfl_xor(v, o);
    return v;
}
#define MFMA16(a, b, c) __builtin_amdgcn_mfma_f32_16x16x32_bf16((a), (b), (c), 0, 0, 0)

struct Args {
    const float *xp, *xs, *memp, *c128, *c512, *c2048, *sth, *cmem, *npre, *npost, *win, *lbl, *hgn, *mnorm, *wmem, *wpa, *wpb, *wpc, *wout;
    float* out; unsigned char* ws;
};

__device__ __forceinline__ int win_vrow(int n) { if (n < 3072) { const int d = n & 63; return (n & ~63) + ((d & 3) | (((d >> 5) & 1) << 2) | (((d >> 2) & 3) << 3) | (((d >> 4) & 1) << 5)); } return n; }
struct TrDesc { const float* W; bf16* WT; int K, N, ldk, koff; bool rope; };
__device__ __forceinline__ void tr_load(const TrDesc& d, int item, int lane, f32x4 (&v)[8]) {
    const int nblk = d.N / 32, kb = item / nblk, nb = item % nblk; const float* p = d.W + (size_t)(64 * kb + (lane >> 3)) * d.N + 32 * nb + (lane & 7) * 4;
#pragma unroll
    for (int i = 0; i < 8; ++i) v[i] = *(const f32x4*)(p + (size_t)(8 * i) * d.N);
}
__device__ __forceinline__ void tr_store(const TrDesc& d, int item, int lane, const f32x4 (&v)[8], LAS float* scr) {
    const int nblk = d.N / 32, kb = item / nblk, nb = item % nblk, k0 = 64 * kb, n0 = 32 * nb;
#pragma unroll
    for (int i = 0; i < 8; ++i) { LAS float* q = scr + (8 * i + (lane >> 3)) * 33 + (lane & 7) * 4; q[0] = v[i][0]; q[1] = v[i][1]; q[2] = v[i][2]; q[3] = v[i][3]; }
    LDS_WAIT(); asm volatile("" ::: "memory");
    const int c = lane & 7;
#pragma unroll
    for (int j = 0; j < 4; ++j) { const int n = (lane >> 3) + 8 * j; const LAS float* s = scr + (8 * c) * 33 + n;
        v4u o; o.x = pk2(s[0 * 33], s[1 * 33]); o.y = pk2(s[2 * 33], s[3 * 33]); o.z = pk2(s[4 * 33], s[5 * 33]); o.w = pk2(s[6 * 33], s[7 * 33]);
        const int dr = d.rope ? win_vrow(n0 + n) : (n0 + n);
        *(v4u*)(d.WT + (size_t)dr * d.ldk + d.koff + k0 + 8 * c) = o; }
    LDS_WAIT(); asm volatile("" ::: "memory");
}
__device__ __forceinline__ void rms_rows2_to_bf16(const float* x0, const float* x1, const float* g, bf16* o0, bf16* o1, int lane) {
    const f32x4* xr0 = (const f32x4*)x0 + lane; const f32x4* xr1 = (const f32x4*)x1 + lane; const f32x4* gr = (const f32x4*)g + lane;
    f32x4 a[4], b[4]; float sa = 0.f, sb = 0.f;
#pragma unroll
    for (int j = 0; j < 4; ++j) { a[j] = xr0[64 * j]; b[j] = xr1[64 * j]; }
#pragma unroll
    for (int j = 0; j < 4; ++j) { sa += (a[j].x * a[j].x + a[j].y * a[j].y) + (a[j].z * a[j].z + a[j].w * a[j].w); sb += (b[j].x * b[j].x + b[j].y * b[j].y) + (b[j].z * b[j].z + b[j].w * b[j].w); }
#pragma unroll
    for (int o = 1; o < 64; o <<= 1) { sa += __shfl_xor(sa, o); sb += __shfl_xor(sb, o); }
    const float ra = rsqrtf(sa * (1.f / 1024.f) + EPS), rb = rsqrtf(sb * (1.f / 1024.f) + EPS);
    v2u* p0 = (v2u*)o0 + lane; v2u* p1 = (v2u*)o1 + lane;
#pragma unroll
    for (int j = 0; j < 4; ++j) { const f32x4 gv = gr[64 * j]; v2u w;
        w.x = pk2(a[j].x * ra * gv.x, a[j].y * ra * gv.y); w.y = pk2(a[j].z * ra * gv.z, a[j].w * ra * gv.w); p0[64 * j] = w;
        w.x = pk2(b[j].x * rb * gv.x, b[j].y * rb * gv.y); w.y = pk2(b[j].z * rb * gv.z, b[j].w * rb * gv.w); p1[64 * j] = w; }
}
__device__ __forceinline__ void sincos_entry(int pos, int i, float& c, float& s) {
    const float invf[32] = {1.000000000e+00f, 7.498942018e-01f, 5.623413324e-01f, 4.216965139e-01f, 3.162277639e-01f, 2.371373773e-01f, 1.778279394e-01f, 1.333521456e-01f, 1.000000015e-01f, 7.498942316e-02f, 5.623413250e-02f, 4.216964915e-02f, 3.162277490e-02f, 2.371373773e-02f, 1.778279431e-02f, 1.333521400e-02f, 9.999999776e-03f, 7.498942316e-03f, 5.623413250e-03f, 4.216964822e-03f, 3.162277630e-03f, 2.371373819e-03f, 1.778279431e-03f, 1.333521446e-03f, 1.000000047e-03f, 7.498941850e-04f, 5.623413017e-04f, 4.216965172e-04f, 3.162277571e-04f, 2.371373703e-04f, 1.778279402e-04f, 1.333521504e-04f};
    const float ang = (float)pos * invf[i];
    const double x = (double)ang, kq = rint(x * 0.63661977236758134308);
    double r = fma(-kq, 1.57079632679489655800, x); r = fma(-kq, 6.12323399573676603587e-17, r);
    const float rf = (float)r, r2 = rf * rf; const int q = ((int)kq) & 3;
    const float sp = rf + rf * r2 * (-1.6666654611e-1f + r2 * (8.3321608736e-3f + r2 * (-1.9515295891e-4f)));
    const float cp = 1.0f - 0.5f * r2 + r2 * r2 * (4.166664568298827e-2f + r2 * (-1.388731625493765e-3f + r2 * 2.443315711809948e-5f));
    c = (q == 0) ? cp : (q == 1 ? -sp : (q == 2 ? -cp : sp));
    s = (q == 0) ? sp : (q == 1 ? cp : (q == 2 ? -sp : -cp));
}
__device__ __forceinline__ TrDesc tr_desc(const Args& A, int& r) {
    unsigned char* ws = A.ws; constexpr int I_IN = 16 * 352, I_MEM = 16 * 32, I_BR = 8 * 32;
    if (r < I_IN) return TrDesc{A.win, (bf16*)(ws + WS_WIN), 1024, NIN, 1024, 0, true}; r -= I_IN;
    if (r < I_MEM) return TrDesc{A.wmem, (bf16*)(ws + WS_WMEM), 1024, 1024, 1024, 0, false}; r -= I_MEM;
    if (r < I_BR) return TrDesc{A.wpa, (bf16*)(ws + WS_WPA), 512, 1024, 1536, 0, false}; r -= I_BR;
    if (r < I_BR) return TrDesc{A.wpb, (bf16*)(ws + WS_WPA), 512, 1024, 1536, 512, false}; r -= I_BR;
    if (r < I_BR) return TrDesc{A.wpc, (bf16*)(ws + WS_WPA), 512, 1024, 1536, 1024, false}; r -= I_BR;
    return TrDesc{A.wout, (bf16*)(ws + WS_WOUT), 1024, 1024, 1024, 0, false};
}
__device__ __forceinline__ void p0_prologue(const Args& A, ldsp lds, int tid, int G) {
    const int lane = tid & 63, wave = tid >> 6;
    unsigned char* ws = A.ws;
    LAS float* scr = (LAS float*)(lds + wave * 16384);
    const int gw = blockIdx.x * 8 + wave, NGW = G * 8;
    bf16* XN = (bf16*)(ws + WS_XN); bf16* MN = (bf16*)(ws + WS_MN);
    for (int m2 = gw; m2 < (T_SEQ + NSAMP + 256) / 2; m2 += NGW) { const int m = 2 * m2;
        if (m < T_SEQ) rms_rows2_to_bf16(A.xp + (size_t)m * 1024, A.xp + (size_t)(m + 1) * 1024, A.npre, XN + (size_t)m * 1024, XN + (size_t)(m + 1) * 1024, lane);
        else if (m < T_SEQ + NSAMP) rms_rows2_to_bf16(A.xs + (size_t)(m - T_SEQ) * 1024, A.xs + (size_t)(m + 1 - T_SEQ) * 1024, A.npre, XN + (size_t)m * 1024, XN + (size_t)(m + 1) * 1024, lane);
        else { const int q = m - T_SEQ - NSAMP; rms_rows2_to_bf16(A.memp + (size_t)q * 1024, A.memp + (size_t)(q + 1) * 1024, A.mnorm, MN + (size_t)q * 1024, MN + (size_t)(q + 1) * 1024, lane); } }
    constexpr int NITEMS = 16 * 352 + 16 * 32 + 3 * 8 * 32 + 16 * 32;
    for (int it = gw; it < NITEMS / 2; it += NGW) { int r0 = 2 * it, r1 = 2 * it + 1; const TrDesc d0 = tr_desc(A, r0), d1 = tr_desc(A, r1);
        f32x4 v0[8], v1[8]; tr_load(d0, r0, lane, v0); tr_load(d1, r1, lane, v1);
        tr_store(d0, r0, lane, v0, scr); tr_store(d1, r1, lane, v1, scr); }
    float* cs = (float*)(ws + WS_CS);
    for (int e = blockIdx.x * 512 + tid; e < T_SEQ * 32; e += G * 512) { float c, s; sincos_entry(e >> 5, e & 31, c, s); *(float2*)(cs + (size_t)e * 2) = make_float2(c, s); }
}

constexpr int VT_STRIDE = 276;
__device__ __forceinline__ void attn_dil_unit(ldsp lds, const bf16* U, bf16* OG, float* LSE, int g, int dil, int r, int nb, int h, int tid) {
    const int lane = tid & 63, w = __builtin_amdgcn_readfirstlane(tid >> 6), l15 = lane & 15, q4 = lane >> 4;
    LAS bf16* VT = (LAS bf16*)lds;
    const int colq = C_AQ + g * 512 + h * 64, colk = C_AK + g * 512 + h * 64, colv = C_AV + g * 512 + h * 64;
    __syncthreads();
#pragma unroll
    for (int it = 0; it < 4; ++it) { const int key = (tid >> 3) + 64 * it, d8 = (tid & 7) * 8, kp = (nb - 1) * 128 + key;
        bf16x8 v = (bf16x8){0, 0, 0, 0, 0, 0, 0, 0};
        if (kp >= 0) v = *(const bf16x8*)(U + (size_t)(kp * dil + r) * NIN + colv + d8);
#pragma unroll
        for (int j = 0; j < 8; ++j) VT[(d8 + j) * VT_STRIDE + key] = (bf16)v[j]; }
    for (int e = tid; e < 64 * 20; e += 512) VT[(e / 20) * VT_STRIDE + 256 + (e % 20)] = 0;
    __syncthreads();
    const int tq = (nb * 128 + w * 16 + l15) * dil + r;
    bf16x8 qf[2];
#pragma unroll
    for (int kk = 0; kk < 2; ++kk) qf[kk] = *(const bf16x8*)(U + (size_t)tq * NIN + colq + 32 * kk + 8 * q4);
    f32x4 s[9];
#pragma unroll
    for (int kt = 0; kt < 9; ++kt) { int kp = (nb - 1) * 128 + 16 * w + 16 * kt + l15; kp = kp < 0 ? 0 : kp;
        const bf16* kr = U + (size_t)(kp * dil + r) * NIN + colk + 8 * q4;
        f32x4 a = (f32x4){0.f, 0.f, 0.f, 0.f};
#pragma unroll
        for (int kk = 0; kk < 2; ++kk) a = MFMA16(*(const bf16x8*)(kr + 32 * kk), qf[kk], a);
        s[kt] = a; }
    float m = -1e30f;
#pragma unroll
    for (int kt = 0; kt < 9; ++kt)
#pragma unroll
        for (int j = 0; j < 4; ++j) { const int klr = 16 * kt + 4 * q4 + j, dist = l15 + 128 - klr;
            const bool ok = dist >= 0 && dist <= 128 && (nb > 0 || (16 * w + klr) >= 128);
            s[kt][j] = ok ? s[kt][j] : -1e30f; m = fmaxf(m, s[kt][j]); }
    m = fmaxf(m, __shfl_xor(m, 16)); m = fmaxf(m, __shfl_xor(m, 32));
    float l = 0.f;
#pragma unroll
    for (int kt = 0; kt < 9; ++kt)
#pragma unroll
        for (int j = 0; j < 4; ++j) { const float p = __expf(s[kt][j] - m); s[kt][j] = p; l += p; }
    l += __shfl_xor(l, 16); l += __shfl_xor(l, 32);
    f32x4 o[4];
#pragma unroll
    for (int dt = 0; dt < 4; ++dt) o[dt] = (f32x4){0.f, 0.f, 0.f, 0.f};
#pragma unroll
    for (int ks = 0; ks < 5; ++ks) {
        v4u pw; pw.x = pk2(s[2 * ks][0], s[2 * ks][1]); pw.y = pk2(s[2 * ks][2], s[2 * ks][3]);
        if (ks < 4) { pw.z = pk2(s[2 * ks + 1][0], s[2 * ks + 1][1]); pw.w = pk2(s[2 * ks + 1][2], s[2 * ks + 1][3]); } else { pw.z = 0u; pw.w = 0u; }
        const bf16x8 pf = __builtin_bit_cast(bf16x8, pw);
#pragma unroll
        for (int dt = 0; dt < 4; ++dt) { const LAS bf16* vp = VT + (16 * dt + l15) * VT_STRIDE + 16 * w + 32 * ks + 4 * q4;
            const v2u lo = *(const LAS v2u*)vp, hi = *(const LAS v2u*)(vp + 16);
            v4u vw; vw.x = lo.x; vw.y = lo.y; vw.z = hi.x; vw.w = hi.y;
            o[dt] = MFMA16(__builtin_bit_cast(bf16x8, vw), pf, o[dt]); } }
    const float inv = 1.0f / l;
    bf16* op = OG + ((size_t)g * MROWS + tq) * 512 + h * 64 + 4 * q4;
#pragma unroll
    for (int dt = 0; dt < 4; ++dt) { v2u wv; wv.x = pk2(o[dt][0] * inv, o[dt][1] * inv); wv.y = pk2(o[dt][2] * inv, o[dt][3] * inv); *(v2u*)(op + 16 * dt) = wv; }
    if (q4 == 0) LSE[((size_t)g * MROWS + tq) * 8 + h] = m + __logf(l);
}
constexpr int AK_STRIDE = 72, AV_STRIDE = 136, AK_SLOT = 128 * AK_STRIDE, AV_SLOT = 64 * AV_STRIDE;
__device__ __forceinline__ void attn_dil_run(ldsp lds, const bf16* U, bf16* OG, float* LSE, int g, int dil, int r, int nb0, int h, int tid) {
    const int lane = tid & 63, w = __builtin_amdgcn_readfirstlane(tid >> 6), l15 = lane & 15, q4 = lane >> 4;
    LAS bf16* KS = (LAS bf16*)lds; LAS bf16* VT = (LAS bf16*)(lds + 3 * AK_SLOT * 2);
    const int colq = C_AQ + g * 512 + h * 64, colk = C_AK + g * 512 + h * 64, colv = C_AV + g * 512 + h * 64;
    const int skey = tid >> 2, spart = tid & 3;
    v4u rk0, rk1, rv0, rv1; bf16x8 qn[2];
#define ADR_LOAD(nbx) do { const bf16* bp_ = U + (size_t)(((nbx) * 128 + skey) * dil + r) * NIN + 16 * spart; \
        rk0 = *(const v4u*)(bp_ + colk); rk1 = *(const v4u*)(bp_ + colk + 8); rv0 = *(const v4u*)(bp_ + colv); rv1 = *(const v4u*)(bp_ + colv + 8); } while (0)
#define ADR_STORE(slot) do { LAS bf16* kd_ = KS + (slot) * AK_SLOT + skey * AK_STRIDE + 16 * spart; *(LAS v4u*)kd_ = rk0; *(LAS v4u*)(kd_ + 8) = rk1; \
        LAS bf16* vd_ = VT + (slot) * AV_SLOT + (16 * spart) * AV_STRIDE + skey; const unsigned va_[8] = {rv0.x, rv0.y, rv0.z, rv0.w, rv1.x, rv1.y, rv1.z, rv1.w}; \
        _Pragma("unroll") for (int j_ = 0; j_ < 8; ++j_) { vd_[(2 * j_) * AV_STRIDE] = (bf16)(va_[j_] & 0xffffu); vd_[(2 * j_ + 1) * AV_STRIDE] = (bf16)(va_[j_] >> 16); } } while (0)
#define ADR_LOADQ(nbx) do { const bf16* qp_ = U + (size_t)(((nbx) * 128 + w * 16 + l15) * dil + r) * NIN + colq + 8 * q4; qn[0] = *(const bf16x8*)qp_; qn[1] = *(const bf16x8*)(qp_ + 32); } while (0)
    __syncthreads();
    if (nb0 > 0) ADR_LOAD(nb0 - 1); else { rk0 = (v4u){0u, 0u, 0u, 0u}; rk1 = rk0; rv0 = rk0; rv1 = rk0; }
    ADR_STORE((nb0 + 2) % 3);
    ADR_LOAD(nb0); ADR_STORE(nb0 % 3);
    ADR_LOADQ(nb0);
    __syncthreads();
#pragma unroll 1
    for (int i = 0; i < 4; ++i) { const int nb = nb0 + i, sp = (nb + 2) % 3, sc = nb % 3;
        const bf16x8 qf0 = qn[0], qf1 = qn[1];
        if (i < 3) { ADR_LOAD(nb + 1); ADR_LOADQ(nb + 1); }
        const int tq = (nb * 128 + w * 16 + l15) * dil + r;
        f32x4 s[9];
#pragma unroll
        for (int kt = 0; kt < 9; ++kt) { const int kidx0 = 16 * w + 16 * kt; const LAS bf16* kr = KS + ((kidx0 >= 128) ? sc : sp) * AK_SLOT + ((kidx0 & 127) + l15) * AK_STRIDE + 8 * q4;
            f32x4 a = (f32x4){0.f, 0.f, 0.f, 0.f};
            a = MFMA16(*(const LAS bf16x8*)kr, qf0, a); a = MFMA16(*(const LAS bf16x8*)(kr + 32), qf1, a);
            s[kt] = a; }
        float m = -1e30f;
#pragma unroll
        for (int kt = 0; kt < 9; ++kt)
#pragma unroll
            for (int j = 0; j < 4; ++j) { const int klr = 16 * kt + 4 * q4 + j, dist = l15 + 128 - klr;
                const bool ok = dist >= 0 && dist <= 128 && (nb > 0 || (16 * w + klr) >= 128);
                s[kt][j] = ok ? s[kt][j] : -1e30f; m = fmaxf(m, s[kt][j]); }
        m = fmaxf(m, __shfl_xor(m, 16)); m = fmaxf(m, __shfl_xor(m, 32));
        float l = 0.f;
#pragma unroll
        for (int kt = 0; kt < 9; ++kt)
#pragma unroll
            for (int j = 0; j < 4; ++j) { const float p = __expf(s[kt][j] - m); s[kt][j] = p; l += p; }
        l += __shfl_xor(l, 16); l += __shfl_xor(l, 32);
        f32x4 o[4];
#pragma unroll
        for (int dt = 0; dt < 4; ++dt) o[dt] = (f32x4){0.f, 0.f, 0.f, 0.f};
#pragma unroll
        for (int ks = 0; ks < 5; ++ks) {
            v4u pw; pw.x = pk2(s[2 * ks][0], s[2 * ks][1]); pw.y = pk2(s[2 * ks][2], s[2 * ks][3]);
            if (ks < 4) { pw.z = pk2(s[2 * ks + 1][0], s[2 * ks + 1][1]); pw.w = pk2(s[2 * ks + 1][2], s[2 * ks + 1][3]); } else { pw.z = 0u; pw.w = 0u; }
            const bf16x8 pf = __builtin_bit_cast(bf16x8, pw);
            const int ka = 16 * w + 32 * ks, kb = ka + 16;
            const LAS bf16* va = VT + (((ka >> 7) == 1) ? sc : sp) * AV_SLOT + (ka & 127) + 4 * q4 + l15 * AV_STRIDE;
            const LAS bf16* vb = VT + (((kb >> 7) == 1) ? sc : sp) * AV_SLOT + (kb & 127) + 4 * q4 + l15 * AV_STRIDE;
#pragma unroll
            for (int dt = 0; dt < 4; ++dt) { const v2u lo = *(const LAS v2u*)(va + 16 * dt * AV_STRIDE), hi = *(const LAS v2u*)(vb + 16 * dt * AV_STRIDE);
                v4u vw; vw.x = lo.x; vw.y = lo.y; vw.z = hi.x; vw.w = hi.y;
                o[dt] = MFMA16(__builtin_bit_cast(bf16x8, vw), pf, o[dt]); } }
        const float inv = 1.0f / l;
        bf16* op = OG + ((size_t)g * MROWS + tq) * 512 + h * 64 + 4 * q4;
#pragma unroll
        for (int dt = 0; dt < 4; ++dt) { v2u wv; wv.x = pk2(o[dt][0] * inv, o[dt][1] * inv); wv.y = pk2(o[dt][2] * inv, o[dt][3] * inv); *(v2u*)(op + 16 * dt) = wv; }
        if (q4 == 0) LSE[((size_t)g * MROWS + tq) * 8 + h] = m + __logf(l);
        if (i < 3) ADR_STORE((nb + 1) % 3);
        __syncthreads();
    }
#undef ADR_LOAD
#undef ADR_STORE
#undef ADR_LOADQ
}
constexpr int XK_STRIDE = 136;
__device__ __forceinline__ void xattn_unit(ldsp lds, const bf16* U, const bf16* MKV, bf16* YC, int cg, int h, int tid) {
    const int lane = tid & 63, w = __builtin_amdgcn_readfirstlane(tid >> 6), l15 = lane & 15, q4 = lane >> 4;
    LAS bf16* KS = (LAS bf16*)lds;
    LAS bf16* VT = (LAS bf16*)(lds + 256 * XK_STRIDE * 2);
    __syncthreads();
    { const int key = tid >> 1, hf = tid & 1; const bf16* kp = MKV + (size_t)key * 1024 + h * 128 + 64 * hf; v4u kv[8];
#pragma unroll
      for (int i = 0; i < 8; ++i) kv[i] = *(const v4u*)(kp + 8 * i);
#pragma unroll
      for (int i = 0; i < 8; ++i) *(LAS v4u*)(KS + key * XK_STRIDE + 64 * hf + 8 * i) = kv[i]; }
#pragma unroll
    for (int it = 0; it < 8; ++it) { const int key = (tid >> 4) + 32 * it, d8 = (tid & 15) * 8;
        const bf16x8 v = *(const bf16x8*)(MKV + (size_t)key * 1024 + 512 + h * 128 + d8);
#pragma unroll
        for (int j = 0; j < 8; ++j) VT[(d8 + j) * VT_STRIDE + key] = (bf16)v[j]; }
    __syncthreads();
#pragma unroll 1
    for (int qt = 0; qt < 2; ++qt) {
        const int row = (2 * cg + qt) * 128 + w * 16 + l15;
        int lofs = 8 * q4; asm volatile("" : "+v"(lofs));
        bf16x8 qf[4];
#pragma unroll
        for (int kk = 0; kk < 4; ++kk) qf[kk] = *(const bf16x8*)(U + (size_t)row * NIN + C_CQ + h * 128 + 32 * kk + 8 * q4);
        f32x4 s[16];
#pragma unroll
        for (int kt = 0; kt < 16; ++kt) { const LAS bf16* kr = KS + (16 * kt + l15) * XK_STRIDE + lofs;
            f32x4 a = (f32x4){0.f, 0.f, 0.f, 0.f};
#pragma unroll
            for (int kk = 0; kk < 4; ++kk) a = MFMA16(*(const LAS bf16x8*)(kr + 32 * kk), qf[kk], a);
            s[kt] = a * 0.08838834764831845f; }
        float m = -1e30f;
#pragma unroll
        for (int kt = 0; kt < 16; ++kt)
#pragma unroll
            for (int j = 0; j < 4; ++j) m = fmaxf(m, s[kt][j]);
        m = fmaxf(m, __shfl_xor(m, 16)); m = fmaxf(m, __shfl_xor(m, 32));
        float l = 0.f;
#pragma unroll
        for (int kt = 0; kt < 16; ++kt)
#pragma unroll
            for (int j = 0; j < 4; ++j) { const float p = __expf(s[kt][j] - m); s[kt][j] = p; l += p; }
        l += __shfl_xor(l, 16); l += __shfl_xor(l, 32);
        f32x4 o[8];
#pragma unroll
        for (int dt = 0; dt < 8; ++dt) o[dt] = (f32x4){0.f, 0.f, 0.f, 0.f};
#pragma unroll
        for (int ks = 0; ks < 8; ++ks) {
            v4u pw; pw.x = pk2(s[2 * ks][0], s[2 * ks][1]); pw.y = pk2(s[2 * ks][2], s[2 * ks][3]); pw.z = pk2(s[2 * ks + 1][0], s[2 * ks + 1][1]); pw.w = pk2(s[2 * ks + 1][2], s[2 * ks + 1][3]);
            const bf16x8 pf = __builtin_bit_cast(bf16x8, pw);
#pragma unroll
            for (int dt = 0; dt < 8; ++dt) { const LAS bf16* vp = VT + (16 * dt + l15) * VT_STRIDE + 32 * ks + (lofs >> 1);
                const v2u lo = *(const LAS v2u*)vp, hi = *(const LAS v2u*)(vp + 16);
                v4u vw; vw.x = lo.x; vw.y = lo.y; vw.z = hi.x; vw.w = hi.y;
                o[dt] = MFMA16(__builtin_bit_cast(bf16x8, vw), pf, o[dt]); } }
        const float inv = 1.0f / l;
        const bf16* zp = U + (size_t)row * NIN + C_CZ + h * 128 + 4 * q4; bf16* op = YC + (size_t)row * YPITCH + h * 128 + 4 * q4;
#pragma unroll
        for (int dt = 0; dt < 8; ++dt) { const v2u z = *(const v2u*)(zp + 16 * dt); v2u wv;
            wv.x = pk2(o[dt][0] * inv * blo(z.x), o[dt][1] * inv * bhi(z.x)); wv.y = pk2(o[dt][2] * inv * blo(z.y), o[dt][3] * inv * bhi(z.y)); *(v2u*)(op + 16 * dt) = wv; }
    }
}
__device__ __forceinline__ float lb_of(const float* lbl, int c) { return 1.0f / (1.0f + __expf(lbl[512 + c] - lbl[c])); }
__device__ __forceinline__ void hgrn_pass1_unit(ldsp lds, const bf16* U, const float* lbl, float* HU, float* HP, int h, int j, int tid) {
    LAS float* fb = (LAS float*)lds; LAS float* kb = fb + 32 * 128; LAS float* vb = kb + 32 * 128;
    const int v = tid & 127, kq = __builtin_amdgcn_readfirstlane(tid >> 7), tok = tid >> 4, c8 = (tid & 15) * 8;
    float s[32], lbr[8];
#pragma unroll
    for (int i = 0; i < 32; ++i) s[i] = 0.f;
#pragma unroll
    for (int e = 0; e < 8; ++e) lbr[e] = lb_of(lbl, h * 128 + c8 + e);
    float pacc = 1.f;
    for (int ch = 0; ch < 8; ++ch) {
        __syncthreads();
        { const size_t ro = (size_t)(j * 256 + ch * 32 + tok) * NIN + h * 128 + c8;
          const v4u fw = *(const v4u*)(U + ro + C_BF), vw = *(const v4u*)(U + ro + C_BI);
          const unsigned fa[4] = {fw.x, fw.y, fw.z, fw.w}, va[4] = {vw.x, vw.y, vw.z, vw.w};
#pragma unroll
          for (int e = 0; e < 4; ++e) { const float x0 = blo(fa[e]), x1 = bhi(fa[e]);
              const float f0 = lbr[2 * e] + (1.f - lbr[2 * e]) * sigmoid_f(x0), f1 = lbr[2 * e + 1] + (1.f - lbr[2 * e + 1]) * sigmoid_f(x1);
              const int o = tok * 128 + c8 + 2 * e;
              fb[o] = f0; fb[o + 1] = f1; kb[o] = 1.f - f0; kb[o + 1] = 1.f - f1; vb[o] = blo(va[e]); vb[o + 1] = bhi(va[e]); } }
        __syncthreads();
        for (int tt = 0; tt < 32; ++tt) { const float vv = vb[tt * 128 + v]; const LAS f32x4* f4 = (const LAS f32x4*)(fb + tt * 128 + kq * 32); const LAS f32x4* k4 = (const LAS f32x4*)(kb + tt * 128 + kq * 32);
#pragma unroll
            for (int i4 = 0; i4 < 8; ++i4) { const f32x4 f = f4[i4], k = k4[i4];
#pragma unroll
                for (int e = 0; e < 4; ++e) s[4 * i4 + e] = f[e] * s[4 * i4 + e] + k[e] * vv; } }
        if (tid < 128) { for (int tt = 0; tt < 32; ++tt) pacc *= fb[tt * 128 + tid]; }
    }
    float* up = HU + ((size_t)(j * 4 + h) * 128 + kq * 32) * 128 + v;
#pragma unroll
    for (int i = 0; i < 32; ++i) up[(size_t)i * 128] = s[i];
    if (tid < 128) HP[(size_t)(j * 4 + h) * 128 + tid] = pacc;
}
__device__ __forceinline__ void hgrn_scan_unit(const float* __restrict__ HU, const float* __restrict__ HP, float* __restrict__ HS, float* __restrict__ outS, int e, int tid) {
    if (tid >= 256) return;
    const int idx = e * 256 + tid, h = idx >> 14, k = (idx >> 7) & 127, vk = idx & 16383;
    float S = 0.f;
#pragma unroll 1
    for (int j0 = 0; j0 < 64; j0 += 16) { float hu[16], hp[16];
#pragma unroll
        for (int q = 0; q < 16; ++q) { hu[q] = HU[(size_t)((j0 + q) * 4 + h) * 16384 + vk]; hp[q] = HP[(size_t)((j0 + q) * 4 + h) * 128 + k]; }
#pragma unroll
        for (int q = 0; q < 16; ++q) { HS[(size_t)((j0 + q) * 4 + h) * 16384 + vk] = S; S = hp[q] * S + hu[q]; } }
    outS[idx] = S;
}
__device__ __forceinline__ void hgrn_pass3_unit(ldsp lds, const bf16* U, const float* lbl, const float* hgn, const float* HS, bf16* YB, int h, int j, int tid) {
    LAS float* fb = (LAS float*)lds; LAS float* kb = fb + 32 * 128; LAS float* vb = kb + 32 * 128; LAS float* qb = vb + 32 * 128; LAS float* ob = qb + 32 * 128;
    const int lane = tid & 63, wv = tid >> 6, v = tid & 127, kq = __builtin_amdgcn_readfirstlane(tid >> 7), tok = tid >> 4, c8 = (tid & 15) * 8;
    float s[32], lbr[8];
    { const float* sp = HS + ((size_t)(j * 4 + h) * 128 + kq * 32) * 128 + v;
#pragma unroll
      for (int i = 0; i < 32; ++i) s[i] = sp[(size_t)i * 128]; }
#pragma unroll
    for (int e = 0; e < 8; ++e) lbr[e] = lb_of(lbl, h * 128 + c8 + e);
    const float g0 = hgn[h * 128 + lane], g1 = hgn[h * 128 + 64 + lane];
    for (int ch = 0; ch < 8; ++ch) {
        __syncthreads();
        { const size_t ro = (size_t)(j * 256 + ch * 32 + tok) * NIN + h * 128 + c8;
          const v4u fw = *(const v4u*)(U + ro + C_BF), vw = *(const v4u*)(U + ro + C_BI), qw = *(const v4u*)(U + ro + C_BQ);
          const unsigned fa[4] = {fw.x, fw.y, fw.z, fw.w}, va[4] = {vw.x, vw.y, vw.z, vw.w}, qa[4] = {qw.x, qw.y, qw.z, qw.w};
#pragma unroll
          for (int e = 0; e < 4; ++e) { const float x0 = blo(fa[e]), x1 = bhi(fa[e]);
              const float f0 = lbr[2 * e] + (1.f - lbr[2 * e]) * sigmoid_f(x0), f1 = lbr[2 * e + 1] + (1.f - lbr[2 * e + 1]) * sigmoid_f(x1);
              const int o = tok * 128 + c8 + 2 * e;
              fb[o] = f0; fb[o + 1] = f1; kb[o] = 1.f - f0; kb[o + 1] = 1.f - f1; vb[o] = blo(va[e]); vb[o + 1] = bhi(va[e]); qb[o] = blo(qa[e]); qb[o + 1] = bhi(qa[e]); } }
        __syncthreads();
        for (int tt = 0; tt < 32; ++tt) { const float vv = vb[tt * 128 + v]; const LAS f32x4* f4 = (const LAS f32x4*)(fb + tt * 128 + kq * 32); const LAS f32x4* k4 = (const LAS f32x4*)(kb + tt * 128 + kq * 32); const LAS f32x4* q4p = (const LAS f32x4*)(qb + tt * 128 + kq * 32);
            float acc = 0.f;
#pragma unroll
            for (int i4 = 0; i4 < 8; ++i4) { const f32x4 f = f4[i4], k = k4[i4], q = q4p[i4];
#pragma unroll
                for (int e = 0; e < 4; ++e) { s[4 * i4 + e] = f[e] * s[4 * i4 + e] + k[e] * vv; acc += s[4 * i4 + e] * q[e]; } }
            ob[(tt * 4 + kq) * 128 + v] = acc; }
        __syncthreads();
#pragma unroll
        for (int q = 0; q < 4; ++q) { const int tt = wv * 4 + q; const LAS float* op = ob + tt * 512;
            const float o0 = (op[lane] + op[128 + lane]) + (op[256 + lane] + op[384 + lane]), o1 = (op[64 + lane] + op[192 + lane]) + (op[320 + lane] + op[448 + lane]);
            const float rstd = rsqrtf(wave_sum(o0 * o0 + o1 * o1) * (1.f / 128.f) + EPS);
            const size_t t = (size_t)(j * 256 + ch * 32 + tt);
            const bf16* zp = U + t * NIN + C_BZ + h * 128; bf16* yp = YB + t * YPITCH + h * 128;
            yp[lane] = (bf16)f2bf(o0 * rstd * g0 * b2f(zp[lane])); yp[64 + lane] = (bf16)f2bf(o1 * rstd * g1 * b2f(zp[64 + lane])); }
    }
}
constexpr int HG_QT_STRIDE = 136, HG_KH_STRIDE = 40, HG_BUF = 38400;
template <bool OUT>
__device__ __forceinline__ void hgrn_mfma_unit(ldsp lds, const bf16* U, const float* lbl, const float* hgn, const float* HS, float* HU, float* HP, bf16* YB, int h, int j, int tid) {
    const int lane = tid & 63, w = __builtin_amdgcn_readfirstlane(tid >> 6), l15 = lane & 15, q4 = lane >> 4;
    const int k = 16 * w + l15, tq = q4;
    LAS float* SSQ = (LAS float*)(lds + 2 * HG_BUF);
    const float lb = lb_of(lbl, h * 128 + k), oml = 1.f - lb;
    f32x4 S[8];
    if (OUT) { const float* sp = HS + (size_t)(j * 4 + h) * 16384 + (size_t)(4 * q4) * 128 + 16 * w + l15;
#pragma unroll
        for (int kt = 0; kt < 8; ++kt)
#pragma unroll
            for (int r = 0; r < 4; ++r) S[kt][r] = sp[(size_t)(16 * kt + r) * 128]; }
    else {
#pragma unroll
        for (int kt = 0; kt < 8; ++kt) S[kt] = (f32x4){0.f, 0.f, 0.f, 0.f}; }
    float ptot = 0.f;
    bf16 rq[8], rf[8], rv[8];
    const bf16* ub = U + (size_t)(j * 256 + 8 * tq) * NIN + h * 128 + k;
#pragma unroll
    for (int i = 0; i < 8; ++i) { rf[i] = ub[(size_t)i * NIN + C_BF]; rv[i] = ub[(size_t)i * NIN + C_BI]; rq[i] = OUT ? ub[(size_t)i * NIN + C_BQ] : (bf16)0; }
    f32x4 op[2] = {(f32x4){0.f, 0.f, 0.f, 0.f}, (f32x4){0.f, 0.f, 0.f, 0.f}};
    __syncthreads();
    for (int ch = 0; ch < 8; ++ch) {
        ldsp ib = lds + (ch & 1) * HG_BUF;
        LAS bf16* QT = (LAS bf16*)ib; LAS bf16* KT = (LAS bf16*)(ib + 8704); LAS bf16* KH = (LAS bf16*)(ib + 17408); LAS bf16* VT = (LAS bf16*)(ib + 27648); LAS float* DC = (LAS float*)(ib + 37888);
        float kin[8], cum[8]; float c = 0.f;
#pragma unroll
        for (int i = 0; i < 8; ++i) { const float f = lb + oml * sigmoid_f(b2f(rf[i])); kin[i] = 1.f - f; c += __logf(f); cum[i] = c; }
        const float t0 = __shfl(c, l15), t1 = __shfl(c, 16 + l15), t2 = __shfl(c, 32 + l15), t3 = __shfl(c, 48 + l15);
        const float pre = (tq > 0 ? t0 : 0.f) + (tq > 1 ? t1 : 0.f) + (tq > 2 ? t2 : 0.f), tot = (t0 + t1) + (t2 + t3);
        { unsigned khw[4], vtw[4];
#pragma unroll
          for (int i2 = 0; i2 < 4; ++i2) { float kh2[2];
#pragma unroll
              for (int e = 0; e < 2; ++e) { const int i = 2 * i2 + e, t = 8 * tq + i; const float b = pre + cum[i];
                  if (OUT) { QT[t * HG_QT_STRIDE + k] = (bf16)f2bf(b2f(rq[i]) * __expf(b)); KT[t * HG_QT_STRIDE + k] = (bf16)f2bf(kin[i] * __expf(fminf(-b, 80.f))); }
                  kh2[e] = kin[i] * __expf(tot - b); }
              khw[i2] = pk2(kh2[0], kh2[1]); vtw[i2] = (unsigned)rv[2 * i2] | ((unsigned)rv[2 * i2 + 1] << 16); }
          v4u a; a.x = khw[0]; a.y = khw[1]; a.z = khw[2]; a.w = khw[3]; *(LAS v4u*)(KH + k * HG_KH_STRIDE + 8 * tq) = a;
          v4u b; b.x = vtw[0]; b.y = vtw[1]; b.z = vtw[2]; b.w = vtw[3]; *(LAS v4u*)(VT + k * HG_KH_STRIDE + 8 * tq) = b; }
        if (tq == 0) { DC[k] = __expf(tot); ptot += tot; }
        __syncthreads();
        if (ch < 7) { const bf16* un = ub + (size_t)((ch + 1) * 32) * NIN;
#pragma unroll
            for (int i = 0; i < 8; ++i) { rf[i] = un[(size_t)i * NIN + C_BF]; rv[i] = un[(size_t)i * NIN + C_BI]; if (OUT) rq[i] = un[(size_t)i * NIN + C_BQ]; } }
        if (OUT && ch > 0) {
            const LAS float* sq = SSQ + ((ch - 1) & 1) * 256; const f32x4 g4 = *(const f32x4*)(hgn + h * 128 + 16 * w + 4 * q4);
#pragma unroll
            for (int tt = 0; tt < 2; ++tt) { float ss = 0.f;
#pragma unroll
                for (int q = 0; q < 8; ++q) ss += sq[q * 32 + 16 * tt + l15];
                const float rstd = rsqrtf(ss * (1.f / 128.f) + EPS);
                const size_t t = (size_t)(j * 256 + (ch - 1) * 32 + 16 * tt + l15);
                const v2u z = *(const v2u*)(U + t * NIN + C_BZ + h * 128 + 16 * w + 4 * q4); v2u y;
                y.x = pk2(op[tt][0] * rstd * g4[0] * blo(z.x), op[tt][1] * rstd * g4[1] * bhi(z.x)); y.y = pk2(op[tt][2] * rstd * g4[2] * blo(z.y), op[tt][3] * rstd * g4[3] * bhi(z.y));
                *(v2u*)(YB + t * YPITCH + h * 128 + 16 * w + 4 * q4) = y; } }
        const bf16x8 vnat = *(const LAS bf16x8*)(VT + (16 * w + l15) * HG_KH_STRIDE + 8 * q4);
        if (OUT) {
            f32x4 a00 = (f32x4){0.f, 0.f, 0.f, 0.f}, a01 = a00, a11 = a00;
#pragma unroll
            for (int kk = 0; kk < 4; ++kk) { const bf16x8 k0 = *(const LAS bf16x8*)(KT + l15 * HG_QT_STRIDE + 32 * kk + 8 * q4), k1 = *(const LAS bf16x8*)(KT + (16 + l15) * HG_QT_STRIDE + 32 * kk + 8 * q4);
                const bf16x8 u0 = *(const LAS bf16x8*)(QT + l15 * HG_QT_STRIDE + 32 * kk + 8 * q4), u1 = *(const LAS bf16x8*)(QT + (16 + l15) * HG_QT_STRIDE + 32 * kk + 8 * q4);
                a00 = MFMA16(k0, u0, a00); a01 = MFMA16(k0, u1, a01); a11 = MFMA16(k1, u1, a11); }
#pragma unroll
            for (int r = 0; r < 4; ++r) { const bool ok = (4 * q4 + r) <= l15; a00[r] = ok ? a00[r] : 0.f; a11[r] = ok ? a11[r] : 0.f; }
            v4u p0, p1; p0.x = pk2(a00[0], a00[1]); p0.y = pk2(a00[2], a00[3]); p0.z = 0u; p0.w = 0u;
            p1.x = pk2(a01[0], a01[1]); p1.y = pk2(a01[2], a01[3]); p1.z = pk2(a11[0], a11[1]); p1.w = pk2(a11[2], a11[3]);
            const LAS bf16* vp = VT + (16 * w + l15) * HG_KH_STRIDE + 4 * q4; const v2u vlo = *(const LAS v2u*)vp, vhi = *(const LAS v2u*)(vp + 16);
            v4u vw; vw.x = vlo.x; vw.y = vlo.y; vw.z = vhi.x; vw.w = vhi.y; const bf16x8 vperm = __builtin_bit_cast(bf16x8, vw);
            f32x4 o[2];
            o[0] = MFMA16(vperm, __builtin_bit_cast(bf16x8, p0), ((f32x4){0.f, 0.f, 0.f, 0.f}));
            o[1] = MFMA16(vperm, __builtin_bit_cast(bf16x8, p1), ((f32x4){0.f, 0.f, 0.f, 0.f}));
#pragma unroll
            for (int kk = 0; kk < 4; ++kk) { v4u sw; sw.x = pk2(S[2 * kk][0], S[2 * kk][1]); sw.y = pk2(S[2 * kk][2], S[2 * kk][3]); sw.z = pk2(S[2 * kk + 1][0], S[2 * kk + 1][1]); sw.w = pk2(S[2 * kk + 1][2], S[2 * kk + 1][3]);
                const bf16x8 sf = __builtin_bit_cast(bf16x8, sw);
#pragma unroll
                for (int tt = 0; tt < 2; ++tt) { const LAS bf16* qp = QT + (16 * tt + l15) * HG_QT_STRIDE + 32 * kk + 4 * q4; const v2u qlo = *(const LAS v2u*)qp, qhi = *(const LAS v2u*)(qp + 16);
                    v4u qw; qw.x = qlo.x; qw.y = qlo.y; qw.z = qhi.x; qw.w = qhi.y; o[tt] = MFMA16(sf, __builtin_bit_cast(bf16x8, qw), o[tt]); } }
            LAS float* sq = SSQ + (ch & 1) * 256;
#pragma unroll
            for (int tt = 0; tt < 2; ++tt) { float p = (o[tt][0] * o[tt][0] + o[tt][1] * o[tt][1]) + (o[tt][2] * o[tt][2] + o[tt][3] * o[tt][3]); p += __shfl_xor(p, 16); p += __shfl_xor(p, 32); if (q4 == 0) sq[w * 32 + 16 * tt + l15] = p; op[tt] = o[tt]; }
        }
#pragma unroll
        for (int kt = 0; kt < 8; ++kt) { const f32x4 d = *(const LAS f32x4*)(DC + 16 * kt + 4 * q4); const bf16x8 kf = *(const LAS bf16x8*)(KH + (16 * kt + l15) * HG_KH_STRIDE + 8 * q4);
            S[kt] = MFMA16(kf, vnat, S[kt] * d); }
    }
    if (OUT) {
        __syncthreads();
        const LAS float* sq = SSQ + 256; const f32x4 g4 = *(const f32x4*)(hgn + h * 128 + 16 * w + 4 * q4);
#pragma unroll
        for (int tt = 0; tt < 2; ++tt) { float ss = 0.f;
#pragma unroll
            for (int q = 0; q < 8; ++q) ss += sq[q * 32 + 16 * tt + l15];
            const float rstd = rsqrtf(ss * (1.f / 128.f) + EPS);
            const size_t t = (size_t)(j * 256 + 7 * 32 + 16 * tt + l15);
            const v2u z = *(const v2u*)(U + t * NIN + C_BZ + h * 128 + 16 * w + 4 * q4); v2u y;
            y.x = pk2(op[tt][0] * rstd * g4[0] * blo(z.x), op[tt][1] * rstd * g4[1] * bhi(z.x)); y.y = pk2(op[tt][2] * rstd * g4[2] * blo(z.y), op[tt][3] * rstd * g4[3] * bhi(z.y));
            *(v2u*)(YB + t * YPITCH + h * 128 + 16 * w + 4 * q4) = y; }
    }
    if (!OUT) { float* up = HU + (size_t)(j * 4 + h) * 16384 + (size_t)(4 * q4) * 128 + 16 * w + l15;
#pragma unroll
        for (int kt = 0; kt < 8; ++kt)
#pragma unroll
            for (int r = 0; r < 4; ++r) up[(size_t)(16 * kt + r) * 128] = S[kt][r];
        if (tq == 0) HP[(size_t)(j * 4 + h) * 128 + k] = __expf(ptot); }
}
__device__ __forceinline__ void attn_merge_row(const bf16* U, const bf16* OG, const float* LSE, bf16* YA, int t, int lane) {
    const int hd = lane >> 3, c8 = lane * 8;
    const float l0 = LSE[((size_t)0 * MROWS + t) * 8 + hd], l1 = LSE[((size_t)1 * MROWS + t) * 8 + hd], l2 = LSE[((size_t)2 * MROWS + t) * 8 + hd];
    const float mx = fmaxf(l0, fmaxf(l1, l2)); float w0 = __expf(l0 - mx), w1 = __expf(l1 - mx), w2 = __expf(l2 - mx); const float inv = 1.f / (w0 + w1 + w2); w0 *= inv; w1 *= inv; w2 *= inv;
    const v4u a = *(const v4u*)(OG + ((size_t)0 * MROWS + t) * 512 + c8), b = *(const v4u*)(OG + ((size_t)1 * MROWS + t) * 512 + c8), c = *(const v4u*)(OG + ((size_t)2 * MROWS + t) * 512 + c8);
    const v4u z = *(const v4u*)(U + (size_t)t * NIN + C_AZ + c8);
    const unsigned aa[4] = {a.x, a.y, a.z, a.w}, ba[4] = {b.x, b.y, b.z, b.w}, ca[4] = {c.x, c.y, c.z, c.w}, za[4] = {z.x, z.y, z.z, z.w}; unsigned oa[4];
#pragma unroll
    for (int e = 0; e < 4; ++e) oa[e] = pk2((w0 * blo(aa[e]) + w1 * blo(ba[e]) + w2 * blo(ca[e])) * blo(za[e]), (w0 * bhi(aa[e]) + w1 * bhi(ba[e]) + w2 * bhi(ca[e])) * bhi(za[e]));
    v4u o; o.x = oa[0]; o.y = oa[1]; o.z = oa[2]; o.w = oa[3]; *(v4u*)(YA + (size_t)t * YPITCH + c8) = o;
}
__device__ __forceinline__ void samp_attn_unit(ldsp lds, const Args& A, const bf16* U, bf16* YA, int b, int hh, int tid) {
    LAS float* xch = (LAS float*)lds;
    const int lane = tid & 63, w = tid >> 6, h = 4 * hh + (w >> 1), kh = w & 1, ks = lane >> 4, dp = lane & 15; const size_t row = T_SEQ + b; const bf16* ur = U + row * NIN;
    float m = -1e30f, l = 0.f; f32x4 acc = (f32x4){0.f, 0.f, 0.f, 0.f};
#pragma unroll
    for (int g = 0; g < 3; ++g) { const int dil = (g == 0) ? 1 : (g == 1 ? 4 : 16), Wb = 128 * dil; const float* cache = ((g == 0) ? A.c128 : (g == 1 ? A.c512 : A.c2048)) + (size_t)b * Wb * 1024 + h * 64 + 4 * dp;
        const v2u qw = *(const v2u*)(ur + C_AQ + g * 512 + h * 64 + 4 * dp); const f32x4 q = (f32x4){blo(qw.x), bhi(qw.x), blo(qw.y), bhi(qw.y)};
        if (ks == 0 && kh == 0) { const v2u kw = *(const v2u*)(ur + C_AK + g * 512 + h * 64 + 4 * dp), vw = *(const v2u*)(ur + C_AV + g * 512 + h * 64 + 4 * dp);
            float sc = q[0] * blo(kw.x) + q[1] * bhi(kw.x) + q[2] * blo(kw.y) + q[3] * bhi(kw.y);
            sc += __shfl_xor(sc, 1); sc += __shfl_xor(sc, 2); sc += __shfl_xor(sc, 4); sc += __shfl_xor(sc, 8);
            const float mn = fmaxf(m, sc), corr = __expf(m - mn), pe = __expf(sc - mn); l = l * corr + pe;
            acc = acc * corr + pe * (f32x4){blo(vw.x), bhi(vw.x), blo(vw.y), bhi(vw.y)}; m = mn; }
#pragma unroll 8
        for (int it = 0; it < 16; ++it) { const int jj = 1 + ks + 4 * (16 * kh + it), idx = Wb - dil * jj; const float* kp = cache + (size_t)idx * 1024;
            const f32x4 k4 = *(const f32x4*)kp, v4 = *(const f32x4*)(kp + 512);
            float sc = (q[0] * k4[0] + q[1] * k4[1]) + (q[2] * k4[2] + q[3] * k4[3]);
            sc += __shfl_xor(sc, 1); sc += __shfl_xor(sc, 2); sc += __shfl_xor(sc, 4); sc += __shfl_xor(sc, 8);
            const float mn = fmaxf(m, sc), corr = __expf(m - mn), pe = __expf(sc - mn); l = l * corr + pe; acc = acc * corr + pe * v4; m = mn; } }
    float ma = fmaxf(m, __shfl_xor(m, 16)); ma = fmaxf(ma, __shfl_xor(ma, 32));
    { const float sc = __expf(m - ma); l *= sc; acc = acc * sc; }
    l += __shfl_xor(l, 16); l += __shfl_xor(l, 32);
#pragma unroll
    for (int e = 0; e < 4; ++e) { acc[e] += __shfl_xor(acc[e], 16); acc[e] += __shfl_xor(acc[e], 32); }
    __syncthreads();
    if (kh == 1 && ks == 0) { LAS float* x = xch + ((w >> 1) * 16 + dp) * 6; x[0] = acc[0]; x[1] = acc[1]; x[2] = acc[2]; x[3] = acc[3]; x[4] = ma; x[5] = l; }
    __syncthreads();
    if (kh == 0 && ks == 0) { const LAS float* x = xch + ((w >> 1) * 16 + dp) * 6; const float mb = x[4], M = fmaxf(ma, mb), ea = __expf(ma - M), eb = __expf(mb - M);
        const float inv = 1.f / (l * ea + x[5] * eb); const v2u z = *(const v2u*)(ur + C_AZ + h * 64 + 4 * dp); v2u o;
        o.x = pk2((acc[0] * ea + x[0] * eb) * inv * blo(z.x), (acc[1] * ea + x[1] * eb) * inv * bhi(z.x)); o.y = pk2((acc[2] * ea + x[2] * eb) * inv * blo(z.y), (acc[3] * ea + x[3] * eb) * inv * bhi(z.y));
        *(v2u*)(YA + row * YPITCH + h * 64 + 4 * dp) = o; }
}
__device__ __forceinline__ void samp_hgrn_unit(ldsp lds, const Args& A, const bf16* U, bf16* YB, int b, int h, int tid) {
    LAS float* fb = (LAS float*)lds; LAS float* kb = fb + 128; LAS float* qb = kb + 128; LAS float* red = qb + 128;
    const size_t row = T_SEQ + b; const bf16* ur = U + row * NIN;
    __syncthreads();
    if (tid < 128) { const float lb = lb_of(A.lbl, h * 128 + tid), f = lb + (1.f - lb) * sigmoid_f(b2f(ur[C_BF + h * 128 + tid])); fb[tid] = f; kb[tid] = 1.f - f; qb[tid] = b2f(ur[C_BQ + h * 128 + tid]); }
    __syncthreads();
    const int v4i = (tid & 31) * 4, kk = tid >> 5;
    const v2u vw = *(const v2u*)(ur + C_BI + h * 128 + v4i); const f32x4 vv = (f32x4){blo(vw.x), bhi(vw.x), blo(vw.y), bhi(vw.y)};
    const float* sp = A.sth + (size_t)(b * 4 + h) * 16384; float* dp = A.out + O_HGS + (size_t)(b * 4 + h) * 16384;
    f32x4 oacc = (f32x4){0.f, 0.f, 0.f, 0.f};
#pragma unroll
    for (int p = 0; p < 8; ++p) { const int k = kk + 16 * p; const f32x4 S = *(const f32x4*)(sp + k * 128 + v4i); const f32x4 Sn = fb[k] * S + kb[k] * vv; *(f32x4*)(dp + k * 128 + v4i) = Sn; oacc += Sn * qb[k]; }
    *(LAS f32x4*)(red + kk * 128 + v4i) = oacc;
    __syncthreads();
    if (tid < 64) { float o0 = 0.f, o1 = 0.f;
#pragma unroll
        for (int q = 0; q < 16; ++q) { o0 += red[q * 128 + tid]; o1 += red[q * 128 + 64 + tid]; }
        const float rstd = rsqrtf(wave_sum(o0 * o0 + o1 * o1) * (1.f / 128.f) + EPS);
        bf16* yp = YB + row * YPITCH + h * 128;
        yp[tid] = (bf16)f2bf(o0 * rstd * A.hgn[h * 128 + tid] * b2f(ur[C_BZ + h * 128 + tid])); yp[64 + tid] = (bf16)f2bf(o1 * rstd * A.hgn[h * 128 + 64 + tid] * b2f(ur[C_BZ + h * 128 + 64 + tid])); }
}
__device__ __forceinline__ void samp_xattn_unit(ldsp lds, const Args& A, const bf16* U, bf16* YC, int b, int h, int tid) {
    LAS float* part = (LAS float*)lds;
    const int lane = tid & 63, w = tid >> 6, sub = lane >> 5, dp = lane & 31; const size_t row = T_SEQ + b; const bf16* ur = U + row * NIN;
    const v2u qw = *(const v2u*)(ur + C_CQ + h * 128 + 4 * dp); const f32x4 q = (f32x4){blo(qw.x), bhi(qw.x), blo(qw.y), bhi(qw.y)} * 0.08838834764831845f;
    const float* mem = A.cmem + (size_t)b * 256 * 1024 + h * 128 + 4 * dp;
    float m = -1e30f, l = 0.f; f32x4 acc = (f32x4){0.f, 0.f, 0.f, 0.f};
#pragma unroll 8
    for (int it = 0; it < 16; ++it) { const float* kp = mem + (size_t)(32 * w + 2 * it + sub) * 1024; const f32x4 k4 = *(const f32x4*)kp, v4 = *(const f32x4*)(kp + 512);
        float sc = (q[0] * k4[0] + q[1] * k4[1]) + (q[2] * k4[2] + q[3] * k4[3]);
        sc += __shfl_xor(sc, 1); sc += __shfl_xor(sc, 2); sc += __shfl_xor(sc, 4); sc += __shfl_xor(sc, 8); sc += __shfl_xor(sc, 16);
        const float mn = fmaxf(m, sc), corr = __expf(m - mn), pe = __expf(sc - mn); l = l * corr + pe; acc = acc * corr + pe * v4; m = mn; }
    const float ma = fmaxf(m, __shfl_xor(m, 32)); const float sc = __expf(m - ma); l *= sc; acc = acc * sc; l += __shfl_xor(l, 32);
#pragma unroll
    for (int e = 0; e < 4; ++e) acc[e] += __shfl_xor(acc[e], 32);
    __syncthreads();
    if (sub == 0) { *(LAS f32x4*)(part + w * 132 + 4 * dp) = acc; if (dp == 0) { part[w * 132 + 128] = ma; part[w * 132 + 129] = l; } }
    __syncthreads();
    if (tid < 128) { float M = -1e30f;
#pragma unroll
        for (int q8 = 0; q8 < 8; ++q8) M = fmaxf(M, part[q8 * 132 + 128]);
        float L = 0.f, O = 0.f;
#pragma unroll
        for (int q8 = 0; q8 < 8; ++q8) { const float e = __expf(part[q8 * 132 + 128] - M); L += part[q8 * 132 + 129] * e; O += part[q8 * 132 + tid] * e; }
        YC[row * YPITCH + h * 128 + tid] = (bf16)f2bf(O / L * b2f(ur[C_CZ + h * 128 + tid])); }
}
template <int NKS>
__device__ __forceinline__ void small_tile(f32x4 (&acc)[4], const bf16* A, int lda, const bf16* Bt, int ldb, int r0, int n0, int k0, int lane) {
    const int l15 = lane & 15, q4 = lane >> 4;
    const bf16* ap = A + (size_t)(r0 + l15) * lda + k0 + 8 * q4; const bf16* bp = Bt + (size_t)(n0 + l15) * ldb + k0 + 8 * q4;
#pragma unroll
    for (int ct = 0; ct < 4; ++ct) acc[ct] = (f32x4){0.f, 0.f, 0.f, 0.f};
#pragma unroll
    for (int ks = 0; ks < NKS; ++ks) { const bf16x8 a = *(const bf16x8*)(ap + 32 * ks);
#pragma unroll
        for (int ct = 0; ct < 4; ++ct) acc[ct] = MFMA16(a, *(const bf16x8*)(bp + (size_t)(16 * ct) * ldb + 32 * ks), acc[ct]); }
}
__device__ __forceinline__ void samp_branch_unit(ldsp lds, const bf16* U, const bf16* Y, const bf16* WPT, bf16* MG, int rt, int cg, int tid) {
    LAS float* part = (LAS float*)lds;
    const int lane = tid & 63, w = __builtin_amdgcn_readfirstlane(tid >> 6), l15 = lane & 15, q4 = lane >> 4, r0 = T_SEQ + 16 * rt, n0 = 64 * cg;
    __syncthreads();
    if (w < 6) { f32x4 acc[4]; small_tile<8>(acc, Y, YPITCH, WPT, 1536, r0, n0, (w >> 1) * 512 + (w & 1) * 256, lane);
#pragma unroll
        for (int ct = 0; ct < 4; ++ct)
#pragma unroll
            for (int r = 0; r < 4; ++r) part[(w * 16 + 4 * q4 + r) * 64 + 16 * ct + l15] = acc[ct][r]; }
    __syncthreads();
    { const int e = tid * 2, row = e >> 6, col = e & 63; const bf16* gp = U + (size_t)(r0 + row) * NIN + C_GA + n0 + col; float m0 = 0.f, m1 = 0.f;
#pragma unroll
      for (int br = 0; br < 3; ++br) { const unsigned gw = *(const unsigned*)(gp + br * 1024); const LAS float* p0 = part + ((2 * br) * 16 + row) * 64 + col; const LAS float* p1 = p0 + 16 * 64;
          m0 += blo(gw) * (p0[0] + p1[0]); m1 += bhi(gw) * (p0[1] + p1[1]); }
      *(unsigned*)(MG + (size_t)(r0 + row) * 1024 + n0 + col) = pk2(m0, m1); }
}
__device__ __forceinline__ void samp_out_unit(ldsp lds, const bf16* MG, const bf16* WOT, float* Z, int rt, int cg, int tid) {
    LAS float* part = (LAS float*)lds;
    const int lane = tid & 63, w = __builtin_amdgcn_readfirstlane(tid >> 6), l15 = lane & 15, q4 = lane >> 4, r0 = T_SEQ + 16 * rt, n0 = 64 * cg;
    __syncthreads();
    { f32x4 acc[4]; small_tile<4>(acc, MG, 1024, WOT, 1024, r0, n0, 128 * w, lane);
#pragma unroll
      for (int ct = 0; ct < 4; ++ct)
#pragma unroll
          for (int r = 0; r < 4; ++r) part[(w * 16 + 4 * q4 + r) * 64 + 16 * ct + l15] = acc[ct][r]; }
    __syncthreads();
    { const int e = tid * 2, row = e >> 6, col = e & 63; float z0 = 0.f, z1 = 0.f;
#pragma unroll
      for (int q = 0; q < 8; ++q) { const LAS float* p = part + (q * 16 + row) * 64 + col; z0 += p[0]; z1 += p[1]; }
      *(float2*)(Z + (size_t)(r0 + row) * 1024 + n0 + col) = make_float2(z0, z1); }
}
__device__ __forceinline__ void final_row(const float* z, const float* hrow, const float* g, float* yrow, int lane) {
    const f32x4* zr = (const f32x4*)z + lane; const f32x4* hr = (const f32x4*)hrow + lane; const f32x4* gr = (const f32x4*)g + lane; f32x4* yr = (f32x4*)yrow + lane;
    f32x4 v[4]; float s = 0.f;
#pragma unroll
    for (int j = 0; j < 4; ++j) { v[j] = zr[64 * j]; s += (v[j].x * v[j].x + v[j].y * v[j].y) + (v[j].z * v[j].z + v[j].w * v[j].w); }
    const float rstd = rsqrtf(wave_sum(s) * (1.f / 1024.f) + EPS);
#pragma unroll
    for (int j = 0; j < 4; ++j) yr[64 * j] = hr[64 * j] + v[j] * rstd * gr[64 * j];
}
__global__ void __launch_bounds__(512, 2) fwd_kernel(Args A) {
    extern __shared__ __attribute__((aligned(16))) unsigned char lds_raw[];
    ldsp lds = (ldsp)lds_raw;
    volatile LAS unsigned* MISC = (volatile LAS unsigned*)(lds + MISC_OFF);
    int tid = threadIdx.x; const int G = gridDim.x, bid = blockIdx.x;
#define NEWTID() do { tid = threadIdx.x; asm volatile("" : "+v"(tid)); } while (0)
    for (int u = tid; u < (LDS_BYTES - LDSCTL_OFF) / 4; u += 512) ((LAS unsigned*)(lds + LDSCTL_OFF))[u] = 0u;
    __syncthreads();
    unsigned char* ws = A.ws;
    unsigned* ctl = (unsigned*)(ws + WS_CTL);
    XcdBarrier bar = xcd_barrier_post(ctl + CW_BAR, MISC + 8);
    bf16* U = (bf16*)(ws + WS_U); bf16* MKV = (bf16*)(ws + WS_MEMKV);
    bf16* YA = (bf16*)(ws + WS_YA); bf16* YB = YA + 512; bf16* YC = YA + 1024;
    bf16* OG = (bf16*)(ws + WS_OG); float* LSE = (float*)(ws + WS_LSE);
    float* HU = (float*)(ws + WS_HU); float* HP = (float*)(ws + WS_HP); float* HS = (float*)(ws + WS_HS);

    NEWTID();
    p0_prologue(A, lds, tid, G);
    xcd_barrier(bar);

    { pg8::Gemm g{(const pg8::bf16_t*)(ws + WS_MN), (const pg8::bf16_t*)(ws + WS_WMEM), 256, 1024, 1024}; pg8::StaticOrder S; S.init(256, 1024, G, (bid + 4) % G);
      pg8::EpiMem E{A.out + O_MEMKV, (pg8::bf16_t*)MKV};
      pg8::gemm_phase<pg8::EpiMem, pg8::StaticOrder, false, PG8_SP2>(lds, g, S, E); }
    __syncthreads();
    { pg8::Gemm g{(const pg8::bf16_t*)(ws + WS_XN), (const pg8::bf16_t*)(ws + WS_WIN), MROWS, NIN, 1024}; pg8::StaticOrder S; S.init(MROWS, NIN, G, bid);
      pg8::EpiU E{(pg8::bf16_t*)U, (const float*)(ws + WS_CS), A.out, (pg8::bf16_t*)(ws + WS_GT)};
      pg8::gemm_phase<pg8::EpiU, pg8::StaticOrder, PG8_ALIGN, PG8_SP2>(lds, g, S, E); }
    xcd_barrier(bar);

    NEWTID();
    for (int u = bid; u < 256; u += G) samp_attn_unit(lds, A, U, YA, u >> 1, u & 1, tid);
    NEWTID();
    for (int u = bid; u < 512; u += G) samp_xattn_unit(lds, A, U, YC, u >> 2, u & 3, tid);
    NEWTID();
    for (int u = bid; u < 512; u += G) samp_hgrn_unit(lds, A, U, YB, u >> 2, u & 3, tid);
    NEWTID();
    for (int u = bid; u < 256; u += G) hgrn_mfma_unit<false>(lds, U, A.lbl, A.hgn, HS, HU, HP, YB, u & 3, u >> 2, tid);
    NEWTID();
    for (int u = bid; u < 768; u += G) { const int g = u >> 8, rem = u & 255, h = rem & 7, x = rem >> 3, dil = (g == 0) ? 1 : (g == 1 ? 4 : 16);
        const int r = (g == 0) ? 0 : (g == 1 ? (x >> 3) : (x >> 1)), nb0 = 4 * ((g == 0) ? x : (g == 1 ? (x & 7) : (x & 1)));
        attn_dil_run(lds, U, OG, LSE, g, dil, r, nb0, h, tid); }
    NEWTID();
    for (int u = bid; u < 256; u += G) xattn_unit(lds, U, MKV, YC, u >> 2, u & 3, tid);
    xcd_barrier(bar);

    NEWTID();
    for (int u = bid - 128; u >= 0 && u < 128; u += G) samp_branch_unit(lds, U, YA, (const bf16*)(ws + WS_WPA), (bf16*)(ws + WS_MG), u >> 4, u & 15, tid);
    NEWTID();
    for (int u = bid; u < 256; u += G) hgrn_scan_unit(HU, HP, HS, A.out + O_HGP, u, tid);
    NEWTID();
    for (int t = bid * 8 + (tid >> 6); t < T_SEQ; t += G * 8) attn_merge_row(U, OG, LSE, YA, t, tid & 63);
    xcd_barrier(bar);

    NEWTID();
    for (int u = bid; u < 256; u += G) hgrn_mfma_unit<true>(lds, U, A.lbl, A.hgn, HS, HU, HP, YB, u & 3, u >> 2, tid);
    NEWTID();
    for (int u = bid - 128; u >= 0 && u < 128; u += G) samp_out_unit(lds, (const bf16*)(ws + WS_MG), (const bf16*)(ws + WS_WOUT), (float*)(ws + WS_Z), u >> 4, u & 15, tid);
    xcd_barrier(bar);

    { pg8::Gemm g{(const pg8::bf16_t*)YA, (const pg8::bf16_t*)(ws + WS_WPA), T_SEQ, 1024, 1536}; pg8::StaticOrder S; S.init(T_SEQ, 1024, G, bid);
      pg8::EpiMerged E{(const pg8::bf16_t*)(ws + WS_GT), (pg8::bf16_t*)(ws + WS_MG)};
      pg8::gemm_phase<pg8::EpiMerged, pg8::StaticOrder, PG8_ALIGN, PG8_SP2>(lds, g, S, E); }
    xcd_barrier(bar);

    { pg8::Gemm g{(const pg8::bf16_t*)(ws + WS_MG), (const pg8::bf16_t*)(ws + WS_WOUT), T_SEQ, 1024, 1024}; pg8::StaticOrder S; S.init(T_SEQ, 1024, G, bid);
      pg8::EpiZ E{(float*)(ws + WS_Z)};
      pg8::gemm_phase<pg8::EpiZ, pg8::StaticOrder, PG8_ALIGN, PG8_SP2>(lds, g, S, E); }
    xcd_barrier(bar);

    NEWTID();
    { const float* Z = (const float*)(ws + WS_Z); const int lane = tid & 63;
      for (int m = bid * 8 + (tid >> 6); m < T_SEQ + NSAMP; m += G * 8) {
          if (m < T_SEQ) final_row(Z + (size_t)m * 1024, A.xp + (size_t)m * 1024, A.npost, A.out + O_YP + (size_t)m * 1024, lane);
          else final_row(Z + (size_t)m * 1024, A.xs + (size_t)(m - T_SEQ) * 1024, A.npost, A.out + O_YS + (size_t)(m - T_SEQ) * 1024, lane); } }
}

extern "C" void kernel_launch(void* const* d_in, const int* in_sizes, int n_in, void* d_out, int out_size, void* d_ws, size_t ws_size, hipStream_t stream) {
    static int grid = 0;
    if (grid == 0) {
        if (n_in != 19 || out_size != (int)O_END || ws_size < WS_END) { fprintf(stderr, "kernel_launch: unexpected shapes (n_in %d, out %d, ws %zu); nothing launched\n", n_in, out_size, ws_size); grid = -1; return; }
        int dev = 0, cus = 0, per_cu = 0;
        if (hipGetDevice(&dev) != hipSuccess || hipDeviceGetAttribute(&cus, hipDeviceAttributeMultiprocessorCount, dev) != hipSuccess) { grid = -1; return; }
        if (hipFuncSetAttribute((const void*)fwd_kernel, hipFuncAttributeMaxDynamicSharedMemorySize, LDS_BYTES) != hipSuccess) { fprintf(stderr, "kernel_launch: hipFuncSetAttribute failed\n"); grid = -1; return; }
        if (hipOccupancyMaxActiveBlocksPerMultiprocessor(&per_cu, (const void*)fwd_kernel, 512, LDS_BYTES) != hipSuccess || per_cu < 1) { fprintf(stderr, "kernel_launch: occupancy query says %d blocks per CU\n", per_cu); per_cu = 1; }
        (void)hipGetLastError();
        grid = cus;
    }
    if (grid < 0) return;
    if (hipMemsetAsync((char*)d_ws + WS_CTL, 0, CTL_ZERO_BYTES, stream) != hipSuccess) return;
    Args a{};
    a.xp = (const float*)d_in[0]; a.xs = (const float*)d_in[1]; a.memp = (const float*)d_in[2]; a.c128 = (const float*)d_in[3]; a.c512 = (const float*)d_in[4]; a.c2048 = (const float*)d_in[5];
    a.sth = (const float*)d_in[6]; a.cmem = (const float*)d_in[7]; a.npre = (const float*)d_in[8]; a.npost = (const float*)d_in[9]; a.win = (const float*)d_in[10]; a.lbl = (const float*)d_in[11];
    a.hgn = (const float*)d_in[12]; a.mnorm = (const float*)d_in[13]; a.wmem = (const float*)d_in[14]; a.wpa = (const float*)d_in[15]; a.wpb = (const float*)d_in[16]; a.wpc = (const float*)d_in[17]; a.wout = (const float*)d_in[18];
    a.out = (float*)d_out; a.ws = (unsigned char*)d_ws;
    hipLaunchKernelGGL(fwd_kernel, dim3(grid), dim3(512), LDS_BYTES, stream, a);
    const hipError_t le = hipPeekAtLastError();
    if (le != hipSuccess) fprintf(stderr, "kernel_launch: launch failed: %s\n", hipGetErrorName(le));
}
```
